# Optimizing an MI355X kernel written in HIP

```python
import jax, jax.numpy as jnp
from jax import lax
import numpy as np

D_MODEL = 1024
BATCH = 8
SEQ = 8192
DEPTH = 1

CHUNK = 64
SGU_CHUNK = 128
SGU_WIDTH = D_MODEL // 2
SGU_GROUPS = 4
SGU_GROUP_DIM = SGU_WIDTH // SGU_GROUPS
MLSTM_WIDTH = D_MODEL // 2
MLSTM_HEADS = 4
MLSTM_V_DIM = MLSTM_WIDTH // MLSTM_HEADS
MLSTM_QK_DIM = MLSTM_V_DIM // 2
QK_TOTAL = MLSTM_HEADS * MLSTM_QK_DIM
CONV_WIDTH = 4
MIX_WIDTH = SGU_WIDTH + MLSTM_WIDTH
IN_WIDTH = 2 * SGU_WIDTH + 2 * QK_TOTAL + 2 * MLSTM_WIDTH + 2 * MLSTM_HEADS
D_FF = ((8 * D_MODEL // 3 + 127) // 128) * 128
EPS = 1e-6

kernel_name = "hybrid_sgu_mlstm_macaron_block"


def _rmsnorm(x, g):
    x32 = x.astype(jnp.float32)
    y = x32 * lax.rsqrt(jnp.mean(x32 * x32, axis=-1, keepdims=True) + EPS)
    return (y * g.astype(jnp.float32)).astype(x.dtype)


def _layernorm(x, g, b):
    x32 = x.astype(jnp.float32)
    mu = jnp.mean(x32, axis=-1, keepdims=True)
    xc = x32 - mu
    y = xc * lax.rsqrt(jnp.mean(xc * xc, axis=-1, keepdims=True) + EPS)
    return (y * g.astype(jnp.float32) + b.astype(jnp.float32)).astype(x.dtype)


def _swiglu(x, w_gate, w_up, w_down):
    return (jax.nn.silu(x @ w_gate) * (x @ w_up)) @ w_down


def _spatial_gating(z, ln_g, ln_b, w_s, b_s):
    bsz, seq, _ = z.shape
    u, v = z[..., :SGU_WIDTH], z[..., SGU_WIDTH:]
    v = _layernorm(v, ln_g, ln_b)
    vg = v.reshape(bsz, seq // SGU_CHUNK, SGU_CHUNK, SGU_GROUPS, SGU_GROUP_DIM)
    blk = jnp.arange(SGU_CHUNK) // CHUNK
    mask = blk[:, None] >= blk[None, :]
    w = jnp.where(mask[None], w_s, jnp.zeros_like(w_s))
    mixed = jnp.einsum('gts,bcsgd->bctgd', w, vg) + b_s.T[:, :, None]
    return u * mixed.reshape(bsz, seq, SGU_WIDTH)


def _causal_depthwise_conv(x, w, b):
    c = x.shape[-1]
    y = lax.conv_general_dilated(
        x, w[:, None, :], window_strides=(1,), padding=[(CONV_WIDTH - 1, 0)],
        dimension_numbers=('NWC', 'WIO', 'NWC'), feature_group_count=c)
    return y + b


def _mlstm_chunkwise(q, k, v, i_pre, f_pre):
    bsz, nh, seq, dk = q.shape
    dv = v.shape[-1]
    nc = seq // CHUNK
    q = q.astype(jnp.float32).reshape(bsz, nh, nc, CHUNK, dk)
    k = k.astype(jnp.float32).reshape(bsz, nh, nc, CHUNK, dk)
    v = v.astype(jnp.float32).reshape(bsz, nh, nc, CHUNK, dv)
    ig = i_pre.astype(jnp.float32).reshape(bsz, nh, nc, CHUNK)
    logf = jax.nn.log_sigmoid(f_pre.astype(jnp.float32)).reshape(bsz, nh, nc, CHUNK)
    b = jnp.cumsum(logf, axis=-1)
    b_last = b[..., -1]

    g = b_last[..., None] - b + ig
    m_loc = jnp.max(g, axis=-1)
    wg = jnp.exp(g - m_loc[..., None])
    c_loc = jnp.einsum('bhcl,bhclv,bhclk->bhcvk', wg, v, k)
    n_loc = jnp.einsum('bhcl,bhclk->bhck', wg, k)

    def step(carry, xs):
        c_st, n_st, m_st = carry
        c_l, n_l, m_l, bl = xs
        m_new = jnp.maximum(bl + m_st, m_l)
        a = jnp.exp(bl + m_st - m_new)
        e = jnp.exp(m_l - m_new)
        c_new = a[..., None, None] * c_st + e[..., None, None] * c_l
        n_new = a[..., None] * n_st + e[..., None] * n_l
        return (c_new, n_new, m_new), (c_st, n_st, m_st)

    init = (jnp.zeros((bsz, nh, dv, dk), jnp.float32),
            jnp.zeros((bsz, nh, dk), jnp.float32),
            jnp.zeros((bsz, nh), jnp.float32))
    xs = (jnp.moveaxis(c_loc, 2, 0), jnp.moveaxis(n_loc, 2, 0),
          jnp.moveaxis(m_loc, 2, 0), jnp.moveaxis(b_last, 2, 0))
    _, (c_prev, n_prev, m_prev) = lax.scan(step, init, xs)
    c_prev = jnp.moveaxis(c_prev, 0, 2)
    n_prev = jnp.moveaxis(n_prev, 0, 2)
    m_prev = jnp.moveaxis(m_prev, 0, 2)

    d = b[..., :, None] - b[..., None, :] + ig[..., None, :]
    tri = jnp.tril(jnp.ones((CHUNK, CHUNK), dtype=bool))
    d = jnp.where(tri, d, -jnp.inf)
    inter_log = b + m_prev[..., None]
    m_t = jnp.maximum(inter_log, jnp.max(d, axis=-1))
    w = jnp.exp(d - m_t[..., None]) * jnp.einsum('bhctd,bhcsd->bhcts', q, k)
    a_inter = jnp.exp(inter_log - m_t)
    num = (jnp.einsum('bhcts,bhcsv->bhctv', w, v)
           + a_inter[..., None] * jnp.einsum('bhcvk,bhctk->bhctv', c_prev, q))
    den = jnp.sum(w, axis=-1) + a_inter * jnp.einsum('bhck,bhctk->bhct', n_prev, q)
    h = num / jnp.maximum(jnp.abs(den), jnp.exp(-m_t))[..., None]
    return h.reshape(bsz, nh, seq, dv)


def _mlstm_mixer(zb, conv_w, conv_b, igate_b, fgate_b, mh_norm):
    bsz, seq, _ = zb.shape
    o0 = 2 * QK_TOTAL
    o1 = o0 + MLSTM_WIDTH
    o2 = o1 + MLSTM_WIDTH
    o3 = o2 + MLSTM_HEADS
    qk = jax.nn.silu(_causal_depthwise_conv(zb[..., :o0], conv_w, conv_b))
    v_raw = zb[..., o0:o1]
    o_raw = zb[..., o1:o2]
    i_raw = zb[..., o2:o3] + igate_b
    f_raw = zb[..., o3:] + fgate_b
    q = qk[..., :QK_TOTAL].reshape(bsz, seq, MLSTM_HEADS, MLSTM_QK_DIM).transpose(0, 2, 1, 3)
    k = (qk[..., QK_TOTAL:] * (MLSTM_QK_DIM ** -0.5)).reshape(
        bsz, seq, MLSTM_HEADS, MLSTM_QK_DIM).transpose(0, 2, 1, 3)
    v = v_raw.reshape(bsz, seq, MLSTM_HEADS, MLSTM_V_DIM).transpose(0, 2, 1, 3)
    h = _mlstm_chunkwise(q, k, v, i_raw.transpose(0, 2, 1), f_raw.transpose(0, 2, 1))
    h = h * lax.rsqrt(jnp.mean(h * h, axis=-1, keepdims=True) + EPS)
    h = h.transpose(0, 2, 1, 3).reshape(bsz, seq, MLSTM_WIDTH) * mh_norm.astype(jnp.float32)
    return (h * jax.nn.sigmoid(o_raw.astype(jnp.float32))).astype(zb.dtype)


def setup_inputs(seed: int = 0) -> dict:
    key = jax.random.key(seed)
    ks = jax.random.split(key, 24)

    def nrm(k, shape, scale):
        return jax.random.normal(k, shape, jnp.float32) * scale

    return {
        "x": nrm(ks[0], (BATCH, SEQ, D_MODEL), 1.0),
        "ffn1_norm": 1.0 + nrm(ks[1], (DEPTH, D_MODEL), 0.02),
        "ffn1_w_gate": nrm(ks[2], (DEPTH, D_MODEL, D_FF), D_MODEL ** -0.5),
        "ffn1_w_up": nrm(ks[3], (DEPTH, D_MODEL, D_FF), D_MODEL ** -0.5),
        "ffn1_w_down": nrm(ks[4], (DEPTH, D_FF, D_MODEL), D_FF ** -0.5),
        "mix_norm": 1.0 + nrm(ks[5], (DEPTH, D_MODEL), 0.02),
        "w_in": nrm(ks[6], (DEPTH, D_MODEL, IN_WIDTH), D_MODEL ** -0.5),
        "sgu_ln_g": 1.0 + nrm(ks[7], (DEPTH, SGU_WIDTH), 0.02),
        "sgu_ln_b": nrm(ks[8], (DEPTH, SGU_WIDTH), 0.02),
        "sgu_w": nrm(ks[9], (DEPTH, SGU_GROUPS, SGU_CHUNK, SGU_CHUNK), SGU_CHUNK ** -0.5),
        "sgu_b": 1.0 + nrm(ks[10], (DEPTH, SGU_GROUPS, SGU_CHUNK), 0.1),
        "conv_w": nrm(ks[11], (DEPTH, CONV_WIDTH, 2 * QK_TOTAL), CONV_WIDTH ** -0.5),
        "conv_b": nrm(ks[12], (DEPTH, 2 * QK_TOTAL), 0.02),
        "igate_b": nrm(ks[13], (DEPTH, MLSTM_HEADS), 0.1),
        "fgate_b": jnp.linspace(3.0, 6.0, MLSTM_HEADS, dtype=jnp.float32)[None, :]
                    + nrm(ks[14], (DEPTH, MLSTM_HEADS), 0.1),
        "mh_norm": 1.0 + nrm(ks[15], (DEPTH, MLSTM_WIDTH), 0.02),
        "w_out": nrm(ks[16], (DEPTH, MIX_WIDTH, D_MODEL), MIX_WIDTH ** -0.5),
        "ffn2_norm": 1.0 + nrm(ks[17], (DEPTH, D_MODEL), 0.02),
        "ffn2_w_gate": nrm(ks[18], (DEPTH, D_MODEL, D_FF), D_MODEL ** -0.5),
        "ffn2_w_up": nrm(ks[19], (DEPTH, D_MODEL, D_FF), D_MODEL ** -0.5),
        "ffn2_w_down": nrm(ks[20], (DEPTH, D_FF, D_MODEL), D_FF ** -0.5),
        "final_norm": 1.0 + nrm(ks[21], (D_MODEL,), 0.02),
    }


def reference(x, ffn1_norm, ffn1_w_gate, ffn1_w_up, ffn1_w_down, mix_norm, w_in,
              sgu_ln_g, sgu_ln_b, sgu_w, sgu_b, conv_w, conv_b, igate_b, fgate_b,
              mh_norm, w_out, ffn2_norm, ffn2_w_gate, ffn2_w_up, ffn2_w_down, final_norm):
    for l in range(DEPTH):
        h = _rmsnorm(x, ffn1_norm[l])
        x = x + 0.5 * _swiglu(h, ffn1_w_gate[l], ffn1_w_up[l], ffn1_w_down[l])
        h = _rmsnorm(x, mix_norm[l])
        z = h @ w_in[l]
        y_a = _spatial_gating(jax.nn.gelu(z[..., :2 * SGU_WIDTH]),
                              sgu_ln_g[l], sgu_ln_b[l], sgu_w[l], sgu_b[l])
        y_b = _mlstm_mixer(z[..., 2 * SGU_WIDTH:], conv_w[l], conv_b[l],
                           igate_b[l], fgate_b[l], mh_norm[l])
        x = x + jnp.concatenate([y_a, y_b], axis=-1) @ w_out[l]
        h = _rmsnorm(x, ffn2_norm[l])
        x = x + 0.5 * _swiglu(h, ffn2_w_gate[l], ffn2_w_up[l], ffn2_w_down[l])
    return _rmsnorm(x, final_norm)
```

```cpp
#include <hip/hip_runtime.h>
#include <hip/hip_cooperative_groups.h>
#include <cstdio>
#include <cstdint>
namespace cg = cooperative_groups;
#ifndef REP_MASK
#define REP_MASK 0
#endif
#ifndef USE_CG_SYNC
#define USE_CG_SYNC 0
#endif
#ifndef FUSE_FINAL
#define FUSE_FINAL 0
#endif
#ifndef PG8_STGMMA
#define PG8_STGMMA 0
#endif
#ifndef GEMM_SP2
#define GEMM_SP2 true
#endif
#ifndef GEMM_ALIGN
#define GEMM_ALIGN true
#endif
namespace pg8 {
#define PG8_LAS __attribute__((address_space(3)))
typedef unsigned short bf16_t;
typedef short bf16x8 __attribute__((ext_vector_type(8)));
typedef float f32x4 __attribute__((ext_vector_type(4)));
typedef unsigned u32x4 __attribute__((ext_vector_type(4)));
constexpr int BM = 256, BK = 64, HALF = 128, HTB = HALF * BK * 2  , STAGE_BYTES = 8 * HTB, NXCD = 8, WGM = 8;

__host__ __device__ __forceinline__ int lds_byte(int r, int c) { const int st = (r >> 4) * 2 + (c >> 5), rr = r & 15, cc = c & 31, ob = rr * 64 + cc * 2; return st * 1024 + (ob ^ (((ob >> 9) & 1) << 5)); }
__host__ __device__ __forceinline__ void stage_rc(int b, int& R, int& C) { const int st = b / 1024, sb = b % 1024, swz = sb ^ (((sb >> 9) & 1) << 5); R = (st >> 1) * 16 + swz / 64; C = (st & 1) * 32 + (swz % 64) / 2; }
__host__ __device__ __forceinline__ int perm32(int rho) { const int n = rho >> 4, i = rho & 15; return 8 * (i >> 2) + 4 * n + (i & 3); }

struct Unit { int pm, pn; };
struct Gemm { const bf16_t* A; const bf16_t* Bt; int M, N, K; };

struct StaticOrder {
    int nM, nN, nwg, G, c;
    __host__ __device__ void init(int M, int N, int G_, int c_) { nM = M / BM; nN = N / BM; nwg = nM * nN; G = G_; c = c_; }
    __host__ __device__ bool next(int i, Unit& u) const {
        const long L = (long)i * G + c; if (L >= nwg) return false;
        int wgid = (int)L; { const int q = nwg / NXCD, r = nwg % NXCD, xcd = wgid % NXCD, off = wgid / NXCD; wgid = (xcd < r ? xcd * (q + 1) : r * (q + 1) + (xcd - r) * q) + off; }
        const int nig = WGM * nN, gid = wgid / nig, fm = gid * WGM, gsz = (nM - fm) < WGM ? (nM - fm) : WGM;
        u.pm = fm + ((wgid % nig) % gsz); u.pn = (wgid % nig) / gsz; return true;
    }
    __device__ __forceinline__ void a_ready(const Unit&) const {}
    __device__ __forceinline__ void done(const Unit&) const {}
};

__device__ __forceinline__ unsigned cvt_pk_bf16(float lo, float hi) { unsigned r; asm volatile("v_cvt_pk_bf16_f32 %0, %1, %2" : "=v"(r) : "v"(lo), "v"(hi)); return r; }
typedef float f32x2 __attribute__((ext_vector_type(2)));
__device__ __forceinline__ float silu_f(float g) { return g * __builtin_amdgcn_rcpf(1.0f + __builtin_amdgcn_exp2f(-1.44269504f * g)); }
__device__ __forceinline__ float sigmoid_f(float g) { return __builtin_amdgcn_rcpf(1.0f + __builtin_amdgcn_exp2f(-1.44269504f * g)); }
__device__ __forceinline__ float gelu_tanh_f(float x) { const float t = x * (1.0f + 0.044715f * x * x); return x * __builtin_amdgcn_rcpf(1.0f + __builtin_amdgcn_exp2f(-2.302208198f * t)); }
__device__ __forceinline__ float row_rs(const float* rowss, int row) { return __builtin_amdgcn_rsqf(rowss[row] * (1.0f / 1024.0f) + 1e-6f); }

struct EpiGU {
    static constexpr bool PERM = true, AFTER_DRAIN = false;
    bf16_t* H; const float* rowss; int ldh;
    __device__ __forceinline__ void prefetch(const Unit& u, int wr, int fr, float (&pre)[8]) const {
        const int row0 = u.pm * BM + wr * 64 + fr;
#pragma unroll
        for (int i = 0; i < 8; ++i) pre[i] = rowss[row0 + (i >> 2) * HALF + (i & 3) * 16];
    }
    __device__ __forceinline__ void operator()(const f32x4 (&acc)[2][2][4][2], const Unit& u, int wr, int wc, int fr, int fq, const float (&pre)[8]) const {
        const int row0 = u.pm * BM + wr * 64 + fr, col0 = u.pn * 128 + wc * 32 + 8 * fq;
        float rr[2][4];
#pragma unroll
        for (int ai = 0; ai < 2; ++ai)
#pragma unroll
            for (int m = 0; m < 4; ++m) rr[ai][m] = pre[ai * 4 + m];
#pragma unroll
        for (int ai = 0; ai < 2; ++ai)
#pragma unroll
            for (int m = 0; m < 4; ++m) {
                const int row = row0 + ai * HALF + m * 16; const float r = __builtin_amdgcn_rsqf(rr[ai][m] * (1.0f / 1024.0f) + 1e-6f), rn = -1.44269504f * r, r2 = r * r;
                unsigned w[4];
#pragma unroll
                for (int n = 0; n < 2; ++n)
#pragma unroll
                    for (int j = 0; j < 2; ++j) {
                        const f32x2 g = (f32x2){acc[ai][0][m][n][2 * j], acc[ai][0][m][n][2 * j + 1]}, uu = (f32x2){acc[ai][1][m][n][2 * j], acc[ai][1][m][n][2 * j + 1]};
                        const f32x2 t = g * rn; f32x2 e; e.x = __builtin_amdgcn_exp2f(t.x); e.y = __builtin_amdgcn_exp2f(t.y);
                        const f32x2 d = e + 1.0f; f32x2 sg; sg.x = __builtin_amdgcn_rcpf(d.x); sg.y = __builtin_amdgcn_rcpf(d.y);
                        const f32x2 h = ((g * uu) * r2) * sg;
                        w[n * 2 + j] = cvt_pk_bf16(h.x, h.y);
                    }
                u32x4 wv; wv.x = w[0]; wv.y = w[1]; wv.z = w[2]; wv.w = w[3];
                __builtin_nontemporal_store(wv, (u32x4*)(H + (size_t)row * ldh + col0));
            }
    }
};
template <bool BASE_BF16> struct EpiRes {
    static constexpr bool PERM = true, AFTER_DRAIN = false;
    const void* base; bf16_t* outb; float* rowss_out; float scale;
    __device__ __forceinline__ void prefetch(const Unit&, int, int, float (&)[8]) const {}
    __device__ __forceinline__ void operator()(const f32x4 (&acc)[2][2][4][2], const Unit& u, int wr, int wc, int fr, int fq, const float (&)[8]) const {
        const int row0 = u.pm * BM + wr * 64 + fr, col0 = u.pn * BM + wc * 32 + 8 * fq;
#pragma unroll
        for (int ai = 0; ai < 2; ++ai)
#pragma unroll
            for (int m = 0; m < 4; ++m) {
                const int row = row0 + ai * HALF + m * 16; float ss = 0.f;
#pragma unroll
                for (int bj = 0; bj < 2; ++bj) {
                    const size_t off = (size_t)row * 1024 + col0 + bj * HALF;
                    f32x4 b0, b1;
                    if (BASE_BF16) { const u32x4 bb = *(const u32x4*)((const bf16_t*)base + off);
                        b0 = (f32x4){__builtin_bit_cast(float, bb.x << 16), __builtin_bit_cast(float, bb.x & 0xffff0000u), __builtin_bit_cast(float, bb.y << 16), __builtin_bit_cast(float, bb.y & 0xffff0000u)};
                        b1 = (f32x4){__builtin_bit_cast(float, bb.z << 16), __builtin_bit_cast(float, bb.z & 0xffff0000u), __builtin_bit_cast(float, bb.w << 16), __builtin_bit_cast(float, bb.w & 0xffff0000u)}; }
                    else { b0 = *(const f32x4*)((const float*)base + off); b1 = *(const f32x4*)((const float*)base + off + 4); }
                    const f32x4 v0 = b0 + acc[ai][bj][m][0] * scale, v1 = b1 + acc[ai][bj][m][1] * scale;
                    u32x4 w; w.x = cvt_pk_bf16(v0[0], v0[1]); w.y = cvt_pk_bf16(v0[2], v0[3]); w.z = cvt_pk_bf16(v1[0], v1[1]); w.w = cvt_pk_bf16(v1[2], v1[3]); __builtin_nontemporal_store(w, (u32x4*)(outb + off));
                    ss += (v0[0] * v0[0] + v0[1] * v0[1]) + (v0[2] * v0[2] + v0[3] * v0[3]) + (v1[0] * v1[0] + v1[1] * v1[1]) + (v1[2] * v1[2] + v1[3] * v1[3]);
                }
                ss += __shfl_xor(ss, 16); ss += __shfl_xor(ss, 32);
                if (fq == 0) __hip_atomic_fetch_add(rowss_out + row, ss, __ATOMIC_RELAXED, __HIP_MEMORY_SCOPE_AGENT);
            }
    }
};
struct EpiResNorm {
    static constexpr bool PERM = true, AFTER_DRAIN = false;
    const float* base; float* out; float* rowss; unsigned* cnt; const float* gain; float scale;
    __device__ __forceinline__ void prefetch(const Unit&, int, int, float (&)[8]) const {}
    __device__ __forceinline__ void operator()(f32x4 (&acc)[2][2][4][2], const Unit& u, int wr, int wc, int fr, int fq, const float (&)[8]) const {
        const int row0 = u.pm * BM + wr * 64 + fr, col0 = u.pn * BM + wc * 32 + 8 * fq;
#pragma unroll
        for (int ai = 0; ai < 2; ++ai)
#pragma unroll
            for (int m = 0; m < 4; ++m) {
                const int row = row0 + ai * HALF + m * 16; float ss = 0.f;
#pragma unroll
                for (int bj = 0; bj < 2; ++bj) {
                    const size_t off = (size_t)row * 1024 + col0 + bj * HALF;
                    const f32x4 b0 = *(const f32x4*)(base + off), b1 = *(const f32x4*)(base + off + 4);
                    const f32x4 v0 = b0 + acc[ai][bj][m][0] * scale, v1 = b1 + acc[ai][bj][m][1] * scale;
                    acc[ai][bj][m][0] = v0; acc[ai][bj][m][1] = v1;
                    ss += (v0[0] * v0[0] + v0[1] * v0[1]) + (v0[2] * v0[2] + v0[3] * v0[3]) + (v1[0] * v1[0] + v1[1] * v1[1]) + (v1[2] * v1[2] + v1[3] * v1[3]);
                }
                ss += __shfl_xor(ss, 16); ss += __shfl_xor(ss, 32);
                if (fq == 0) __hip_atomic_fetch_add(rowss + row, ss, __ATOMIC_RELAXED, __HIP_MEMORY_SCOPE_AGENT);
            }
        asm volatile("s_waitcnt vmcnt(0)" ::: "memory");
        unsigned* c = cnt + 16 * u.pm;
        if (fr == 0 && fq == 0) __hip_atomic_fetch_add(c, 1u, __ATOMIC_RELAXED, __HIP_MEMORY_SCOPE_AGENT);
        { unsigned sp = 0;
          while ((unsigned)__builtin_amdgcn_readfirstlane(__hip_atomic_load(c, __ATOMIC_RELAXED, __HIP_MEMORY_SCOPE_AGENT)) < 32u) { __builtin_amdgcn_s_sleep(1); if (++sp > (1u << 22)) break; } }
        __builtin_amdgcn_fence(__ATOMIC_ACQUIRE, "agent");
#pragma unroll
        for (int ai = 0; ai < 2; ++ai)
#pragma unroll
            for (int m = 0; m < 4; ++m) {
                const int row = row0 + ai * HALF + m * 16;
                const float r = __builtin_amdgcn_rsqf(__hip_atomic_load(rowss + row, __ATOMIC_RELAXED, __HIP_MEMORY_SCOPE_AGENT) * (1.0f / 1024.0f) + 1e-6f);
#pragma unroll
                for (int bj = 0; bj < 2; ++bj) {
                    const int col = col0 + bj * HALF; const size_t off = (size_t)row * 1024 + col;
                    const f32x4 g0 = *(const f32x4*)(gain + col), g1 = *(const f32x4*)(gain + col + 4);
                    *(f32x4*)(out + off) = acc[ai][bj][m][0] * r * g0; *(f32x4*)(out + off + 4) = acc[ai][bj][m][1] * r * g1;
                }
            }
    }
};
struct EpiIn {
    static constexpr bool PERM = true, AFTER_DRAIN = false;
    bf16_t* Z; float* gates; const float* rowss; int ldz;
    __device__ __forceinline__ void prefetch(const Unit& u, int wr, int fr, float (&pre)[8]) const {
        const int row0 = u.pm * BM + wr * 64 + fr;
#pragma unroll
        for (int i = 0; i < 8; ++i) pre[i] = rowss[row0 + (i >> 2) * HALF + (i & 3) * 16];
    }
    __device__ __forceinline__ void operator()(const f32x4 (&acc)[2][2][4][2], const Unit& u, int wr, int wc, int fr, int fq, const float (&pre)[8]) const {
        const int row0 = u.pm * BM + wr * 64 + fr, col0 = u.pn * BM + wc * 32 + 8 * fq;
        if (u.pn == 10) {
            if (wc == 0 && fq == 0) {
#pragma unroll
                for (int ai = 0; ai < 2; ++ai)
#pragma unroll
                    for (int m = 0; m < 4; ++m) {
                        const int row = row0 + ai * HALF + m * 16; const float r = __builtin_amdgcn_rsqf(pre[ai * 4 + m] * (1.0f / 1024.0f) + 1e-6f);
                        *(f32x4*)(gates + (size_t)row * 8) = acc[ai][0][m][0] * r; *(f32x4*)(gates + (size_t)row * 8 + 4) = acc[ai][0][m][1] * r;
                    }
            }
            return;
        }
        const bool act = u.pn < 4;
#pragma unroll
        for (int ai = 0; ai < 2; ++ai)
#pragma unroll
            for (int m = 0; m < 4; ++m) {
                const int row = row0 + ai * HALF + m * 16; const float r = __builtin_amdgcn_rsqf(pre[ai * 4 + m] * (1.0f / 1024.0f) + 1e-6f);
#pragma unroll
                for (int bj = 0; bj < 2; ++bj) {
                    f32x4 v0 = acc[ai][bj][m][0] * r, v1 = acc[ai][bj][m][1] * r;
                    if (act) {
#pragma unroll
                        for (int j = 0; j < 2; ++j) {
                            f32x2 x0 = (f32x2){v0[2 * j], v0[2 * j + 1]}, x1 = (f32x2){v1[2 * j], v1[2 * j + 1]};
                            const f32x2 t0 = (x0 * x0 * 0.044715f + 1.0f) * x0 * (-2.302208198f), t1 = (x1 * x1 * 0.044715f + 1.0f) * x1 * (-2.302208198f);
                            f32x2 e0, e1; e0.x = __builtin_amdgcn_exp2f(t0.x); e0.y = __builtin_amdgcn_exp2f(t0.y); e1.x = __builtin_amdgcn_exp2f(t1.x); e1.y = __builtin_amdgcn_exp2f(t1.y);
                            e0 = e0 + 1.0f; e1 = e1 + 1.0f;
                            v0[2 * j] = x0.x * __builtin_amdgcn_rcpf(e0.x); v0[2 * j + 1] = x0.y * __builtin_amdgcn_rcpf(e0.y); v1[2 * j] = x1.x * __builtin_amdgcn_rcpf(e1.x); v1[2 * j + 1] = x1.y * __builtin_amdgcn_rcpf(e1.y);
                        }
                    }
                    u32x4 w; w.x = cvt_pk_bf16(v0[0], v0[1]); w.y = cvt_pk_bf16(v0[2], v0[3]); w.z = cvt_pk_bf16(v1[0], v1[1]); w.w = cvt_pk_bf16(v1[2], v1[3]);
                    __builtin_nontemporal_store(w, (u32x4*)(Z + (size_t)row * ldz + col0 + bj * HALF));
                }
            }
    }
};

template <class Epi, class Sched, bool ALIGN_EPI = false, bool SP2 = false>
__device__ __forceinline__ void gemm_phase(PG8_LAS unsigned char* lds, const Gemm g, const Sched& S, const Epi& E) {
    const int tid = threadIdx.x, wid = __builtin_amdgcn_readfirstlane(tid >> 6), lane = tid & 63, wr = wid >> 2, wc = wid & 3, fr = lane & 15, fq = lane >> 4;
    const int K = g.K, nt = K / BK;
    unsigned voffA[2], voffB[2];
#pragma unroll
    for (int i = 0; i < 2; ++i) { int R, C; stage_rc(tid * 16 + i * 8192, R, C); const int Rb = Epi::PERM ? ((R & ~31) + perm32(R & 31)) : R;
        voffA[i] = (unsigned)(R * K + C) * 2u; voffB[i] = (unsigned)(Rb * K + C) * 2u; }
    const size_t kstep = (size_t)(BK * 2);
    const size_t hstep = (size_t)HALF * K * 2;
    const size_t tstep = 2 * hstep;
    const unsigned ldsw = (unsigned)wid * 1024u;
    const int aoff = lds_byte(wr * 64 + fr, fq * 8), boff = lds_byte(wc * 32 + fr, fq * 8);
#define PG8_SA(b, h) (((b) * 2 + (h)) * HTB)
#define PG8_SB(b, h) ((4 + (b) * 2 + (h)) * HTB)
#define PG8_STAGE(bufoff, gbase, voff) do { _Pragma("unroll") for (int _i = 0; _i < 2; ++_i) \
        __builtin_amdgcn_global_load_lds((const unsigned*)((const char*)(gbase) + (voff)[_i]), (PG8_LAS unsigned*)(lds + (bufoff) + ldsw + _i * 8192), 16, 0, 0); } while (0)
#define PG8_LDA(dst, b, h) do { _Pragma("unroll") for (int m = 0; m < 4; ++m) _Pragma("unroll") for (int k = 0; k < 2; ++k) dst[m][k] = *(const PG8_LAS bf16x8*)(lds + PG8_SA(b, h) + aoff + m * 2048 + k * 1024); } while (0)
#define PG8_LDB(dst, b, h) do { _Pragma("unroll") for (int n = 0; n < 2; ++n) _Pragma("unroll") for (int k = 0; k < 2; ++k) dst[n][k] = *(const PG8_LAS bf16x8*)(lds + PG8_SB(b, h) + boff + n * 2048 + k * 1024); } while (0)
#define PG8_MMA(ai, bj, At, Bt) do { __builtin_amdgcn_s_setprio(1); _Pragma("unroll") for (int m = 0; m < 4; ++m) _Pragma("unroll") for (int n = 0; n < 2; ++n) _Pragma("unroll") for (int k = 0; k < 2; ++k) \
        acc[ai][bj][m][n] = __builtin_amdgcn_mfma_f32_16x16x32_bf16(Bt[n][k], At[m][k], acc[ai][bj][m][n], 0, 0, 0); __builtin_amdgcn_s_setprio(0); } while (0)
#define PG8_STAGE1(bufoff, gbase, voff, i) __builtin_amdgcn_global_load_lds((const unsigned*)((const char*)(gbase) + (voff)[i]), (PG8_LAS unsigned*)(lds + (bufoff) + ldsw + (i) * 8192), 16, 0, 0)
#define PG8_MMAQ(ai, bj, At, Bt, m) do { _Pragma("unroll") for (int n = 0; n < 2; ++n) _Pragma("unroll") for (int k = 0; k < 2; ++k) \
        acc[ai][bj][m][n] = __builtin_amdgcn_mfma_f32_16x16x32_bf16(Bt[n][k], At[m][k], acc[ai][bj][m][n], 0, 0, 0); } while (0)
#define PG8_M1(At, B0, B1, bufoff, gbase, voff) do { __builtin_amdgcn_s_setprio(1); \
        PG8_MMAQ(0, 0, At, B0, 0); PG8_MMAQ(0, 0, At, B0, 1); PG8_SCHED; PG8_STAGE1(bufoff, gbase, voff, 0); PG8_SCHED; \
        PG8_MMAQ(0, 0, At, B0, 2); PG8_MMAQ(0, 0, At, B0, 3); PG8_SCHED; PG8_STAGE1(bufoff, gbase, voff, 1); PG8_SCHED; \
        PG8_MMAQ(0, 1, At, B1, 0); PG8_MMAQ(0, 1, At, B1, 1); PG8_MMAQ(0, 1, At, B1, 2); PG8_MMAQ(0, 1, At, B1, 3); __builtin_amdgcn_s_setprio(0); } while (0)
#define PG8_M2(At, B0, B1, o0, g0, v0, o1, g1, v1, o2, g2, v2) do { __builtin_amdgcn_s_setprio(1); \
        PG8_MMAQ(1, 0, At, B0, 0); PG8_SCHED; PG8_STAGE1(o0, g0, v0, 0); PG8_SCHED; PG8_MMAQ(1, 0, At, B0, 1); PG8_SCHED; PG8_STAGE1(o0, g0, v0, 1); PG8_SCHED; \
        PG8_MMAQ(1, 0, At, B0, 2); PG8_SCHED; PG8_STAGE1(o1, g1, v1, 0); PG8_SCHED; PG8_MMAQ(1, 0, At, B0, 3); PG8_SCHED; PG8_STAGE1(o1, g1, v1, 1); PG8_SCHED; \
        PG8_MMAQ(1, 1, At, B1, 0); PG8_SCHED; PG8_STAGE1(o2, g2, v2, 0); PG8_SCHED; PG8_MMAQ(1, 1, At, B1, 1); PG8_SCHED; PG8_STAGE1(o2, g2, v2, 1); PG8_SCHED; \
        PG8_MMAQ(1, 1, At, B1, 2); PG8_MMAQ(1, 1, At, B1, 3); __builtin_amdgcn_s_setprio(0); } while (0)
#define PG8_WAIT_V(n) asm volatile("s_waitcnt vmcnt(" #n ")" ::: "memory")
#define PG8_WAIT_L(n) asm volatile("s_waitcnt lgkmcnt(" #n ")" ::: "memory")
#define PG8_BAR __builtin_amdgcn_s_barrier()
#define PG8_SCHED __builtin_amdgcn_sched_barrier(0)
    Unit cur, nxt; int ui = 0;
    if (!S.next(0, cur)) return;
    float pre[8]; E.prefetch(cur, wr, fr, pre);
    f32x4 acc[2][2][4][2];
#pragma unroll
    for (int a = 0; a < 2; ++a)
#pragma unroll
        for (int b = 0; b < 2; ++b)
#pragma unroll
            for (int m = 0; m < 4; ++m)
#pragma unroll
                for (int n = 0; n < 2; ++n) acc[a][b][m][n] = (f32x4){0.f, 0.f, 0.f, 0.f};
    bf16x8 At[4][2], B0[2][2], B1[2][2];
    const char* cA = (const char*)g.A + (size_t)cur.pm * tstep; const char* cB = (const char*)g.Bt + (size_t)cur.pn * tstep;
    S.a_ready(cur);
    if constexpr (SP2) {
        PG8_STAGE(PG8_SB(0, 0), cB, voffB); PG8_STAGE(PG8_SB(0, 1), cB + hstep, voffB); PG8_STAGE(PG8_SA(0, 0), cA, voffA); PG8_STAGE(PG8_SA(0, 1), cA + hstep, voffA);
        if (wr == 1) PG8_BAR;
        PG8_WAIT_V(2); PG8_BAR;
        PG8_STAGE(PG8_SB(1, 0), cB + kstep, voffB); PG8_STAGE(PG8_SA(1, 0), cA + kstep, voffA); PG8_STAGE(PG8_SB(1, 1), cB + hstep + kstep, voffB);
        PG8_WAIT_V(6); PG8_BAR;
    } else {
        PG8_STAGE(PG8_SB(0, 0), cB, voffB); PG8_STAGE(PG8_SA(0, 0), cA, voffA); PG8_STAGE(PG8_SB(0, 1), cB + hstep, voffB); PG8_STAGE(PG8_SA(0, 1), cA + hstep, voffA);
        if (wr == 1) PG8_BAR;
        PG8_WAIT_V(4); PG8_BAR;
        PG8_STAGE(PG8_SB(1, 0), cB + kstep, voffB); PG8_STAGE(PG8_SA(1, 0), cA + kstep, voffA); PG8_STAGE(PG8_SB(1, 1), cB + hstep + kstep, voffB);
        PG8_WAIT_V(6); PG8_BAR;
    }
    for (;;) {
        const bool has_next = S.next(ui + 1, nxt);
        const char* nA = has_next ? (const char*)g.A + (size_t)nxt.pm * tstep : cA; const char* nB = has_next ? (const char*)g.Bt + (size_t)nxt.pn * tstep : cB;
        for (int t = 0; t < nt; t += 2) {
            const bool last = (t == nt - 2);
            const char* a1 = cA + (size_t)(t + 1) * kstep;
            const char* a2 = last ? nA : cA + (size_t)(t + 2) * kstep; const char* b2 = last ? nB : cB + (size_t)(t + 2) * kstep;
            const char* a3 = a2 + kstep; const char* b3 = b2 + kstep;
            if (last && has_next) S.a_ready(nxt);
            if constexpr (SP2) {
#if PG8_STGMMA
            PG8_LDB(B0, 0, 0); PG8_LDB(B1, 0, 1); PG8_SCHED; PG8_LDA(At, 0, 0);
            PG8_WAIT_V(6); PG8_WAIT_L(0); PG8_BAR; PG8_M1(At, B0, B1, PG8_SA(1, 1), a1 + hstep, voffA); PG8_BAR; PG8_SCHED;
            PG8_LDA(At, 0, 1);
            PG8_WAIT_V(2); PG8_WAIT_L(0); PG8_BAR; PG8_M2(At, B0, B1, PG8_SB(0, 0), b2, voffB, PG8_SB(0, 1), b2 + hstep, voffB, PG8_SA(0, 0), a2, voffA); PG8_BAR; PG8_SCHED;
            PG8_LDB(B0, 1, 0); PG8_LDB(B1, 1, 1); PG8_SCHED; PG8_LDA(At, 1, 0);
            PG8_WAIT_V(6); PG8_WAIT_L(0); PG8_BAR; PG8_M1(At, B0, B1, PG8_SA(0, 1), a2 + hstep, voffA); PG8_BAR; PG8_SCHED;
            PG8_LDA(At, 1, 1);
            PG8_WAIT_V(2); PG8_WAIT_L(0); PG8_BAR; PG8_M2(At, B0, B1, PG8_SB(1, 0), b3, voffB, PG8_SB(1, 1), b3 + hstep, voffB, PG8_SA(1, 0), a3, voffA); PG8_BAR; PG8_SCHED;
#else
            PG8_LDB(B0, 0, 0); PG8_LDB(B1, 0, 1); PG8_SCHED; PG8_LDA(At, 0, 0); PG8_STAGE(PG8_SA(1, 1), a1 + hstep, voffA);
            PG8_WAIT_V(8); PG8_WAIT_L(0); PG8_BAR; PG8_MMA(0, 0, At, B0); PG8_MMA(0, 1, At, B1); PG8_BAR; PG8_SCHED;
            PG8_LDA(At, 0, 1); PG8_STAGE(PG8_SB(0, 0), b2, voffB); PG8_STAGE(PG8_SB(0, 1), b2 + hstep, voffB); PG8_STAGE(PG8_SA(0, 0), a2, voffA);
            PG8_WAIT_V(8); PG8_WAIT_L(0); PG8_BAR; PG8_MMA(1, 0, At, B0); PG8_MMA(1, 1, At, B1); PG8_BAR; PG8_SCHED;
            PG8_LDB(B0, 1, 0); PG8_LDB(B1, 1, 1); PG8_SCHED; PG8_LDA(At, 1, 0); PG8_STAGE(PG8_SA(0, 1), a2 + hstep, voffA);
            PG8_WAIT_V(8); PG8_WAIT_L(0); PG8_BAR; PG8_MMA(0, 0, At, B0); PG8_MMA(0, 1, At, B1); PG8_BAR; PG8_SCHED;
            PG8_LDA(At, 1, 1); PG8_STAGE(PG8_SB(1, 0), b3, voffB); PG8_STAGE(PG8_SB(1, 1), b3 + hstep, voffB); PG8_STAGE(PG8_SA(1, 0), a3, voffA);
            PG8_WAIT_V(8); PG8_WAIT_L(0); PG8_BAR; PG8_MMA(1, 0, At, B0); PG8_MMA(1, 1, At, B1); PG8_BAR; PG8_SCHED;
#endif
            } else {
            PG8_LDB(B0, 0, 0); PG8_SCHED; PG8_LDA(At, 0, 0); PG8_STAGE(PG8_SA(1, 1), a1 + hstep, voffA);
            PG8_WAIT_L(8); PG8_BAR; PG8_WAIT_L(0); PG8_MMA(0, 0, At, B0); PG8_BAR; PG8_SCHED;
            PG8_LDB(B1, 0, 1); PG8_STAGE(PG8_SB(0, 0), b2, voffB);
            PG8_BAR; PG8_WAIT_L(0); PG8_MMA(0, 1, At, B1); PG8_BAR;
            PG8_LDA(At, 0, 1); PG8_STAGE(PG8_SA(0, 0), a2, voffA);
            PG8_BAR; PG8_WAIT_L(0); PG8_MMA(1, 0, At, B0); PG8_BAR; PG8_SCHED;
            PG8_STAGE(PG8_SB(0, 1), b2 + hstep, voffB);
            PG8_WAIT_V(6); PG8_BAR; PG8_MMA(1, 1, At, B1); PG8_BAR;
            PG8_LDB(B0, 1, 0); PG8_SCHED; PG8_LDA(At, 1, 0); PG8_STAGE(PG8_SA(0, 1), a2 + hstep, voffA);
            PG8_WAIT_L(8); PG8_BAR; PG8_WAIT_L(0); PG8_MMA(0, 0, At, B0); PG8_BAR; PG8_SCHED;
            PG8_LDB(B1, 1, 1); PG8_STAGE(PG8_SB(1, 0), b3, voffB);
            PG8_BAR; PG8_WAIT_L(0); PG8_MMA(0, 1, At, B1); PG8_BAR;
            PG8_LDA(At, 1, 1); PG8_STAGE(PG8_SA(1, 0), a3, voffA);
            PG8_BAR; PG8_WAIT_L(0); PG8_MMA(1, 0, At, B0); PG8_BAR; PG8_SCHED;
            PG8_STAGE(PG8_SB(1, 1), b3 + hstep, voffB);
            PG8_WAIT_V(6); PG8_BAR; PG8_MMA(1, 1, At, B1); PG8_BAR;
            }
        }
        if constexpr (ALIGN_EPI) { if (wr == 0) PG8_BAR; }
        if constexpr (!Epi::AFTER_DRAIN) { E(acc, cur, wr, wc, fr, fq, pre); S.done(cur); }
        if (!has_next) break;
#pragma unroll
        for (int a = 0; a < 2; ++a)
#pragma unroll
            for (int b = 0; b < 2; ++b)
#pragma unroll
                for (int m = 0; m < 4; ++m)
#pragma unroll
                    for (int n = 0; n < 2; ++n) acc[a][b][m][n] = (f32x4){0.f, 0.f, 0.f, 0.f};
        cur = nxt; cA = nA; cB = nB; ++ui;
        E.prefetch(cur, wr, fr, pre);
        if constexpr (ALIGN_EPI) { if (wr == 1) PG8_BAR; }
    }
    PG8_WAIT_V(0);
    if constexpr (!ALIGN_EPI) { if (wr == 0) PG8_BAR; }
    PG8_BAR;
    if constexpr (Epi::AFTER_DRAIN) { E.fused(acc, cur, wr, wc, fr, fq, lds, wid, lane); S.done(cur); }
#undef PG8_SA
#undef PG8_SB
#undef PG8_STAGE
#undef PG8_LDA
#undef PG8_LDB
#undef PG8_MMA
#undef PG8_MMAQ
#undef PG8_M1
#undef PG8_M2
#undef PG8_STAGE1
#undef PG8_WAIT_V
#undef PG8_WAIT_L
#undef PG8_BAR
#undef PG8_SCHED
}
}

constexpr int NWAVES = 8, NTHR = 512;
constexpr int BATCH = 8, SEQ = 8192, D = 1024, M = BATCH * SEQ, FF = 2816, NGU = 2 * FF, NIN = 2568, NINP = 2816, ZW = 2560, NCHK = SEQ / 64, NHEAD = 4;
constexpr int NTASK = BATCH * NHEAD * NCHK;
constexpr float EPS = 1e-6f;
constexpr size_t MiB = 1u << 20;
constexpr size_t WS_WGU1 = 2 * MiB, WS_WD1 = 13 * MiB, WS_WIN = 19 * MiB, WS_WOUT = 25 * MiB, WS_WGU2 = 27 * MiB, WS_WD2 = 38 * MiB, WS_SGUW = 44 * MiB;
constexpr size_t WS_RSS = 45 * MiB, WS_GATES = 46 * MiB, WS_ML = 48 * MiB, WS_NST = 49 * MiB;
constexpr size_t WS_XB = 64 * MiB, WS_HID = 192 * MiB, WS_Z = 192 * MiB, WS_Y = 544 * MiB, WS_CST = 672 * MiB, WS_END = 800 * MiB;
constexpr int LDS_BYTES = 147456, MISC_OFF = LDS_BYTES - 128;
constexpr size_t WS_CTL = 0, CTL_ZERO_BYTES = 65536;

#define LAS __attribute__((address_space(3)))
typedef unsigned short bf16;
typedef unsigned u32x4 __attribute__((ext_vector_type(4)));
typedef unsigned u32x2 __attribute__((ext_vector_type(2)));
typedef float f32x4 __attribute__((ext_vector_type(4)));
typedef short bf16x8 __attribute__((ext_vector_type(8)));
#define LDS_WAIT() asm volatile("s_waitcnt lgkmcnt(0)" ::: "memory")
#define LBAR() do { asm volatile("s_waitcnt lgkmcnt(0)" ::: "memory"); __builtin_amdgcn_s_barrier(); asm volatile("" ::: "memory"); } while (0)
__device__ __forceinline__ unsigned f2bf(float f) { unsigned u = __builtin_bit_cast(unsigned, f); return (u + 0x7fffu + ((u >> 16) & 1u)) >> 16; }
__device__ __forceinline__ unsigned pk2(float lo, float hi) { return f2bf(lo) | (f2bf(hi) << 16); }
__device__ __forceinline__ float bflo(unsigned w) { return __builtin_bit_cast(float, w << 16); }
__device__ __forceinline__ float bfhi(unsigned w) { return __builtin_bit_cast(float, w & 0xffff0000u); }
__device__ __forceinline__ float wave_sum(float v) {
#pragma unroll
    for (int o = 1; o < 64; o <<= 1) v += __shfl_xor(v, o);
    return v;
}
__device__ __forceinline__ float wave_max(float v) {
#pragma unroll
    for (int o = 1; o < 64; o <<= 1) v = fmaxf(v, __shfl_xor(v, o));
    return v;
}
template <int CTRL, int ROWMASK> __device__ __forceinline__ float dpp_mov(float ident, float src) {
    return __builtin_bit_cast(float, __builtin_amdgcn_update_dpp(__builtin_bit_cast(int, ident), __builtin_bit_cast(int, src), CTRL, ROWMASK, 0xf, false));
}
__device__ __forceinline__ float scan_add(float v, int) {
    v += dpp_mov<0x111, 0xf>(0.f, v); v += dpp_mov<0x112, 0xf>(0.f, v); v += dpp_mov<0x114, 0xf>(0.f, v); v += dpp_mov<0x118, 0xf>(0.f, v);
    v += dpp_mov<0x142, 0xa>(0.f, v); v += dpp_mov<0x143, 0xc>(0.f, v);
    return v;
}
__device__ __forceinline__ float scan_max(float v, int) {
    const float ninf = -__builtin_inff();
    v = fmaxf(v, dpp_mov<0x111, 0xf>(ninf, v)); v = fmaxf(v, dpp_mov<0x112, 0xf>(ninf, v)); v = fmaxf(v, dpp_mov<0x114, 0xf>(ninf, v)); v = fmaxf(v, dpp_mov<0x118, 0xf>(ninf, v));
    v = fmaxf(v, dpp_mov<0x142, 0xa>(ninf, v)); v = fmaxf(v, dpp_mov<0x143, 0xc>(ninf, v));
    return v;
}
__device__ __forceinline__ float logsigmoid_f(float x) { const float e = __expf(-fabsf(x)); return fminf(x, 0.f) - ((e < 1e-4f) ? e * (1.0f - 0.5f * e) : __logf(1.0f + e)); }

struct Args {
    const float* in[22]; float* out; unsigned char* ws; int ph_lo, ph_hi;
};
enum { I_X = 0, I_N1, I_G1, I_U1, I_D1, I_MIXN, I_WIN, I_LNG, I_LNB, I_SGUW, I_SGUB, I_CONVW, I_CONVB, I_IGB, I_FGB, I_MHN, I_WOUT, I_N2, I_G2, I_U2, I_D2, I_FINALN };

__device__ __forceinline__ void tr_item(const float* __restrict__ W, int K, int N, const float* __restrict__ gain, bf16* WT, int drow0, int k0, int n0, LAS float* scr, int lane) {
    const int kk8 = lane >> 3, c4 = (lane & 7) * 4; const bool ok = (n0 + c4) < N;
    f32x4 v[8];
#pragma unroll
    for (int i = 0; i < 8; ++i) { const int kk = 8 * i + kk8; v[i] = ok ? *(const f32x4*)(W + (size_t)(k0 + kk) * N + n0 + c4) : (f32x4){0.f, 0.f, 0.f, 0.f}; }
#pragma unroll
    for (int i = 0; i < 8; ++i) { const int kk = 8 * i + kk8; const float g = gain ? gain[k0 + kk] : 1.0f; LAS float* d = scr + kk * 33 + c4;
        d[0] = v[i][0] * g; d[1] = v[i][1] * g; d[2] = v[i][2] * g; d[3] = v[i][3] * g; }
    LDS_WAIT(); asm volatile("" ::: "memory");
    const int c = lane & 7;
#pragma unroll
    for (int j = 0; j < 4; ++j) { const int nn = (lane >> 3) + 8 * j; const LAS float* s = scr + (8 * c) * 33 + nn;
        u32x4 o; o.x = pk2(s[0 * 33], s[1 * 33]); o.y = pk2(s[2 * 33], s[3 * 33]); o.z = pk2(s[4 * 33], s[5 * 33]); o.w = pk2(s[6 * 33], s[7 * 33]);
        *(u32x4*)(WT + (size_t)(drow0 + nn) * K + k0 + 8 * c) = o; }
    LDS_WAIT(); asm volatile("" ::: "memory");
}
__device__ __forceinline__ void p0_prologue(const Args& a, LAS unsigned char* lds, int vcu, int G, int tid) {
    const int wave = __builtin_amdgcn_readfirstlane(tid >> 6), lane = tid & 63;
    unsigned char* ws = a.ws;
    LAS float* scr = (LAS float*)(lds + wave * 16384);
    const int gw = vcu * NWAVES + wave, NGW = G * NWAVES;
    constexpr int IT_GU = 16 * 88, IT_D = 44 * 32, IT_IN = 16 * 88, IT_OUT = 16 * 32;
    constexpr int NITEMS = 4 * IT_GU + 2 * IT_D + IT_IN + IT_OUT;
    for (int it = gw; it < NITEMS; it += NGW) {
        int r = it;
        if (r < 2 * IT_GU) {
            const int s = r / IT_GU; r -= s * IT_GU; const int kb = r / 88, nb = r % 88, n0 = nb * 32;
            tr_item(a.in[s ? I_U1 : I_G1], D, FF, a.in[I_N1], (bf16*)(ws + WS_WGU1), 256 * (n0 >> 7) + 128 * s + (n0 & 127), kb * 64, n0, scr, lane); continue; }
        r -= 2 * IT_GU;
        if (r < 2 * IT_GU) {
            const int s = r / IT_GU; r -= s * IT_GU; const int kb = r / 88, nb = r % 88, n0 = nb * 32;
            tr_item(a.in[s ? I_U2 : I_G2], D, FF, a.in[I_N2], (bf16*)(ws + WS_WGU2), 256 * (n0 >> 7) + 128 * s + (n0 & 127), kb * 64, n0, scr, lane); continue; }
        r -= 2 * IT_GU;
        if (r < 2 * IT_D) {
            const int s = r / IT_D; r -= s * IT_D; const int kb = r / 32, nb = r % 32, n0 = nb * 32;
            tr_item(a.in[s ? I_D2 : I_D1], FF, D, nullptr, (bf16*)(ws + (s ? WS_WD2 : WS_WD1)), n0, kb * 64, n0, scr, lane); continue; }
        r -= 2 * IT_D;
        if (r < IT_IN) { const int kb = r / 88, nb = r % 88, n0 = nb * 32;
            tr_item(a.in[I_WIN], D, NIN, a.in[I_MIXN], (bf16*)(ws + WS_WIN), n0, kb * 64, n0, scr, lane); continue; }
        r -= IT_IN;
        { const int kb = r / 32, nb = r % 32, n0 = nb * 32;
            tr_item(a.in[I_WOUT], D, D, nullptr, (bf16*)(ws + WS_WOUT), n0, kb * 64, n0, scr, lane); }
    }
    {
        float* rss0 = (float*)(ws + WS_RSS); bf16* XB = (bf16*)(ws + WS_XB); const float* x = a.in[I_X];
        for (int m0 = gw * 4; m0 < M; m0 += NGW * 4) {
            f32x4 v[4][4];
#pragma unroll
            for (int r = 0; r < 4; ++r) { const f32x4* xr = (const f32x4*)(x + (size_t)(m0 + r) * D) + lane;
#pragma unroll
                for (int j = 0; j < 4; ++j) v[r][j] = __builtin_nontemporal_load(xr + 64 * j); }
#pragma unroll
            for (int r = 0; r < 4; ++r) { unsigned long long* o8 = (unsigned long long*)(XB + (size_t)(m0 + r) * D) + lane; float s = 0.f;
#pragma unroll
                for (int j = 0; j < 4; ++j) { s += (v[r][j].x * v[r][j].x + v[r][j].y * v[r][j].y) + (v[r][j].z * v[r][j].z + v[r][j].w * v[r][j].w);
                    __builtin_nontemporal_store((unsigned long long)pk2(v[r][j].x, v[r][j].y) | ((unsigned long long)pk2(v[r][j].z, v[r][j].w) << 32), o8 + 64 * j); }
                s = wave_sum(s); if (lane == 0) rss0[m0 + r] = s; }
        }
    }
    {
        float* rss = (float*)(ws + WS_RSS) + M; const int gt = vcu * NTHR + tid, NGT = G * NTHR;
        for (int i = gt; i < 3 * M; i += NGT) rss[i] = 0.f;
        bf16* sw = (bf16*)(ws + WS_SGUW); const float* w = a.in[I_SGUW];
        for (int i = gt; i < 4 * 128 * 128; i += NGT) { const int t = (i >> 7) & 127, s = i & 127; sw[i] = (bf16)(((t >> 6) >= (s >> 6)) ? f2bf(w[i]) : 0u); }
    }
}

__device__ __forceinline__ void sgu_chunk(const Args& a, LAS unsigned char* lds, int chunk, int tid) {
    const int wave = __builtin_amdgcn_readfirstlane(tid >> 6), lane = tid & 63, fr = lane & 15, fq = lane >> 4;
    unsigned char* ws = a.ws;
    const bf16* Z = (const bf16*)(ws + WS_Z); bf16* Y = (bf16*)(ws + WS_Y); const bf16* SW = (const bf16*)(ws + WS_SGUW);
    constexpr int VS = 136;
    LAS bf16* vT = (LAS bf16*)lds;
    LAS float* st = (LAS float*)(lds + 512 * VS * 2);
    bf16x8 wfr[4][4]; float bsv[4];
    { const int tt = 16 * wave + fr;
#pragma unroll
      for (int g = 0; g < 4; ++g) { bsv[g] = a.in[I_SGUB][g * 128 + tt];
#pragma unroll
          for (int ks = 0; ks < 4; ++ks) wfr[g][ks] = *(const bf16x8*)(SW + ((size_t)(g * 128 + tt) * 128 + 32 * ks + 8 * fq)); } }
    {
        const int t = tid & 127, g = tid >> 7;
        const u32x4* zr = (const u32x4*)(Z + ((size_t)chunk * 128 + t) * ZW + 512 + g * 128);
        u32x4 raw[16]; float s = 0.f, ss = 0.f;
#pragma unroll
        for (int i = 0; i < 16; ++i) { raw[i] = zr[i];
#pragma unroll
            for (int j = 0; j < 4; ++j) { const float lo = bflo(raw[i][j]), hi = bfhi(raw[i][j]); s += lo + hi; ss += lo * lo + hi * hi; } }
        st[(g * 128 + t) * 2] = s; st[(g * 128 + t) * 2 + 1] = ss;
        __syncthreads();
        float S = 0.f, SS = 0.f;
#pragma unroll
        for (int gg = 0; gg < 4; ++gg) { S += st[(gg * 128 + t) * 2]; SS += st[(gg * 128 + t) * 2 + 1]; }
        const float mu = S * (1.f / 512.f), var = fmaxf(SS * (1.f / 512.f) - mu * mu, 0.f), rstd = 1.0f / sqrtf(var + EPS);
        const float* lg = a.in[I_LNG] + g * 128; const float* lb = a.in[I_LNB] + g * 128;
#pragma unroll
        for (int i = 0; i < 16; ++i)
#pragma unroll
            for (int j = 0; j < 4; ++j) { const int d = 8 * i + 2 * j;
                const float y0 = (bflo(raw[i][j]) - mu) * rstd * lg[d] + lb[d], y1 = (bfhi(raw[i][j]) - mu) * rstd * lg[d + 1] + lb[d + 1];
                vT[(g * 128 + d) * VS + t] = (bf16)f2bf(y0); vT[(g * 128 + d + 1) * VS + t] = (bf16)f2bf(y1); }
    }
    __syncthreads();
    {
        const int tb = wave, tt = 16 * tb + fr; const size_t row = (size_t)chunk * 128 + tt; const bool full = tb >= 4;
#pragma unroll
        for (int g = 0; g < 4; ++g) {
            f32x4 acc[4][2];
#pragma unroll
            for (int p = 0; p < 4; ++p) { acc[p][0] = (f32x4){0.f, 0.f, 0.f, 0.f}; acc[p][1] = (f32x4){0.f, 0.f, 0.f, 0.f}; }
            u32x4 uu[4];
#pragma unroll
            for (int p = 0; p < 4; ++p) uu[p] = *(const u32x4*)(Z + row * ZW + g * 128 + 32 * p + 8 * fq);
#pragma unroll
            for (int ks = 0; ks < 4; ++ks) {
                if (ks < 2 || full) {
                    const bf16x8 wf = wfr[g][ks];
#pragma unroll
                    for (int p = 0; p < 4; ++p)
#pragma unroll
                        for (int n = 0; n < 2; ++n) { const int drow = g * 128 + 32 * p + 8 * (fr >> 2) + 4 * n + (fr & 3);
                            const bf16x8 vf = *(const LAS bf16x8*)(vT + drow * VS + 32 * ks + 8 * fq);
                            acc[p][n] = __builtin_amdgcn_mfma_f32_16x16x32_bf16(vf, wf, acc[p][n], 0, 0, 0); }
                }
            }
            const float bias = bsv[g];
#pragma unroll
            for (int p = 0; p < 4; ++p) { const int d0 = g * 128 + 32 * p + 8 * fq; const u32x4 u = uu[p];
                u32x4 o;
                o.x = pk2(bflo(u.x) * (acc[p][0][0] + bias), bfhi(u.x) * (acc[p][0][1] + bias)); o.y = pk2(bflo(u.y) * (acc[p][0][2] + bias), bfhi(u.y) * (acc[p][0][3] + bias));
                o.z = pk2(bflo(u.z) * (acc[p][1][0] + bias), bfhi(u.z) * (acc[p][1][1] + bias)); o.w = pk2(bflo(u.w) * (acc[p][1][2] + bias), bfhi(u.w) * (acc[p][1][3] + bias));
                __builtin_nontemporal_store(o, (u32x4*)(Y + row * 1024 + d0)); }
        }
    }
    __syncthreads();
}

__device__ __forceinline__ void conv8_fetch(const bf16* Z, int b, int pos, int ch, u32x4 (&z)[4]) {
#pragma unroll
    for (int j = 0; j < 4; ++j) { const int tt = pos - 3 + j; z[j] = (tt >= 0) ? *(const u32x4*)(Z + ((size_t)b * SEQ + tt) * ZW + 1024 + ch) : (u32x4){0u, 0u, 0u, 0u}; }
}
__device__ __forceinline__ void conv8_math(const Args& a, int ch, const u32x4 (&zz)[4], float (&o)[8]) {
    const float* cw = a.in[I_CONVW]; const float* cb = a.in[I_CONVB];
    const f32x4 b0 = *(const f32x4*)(cb + ch), b1 = *(const f32x4*)(cb + ch + 4);
    float acc[8] = {b0[0], b0[1], b0[2], b0[3], b1[0], b1[1], b1[2], b1[3]};
#pragma unroll
    for (int j = 0; j < 4; ++j) { const u32x4 z = zz[j];
        const f32x4 w0 = *(const f32x4*)(cw + j * 512 + ch), w1 = *(const f32x4*)(cw + j * 512 + ch + 4);
        acc[0] += w0[0] * bflo(z.x); acc[1] += w0[1] * bfhi(z.x); acc[2] += w0[2] * bflo(z.y); acc[3] += w0[3] * bfhi(z.y);
        acc[4] += w1[0] * bflo(z.z); acc[5] += w1[1] * bfhi(z.z); acc[6] += w1[2] * bflo(z.w); acc[7] += w1[3] * bfhi(z.w); }
#pragma unroll
    for (int i = 0; i < 8; ++i) o[i] = pg8::silu_f(acc[i]);
}

struct M1Pre { u32x4 zk[4]; u32x4 vv[2]; float fpre, ipre; };
__device__ __forceinline__ void m1_fetch(const Args& a, int task, int tid, M1Pre& P) {
    const int wave = __builtin_amdgcn_readfirstlane(tid >> 6), lane = tid & 63;
    const bf16* Z = (const bf16*)(a.ws + WS_Z); const float* gates = (const float*)(a.ws + WS_GATES);
    const int b = task / (NHEAD * NCHK), h = (task / NCHK) % NHEAD, c = task % NCHK; const size_t row0 = (size_t)b * SEQ + c * 64;
    if (wave == 0) { P.fpre = gates[(row0 + lane) * 8 + 4 + h]; P.ipre = gates[(row0 + lane) * 8 + h]; }
    const int l = tid & 63, c8 = wave * 8, v16 = wave * 16;
    conv8_fetch(Z, b, c * 64 + l, 256 + h * 64 + c8, P.zk);
    const u32x4* vr = (const u32x4*)(Z + (row0 + l) * ZW + 1536 + h * 128 + v16); P.vv[0] = vr[0]; P.vv[1] = vr[1];
}
__device__ __forceinline__ void m1_body(const Args& a, LAS unsigned char* lds, int task, int tid, M1Pre& P, bool has_next, int next_task, M1Pre& Pn) {
    const int wave = __builtin_amdgcn_readfirstlane(tid >> 6), lane = tid & 63, fr = lane & 15, fq = lane >> 4;
    unsigned char* ws = a.ws;
    float* ML = (float*)(ws + WS_ML); float* BL = ML + NTASK; bf16* CST = (bf16*)(ws + WS_CST); float* NST = (float*)(ws + WS_NST);
    const int h = (task / NCHK) % NHEAD;
    constexpr int KS = 72;
    LAS float* wg = (LAS float*)lds;
    LAS bf16* kwT = (LAS bf16*)(lds + 256);
    LAS bf16* vT = (LAS bf16*)(lds + 256 + 64 * KS * 2);
    if (wave == 0) {
        const float fpre = P.fpre + a.in[I_FGB][h], ipre = P.ipre + a.in[I_IGB][h];
        const float bc = scan_add(logsigmoid_f(fpre), lane), blast = __shfl(bc, 63);
        const float g = blast - bc + ipre, mloc = wave_max(g);
        wg[lane] = expf(g - mloc);
        if (lane == 0) { ML[task] = mloc; BL[task] = blast; }
    }
    const int l = tid & 63, c8 = wave * 8, v16 = wave * 16;
    float kv[8]; conv8_math(a, 256 + h * 64 + c8, P.zk, kv);
#pragma unroll
    for (int q = 0; q < 2; ++q) { const u32x4 z = P.vv[q];
#pragma unroll
        for (int j = 0; j < 4; ++j) { vT[(v16 + 8 * q + 2 * j) * KS + l] = (bf16)(z[j] & 0xffffu); vT[(v16 + 8 * q + 2 * j + 1) * KS + l] = (bf16)(z[j] >> 16); } }
    LBAR();
    {
        const float sc = 0.125f * wg[l];
#pragma unroll
        for (int i = 0; i < 8; ++i) kwT[(c8 + i) * KS + l] = (bf16)f2bf(kv[i] * sc);
    }
    LBAR();
    if (has_next) m1_fetch(a, next_task, tid, Pn);
    {
        f32x4 acc[4];
#pragma unroll
        for (int kb = 0; kb < 4; ++kb) acc[kb] = (f32x4){0.f, 0.f, 0.f, 0.f};
#pragma unroll
        for (int ks = 0; ks < 2; ++ks) { const bf16x8 yf = *(const LAS bf16x8*)(vT + (16 * wave + fr) * KS + 32 * ks + 8 * fq);
#pragma unroll
            for (int kb = 0; kb < 4; ++kb) { const bf16x8 xf = *(const LAS bf16x8*)(kwT + (16 * kb + fr) * KS + 32 * ks + 8 * fq);
                acc[kb] = __builtin_amdgcn_mfma_f32_16x16x32_bf16(xf, yf, acc[kb], 0, 0, 0); } }
        bf16* cp = CST + (size_t)task * 8192 + (16 * wave + fr) * 64 + 4 * fq;
#pragma unroll
        for (int kb = 0; kb < 4; ++kb) { u32x2 o; o.x = pk2(acc[kb][0], acc[kb][1]); o.y = pk2(acc[kb][2], acc[kb][3]); __builtin_nontemporal_store(o, (u32x2*)(cp + 16 * kb)); }
        if (tid < 64) { float s = 0.f;
#pragma unroll 8
            for (int ll = 0; ll < 64; ++ll) s += __builtin_bit_cast(float, (unsigned)kwT[tid * KS + ll] << 16);
            NST[(size_t)task * 64 + tid] = s; }
    }
    LBAR();
}

__device__ __forceinline__ void scan_block(const Args& a, LAS unsigned char* lds, int vb, int tid) {
    unsigned char* ws = a.ws;
    float* ML = (float*)(ws + WS_ML); float* BL = ML + NTASK; float* MP = ML + 2 * NTASK; bf16* CST = (bf16*)(ws + WS_CST); float* NST = (float*)(ws + WS_NST);
    const int bh = vb >> 3, part = vb & 7;
    LAS float* sm = (LAS float*)lds;
    if (tid < 128) { sm[tid] = ML[bh * NCHK + tid]; sm[128 + tid] = BL[bh * NCHK + tid]; }
    typedef float f32x2v __attribute__((ext_vector_type(2)));
    unsigned* cp = (unsigned*)(CST + (size_t)bh * NCHK * 8192) + part * 512 + tid;
    const bool hasn = (part == 0 && tid < 64); float* np = NST + (size_t)bh * NCHK * 64 + tid;
    f32x2v cs = (f32x2v){0.f, 0.f}; float ns = 0.f, ms = 0.f;
    unsigned cl[8], cn[8]; float nl[8], nn[8];
#pragma unroll
    for (int i = 0; i < 8; ++i) { cl[i] = cp[(size_t)i * 4096]; nl[i] = hasn ? np[i * 64] : 0.f; }
    LBAR();
    for (int c0 = 0; c0 < NCHK; c0 += 8) {
        if (c0 + 8 < NCHK) {
#pragma unroll
            for (int i = 0; i < 8; ++i) { cn[i] = cp[(size_t)(c0 + 8 + i) * 4096]; nn[i] = hasn ? np[(c0 + 8 + i) * 64] : 0.f; }
        }
#pragma unroll
        for (int i = 0; i < 8; ++i) {
            const float ml = sm[c0 + i], bl = sm[128 + c0 + i];
            const float mn = fmaxf(bl + ms, ml), aa = __expf(bl + ms - mn), ee = __expf(ml - mn);
            cp[(size_t)(c0 + i) * 4096] = pk2(cs.x, cs.y); if (hasn) np[(c0 + i) * 64] = ns;
            if (part == 0 && tid == 0) MP[bh * NCHK + c0 + i] = ms;
            cs = cs * aa + (f32x2v){bflo(cl[i]), bfhi(cl[i])} * ee; ns = ns * aa + nl[i] * ee; ms = mn;
        }
#pragma unroll
        for (int i = 0; i < 8; ++i) { cl[i] = cn[i]; nl[i] = nn[i]; }
    }
    LBAR();
}

struct M3Pre { u32x4 zq[2][4]; u32x4 vv[2]; u32x4 cc[2]; u32x4 ov[2]; float fpre, ipre, mp, nst; };
__device__ __forceinline__ void m3_fetch(const Args& a, int task, int tid, M3Pre& P) {
    const int wave = __builtin_amdgcn_readfirstlane(tid >> 6), lane = tid & 63, fr = lane & 15, fq = lane >> 4;
    unsigned char* ws = a.ws;
    const bf16* Z = (const bf16*)(ws + WS_Z); const float* gates = (const float*)(ws + WS_GATES);
    const float* MP = (const float*)(ws + WS_ML) + 2 * NTASK; const bf16* CST = (const bf16*)(ws + WS_CST); const float* NST = (const float*)(ws + WS_NST);
    const int b = task / (NHEAD * NCHK), h = (task / NCHK) % NHEAD, c = task % NCHK; const size_t row0 = (size_t)b * SEQ + c * 64;
    if (wave == 0) { P.fpre = gates[(row0 + lane) * 8 + 4 + h]; P.ipre = gates[(row0 + lane) * 8 + h]; P.mp = MP[task]; P.nst = NST[(size_t)task * 64 + lane]; }
    { const int mat = tid >> 8, l = (tid & 255) >> 2, c16 = (tid & 3) * 16;
#pragma unroll
      for (int q = 0; q < 2; ++q) conv8_fetch(Z, b, c * 64 + l, mat * 256 + h * 64 + c16 + 8 * q, P.zq[q]); }
    { const int l = tid & 63, v16 = wave * 16; const u32x4* vr = (const u32x4*)(Z + (row0 + l) * ZW + 1536 + h * 128 + v16); P.vv[0] = vr[0]; P.vv[1] = vr[1]; }
    { const int v = tid >> 2, k16 = (tid & 3) * 16; const u32x4* cr = (const u32x4*)(CST + (size_t)task * 8192 + v * 64 + k16); P.cc[0] = cr[0]; P.cc[1] = cr[1]; }
    { const int tb = wave & 3, vh = wave >> 2, t = 16 * tb + fr;
#pragma unroll
      for (int p = 0; p < 2; ++p) P.ov[p] = *(const u32x4*)(Z + (row0 + t) * ZW + 2048 + h * 128 + vh * 64 + 32 * p + 8 * fq); }
}
__device__ __forceinline__ void m3_body(const Args& a, LAS unsigned char* lds, int task, int tid, M3Pre& P, bool has_next, int next_task, M3Pre& Pn) {
    const int wave = __builtin_amdgcn_readfirstlane(tid >> 6), lane = tid & 63, fr = lane & 15, fq = lane >> 4;
    unsigned char* ws = a.ws;
    bf16* Y = (bf16*)(ws + WS_Y);
    const int b = task / (NHEAD * NCHK), h = (task / NCHK) % NHEAD, c = task % NCHK; const size_t row0 = (size_t)b * SEQ + c * 64;
    constexpr int QS = 72, PS = 136;
    LAS float* bm = (LAS float*)lds; LAS float* ib = bm + 64; LAS float* ai = bm + 128; LAS float* emt = bm + 192;
    LAS float* hs = (LAS float*)(lds + 1024);
    LAS bf16* Qs = (LAS bf16*)(lds + 2048);
    LAS bf16* Ks = (LAS bf16*)(lds + 2048 + 9216);
    LAS bf16* Ps = (LAS bf16*)(lds + 20480);
    LAS bf16* Rs = (LAS bf16*)(lds + 37888);
    if (wave == 0) {
        const float fpre = P.fpre + a.in[I_FGB][h], ipre = P.ipre + a.in[I_IGB][h];
        const float bc = scan_add(logsigmoid_f(fpre), lane), ibv = ipre - bc, cm = scan_max(ibv, lane), mp = P.mp;
        const float mx = fmaxf(mp, cm), mt = bc + mx;
        bm[lane] = -mx; ib[lane] = ibv; ai[lane] = expf(mp - mx); emt[lane] = expf(-mt);
        Rs[128 * PS + lane] = (bf16)0x3f80u; Rs[128 * PS + 64 + lane] = (bf16)f2bf(P.nst);
    }
    {
        const int mat = tid >> 8, l = (tid & 255) >> 2, c16 = (tid & 3) * 16; LAS bf16* dst = (mat ? Ks : Qs) + l * QS + c16; const float sc = mat ? 0.125f : 1.0f;
#pragma unroll
        for (int q = 0; q < 2; ++q) { float kv[8]; conv8_math(a, mat * 256 + h * 64 + c16 + 8 * q, P.zq[q], kv);
            u32x4 o; o.x = pk2(kv[0] * sc, kv[1] * sc); o.y = pk2(kv[2] * sc, kv[3] * sc); o.z = pk2(kv[4] * sc, kv[5] * sc); o.w = pk2(kv[6] * sc, kv[7] * sc);
            *(LAS u32x4*)(dst + 8 * q) = o; }
    }
    {
        const int l = tid & 63, v16 = wave * 16;
#pragma unroll
        for (int q = 0; q < 2; ++q) { const u32x4 z = P.vv[q];
#pragma unroll
            for (int j = 0; j < 4; ++j) { Rs[(v16 + 8 * q + 2 * j) * PS + l] = (bf16)(z[j] & 0xffffu); Rs[(v16 + 8 * q + 2 * j + 1) * PS + l] = (bf16)(z[j] >> 16); } }
        const int v = tid >> 2, k16 = (tid & 3) * 16;
        *(LAS u32x4*)(Rs + v * PS + 64 + k16) = P.cc[0]; *(LAS u32x4*)(Rs + v * PS + 64 + k16 + 8) = P.cc[1];
    }
    const u32x4 ov0 = P.ov[0], ov1 = P.ov[1];
    LBAR();
    if (has_next) m3_fetch(a, next_task, tid, Pn);
    f32x4 gn[2][2];
    { const int vh = wave >> 2;
#pragma unroll
      for (int p = 0; p < 2; ++p) { const int v0 = h * 128 + vh * 64 + 32 * p + 8 * fq; gn[p][0] = *(const f32x4*)(a.in[I_MHN] + v0); gn[p][1] = *(const f32x4*)(a.in[I_MHN] + v0 + 4); } }
    {
        const int tb = wave & 3, sb2 = wave >> 2, t = 16 * tb + fr; const float bmt = bm[t];
#pragma unroll
        for (int e = 0; e < 2; ++e) { const int sb = 2 * sb2 + e; u32x2 o = (u32x2){0u, 0u};
            if (sb <= tb) { f32x4 acc = (f32x4){0.f, 0.f, 0.f, 0.f};
#pragma unroll
                for (int ks = 0; ks < 2; ++ks) { const bf16x8 xf = *(const LAS bf16x8*)(Ks + (16 * sb + fr) * QS + 32 * ks + 8 * fq), yf = *(const LAS bf16x8*)(Qs + t * QS + 32 * ks + 8 * fq);
                    acc = __builtin_amdgcn_mfma_f32_16x16x32_bf16(xf, yf, acc, 0, 0, 0); }
                float w[4];
#pragma unroll
                for (int j = 0; j < 4; ++j) { const int s = 16 * sb + 4 * fq + j; w[j] = (s <= t) ? __expf(bmt + ib[s]) * acc[j] : 0.f; }
                o.x = pk2(w[0], w[1]); o.y = pk2(w[2], w[3]); }
            *(LAS u32x2*)(Ps + t * PS + 16 * sb + 4 * fq) = o; }
        const int t2 = tid >> 3, k8 = (tid & 7) * 8; const float av = ai[t2]; const u32x4 qv = *(const LAS u32x4*)(Qs + t2 * QS + k8);
        u32x4 o; o.x = pk2(bflo(qv.x) * av, bfhi(qv.x) * av); o.y = pk2(bflo(qv.y) * av, bfhi(qv.y) * av); o.z = pk2(bflo(qv.z) * av, bfhi(qv.z) * av); o.w = pk2(bflo(qv.w) * av, bfhi(qv.w) * av);
        *(LAS u32x4*)(Ps + t2 * PS + 64 + k8) = o;
    }
    LBAR();
    {
        const int tb = wave & 3, vh = wave >> 2, t = 16 * tb + fr;
        f32x4 acc[2][2], accd = (f32x4){0.f, 0.f, 0.f, 0.f};
#pragma unroll
        for (int p = 0; p < 2; ++p) { acc[p][0] = (f32x4){0.f, 0.f, 0.f, 0.f}; acc[p][1] = (f32x4){0.f, 0.f, 0.f, 0.f}; }
#pragma unroll
        for (int ks = 0; ks < 4; ++ks) { const bf16x8 yf = *(const LAS bf16x8*)(Ps + t * PS + 32 * ks + 8 * fq);
#pragma unroll
            for (int p = 0; p < 2; ++p)
#pragma unroll
                for (int n = 0; n < 2; ++n) { const int vrow = vh * 64 + 32 * p + 8 * (fr >> 2) + 4 * n + (fr & 3);
                    const bf16x8 xf = *(const LAS bf16x8*)(Rs + vrow * PS + 32 * ks + 8 * fq);
                    acc[p][n] = __builtin_amdgcn_mfma_f32_16x16x32_bf16(xf, yf, acc[p][n], 0, 0, 0); }
            const bf16x8 xd = *(const LAS bf16x8*)(Rs + 128 * PS + 32 * ks + 8 * fq);
            accd = __builtin_amdgcn_mfma_f32_16x16x32_bf16(xd, yf, accd, 0, 0, 0); }
        const float den = accd[0], inv = 1.0f / fmaxf(fabsf(den), emt[t]);
        float ssq = 0.f;
#pragma unroll
        for (int p = 0; p < 2; ++p)
#pragma unroll
            for (int n = 0; n < 2; ++n) { acc[p][n] = acc[p][n] * inv; ssq += (acc[p][n][0] * acc[p][n][0] + acc[p][n][1] * acc[p][n][1]) + (acc[p][n][2] * acc[p][n][2] + acc[p][n][3] * acc[p][n][3]); }
        ssq += __shfl_xor(ssq, 16); ssq += __shfl_xor(ssq, 32);
        if (fq == 0) hs[t * 2 + vh] = ssq;
        LBAR();
        const float rs = __builtin_amdgcn_rsqf((hs[t * 2] + hs[t * 2 + 1]) * (1.f / 128.f) + EPS);
#pragma unroll
        for (int p = 0; p < 2; ++p) { const int v0 = h * 128 + vh * 64 + 32 * p + 8 * fq;
            const u32x4 ov = p ? ov1 : ov0; const f32x4 g0 = gn[p][0], g1 = gn[p][1];
            u32x4 o;
            o.x = pk2(acc[p][0][0] * rs * g0[0] * pg8::sigmoid_f(bflo(ov.x)), acc[p][0][1] * rs * g0[1] * pg8::sigmoid_f(bfhi(ov.x)));
            o.y = pk2(acc[p][0][2] * rs * g0[2] * pg8::sigmoid_f(bflo(ov.y)), acc[p][0][3] * rs * g0[3] * pg8::sigmoid_f(bfhi(ov.y)));
            o.z = pk2(acc[p][1][0] * rs * g1[0] * pg8::sigmoid_f(bflo(ov.z)), acc[p][1][1] * rs * g1[1] * pg8::sigmoid_f(bfhi(ov.z)));
            o.w = pk2(acc[p][1][2] * rs * g1[2] * pg8::sigmoid_f(bflo(ov.w)), acc[p][1][3] * rs * g1[3] * pg8::sigmoid_f(bfhi(ov.w)));
            __builtin_nontemporal_store(o, (u32x4*)(Y + (row0 + t) * 1024 + 512 + v0)); }
    }
    LBAR();
}

#define XB_TMO      128
#define XB_XCNT(j)  (256  + 64 * (j))
#define XB_XSUB(j)  (1280 + 64 * (j))
#define XB_XGEN(j)  (2304 + 64 * (j))
#define XB_TOP      3328
#define XB_TOPGEN   3392
#define XCD_BAR_WORDS 3456
#define XB_SPIN_CAP (1u << 18)

__device__ __forceinline__ unsigned xb_ld(unsigned* p)              { return __hip_atomic_load(p, __ATOMIC_RELAXED, __HIP_MEMORY_SCOPE_AGENT); }
__device__ __forceinline__ unsigned xb_add(unsigned* p, unsigned v) { return __hip_atomic_fetch_add(p, v, __ATOMIC_RELAXED, __HIP_MEMORY_SCOPE_AGENT); }
__device__ __forceinline__ unsigned xb_xcc_id() { return (unsigned)__builtin_amdgcn_s_getreg((3 << 11) | 20) & 0xFu; }
#define XB_SPIN(cond, bar) do { unsigned _sp = 0; while (cond) { __builtin_amdgcn_s_sleep(1); \
    if ((++_sp & 255u) == 0u) { if (xb_ld(&(bar)[XB_TMO])) break; if (_sp > XB_SPIN_CAP) { atomicAdd(&(bar)[XB_TMO], 1u); break; } } } } while (0)

struct XcdBarrier {
    unsigned* bar; unsigned x;
    volatile LAS unsigned* st;
};

__device__ __forceinline__ XcdBarrier xcd_barrier_post(unsigned* bar, volatile LAS unsigned* st) {
    XcdBarrier b; b.bar = bar; b.x = xb_xcc_id(); b.st = st;
    if (threadIdx.x == 0) (void)xb_add(&bar[XB_XCNT(b.x)], 1u);
    return b;
}
__device__ __forceinline__ void xcd_barrier_complete(unsigned* bar, unsigned x, unsigned& nloc, unsigned& nx) {
    const unsigned G = gridDim.x * gridDim.y * gridDim.z;
    unsigned sum, cnt, mine, sp = 0u;
    for (;;) {
        sum = 0u; cnt = 0u; mine = 0u;
#pragma unroll
        for (unsigned j = 0; j < 16; ++j) { const unsigned c = xb_ld(&bar[XB_XCNT(j)]); sum += c; cnt += (c > 0u) ? 1u : 0u; mine = (j == x) ? c : mine; }
        if (sum == G) break;
        __builtin_amdgcn_s_sleep(1);
        if ((++sp & 255u) == 0u) { if (xb_ld(&bar[XB_TMO])) break; if (sp > XB_SPIN_CAP) { atomicAdd(&bar[XB_TMO], 1u); break; } }
    }
    nloc = mine > 0u ? mine : 1u; nx = cnt > 0u ? cnt : 1u;
}

__device__ __forceinline__ void xcd_barrier(const XcdBarrier& b) {
    asm volatile("s_waitcnt vmcnt(0)" ::: "memory");
    __syncthreads();
    if (threadIdx.x == 0) {
        unsigned* bar = b.bar;
        __builtin_amdgcn_s_waitcnt(0);
        unsigned nloc = b.st[0], nx = b.st[1];
        if (nloc == 0u) { xcd_barrier_complete(bar, b.x, nloc, nx); b.st[0] = nloc; b.st[1] = nx; }
        const unsigned old = xb_add(&bar[XB_XSUB(b.x)], 1u);
        const unsigned gen = old / nloc;
        if (old + 1u == (gen + 1u) * nloc) {
            __builtin_amdgcn_fence(__ATOMIC_RELEASE, "agent");
            asm volatile("s_waitcnt vmcnt(0)" ::: "memory");
            const unsigned og = xb_add(&bar[XB_TOP], 1u);
            const unsigned tg = og / nx;
            if (og + 1u == (tg + 1u) * nx) xb_add(&bar[XB_TOPGEN], 1u);
            else XB_SPIN(xb_ld(&bar[XB_TOPGEN]) == tg, bar);
            __builtin_amdgcn_fence(__ATOMIC_ACQUIRE, "agent");
            xb_add(&bar[XB_XGEN(b.x)], 1u);
            asm volatile("s_waitcnt vmcnt(0)" ::: "memory");
        } else {
            XB_SPIN(xb_ld(&bar[XB_XGEN(b.x)]) == gen, bar);
            __builtin_amdgcn_fence(__ATOMIC_ACQUIRE, "agent");
            asm volatile("s_waitcnt vmcnt(0)" ::: "memory");
        }
    }
    __syncthreads();
}
__global__ void __launch_bounds__(NTHR, 2) fwd_megakernel(Args args) {
    extern __shared__ __attribute__((aligned(16))) unsigned char lds_raw[];
    LAS unsigned char* lds = (LAS unsigned char*)lds_raw;
    cg::grid_group grid = cg::this_grid();
    const int tid = threadIdx.x, wave = __builtin_amdgcn_readfirstlane(tid >> 6), lane = tid & 63;
    const int G = gridDim.x, bx = blockIdx.x, vcu = (G % 8 == 0) ? (bx % 8) * (G / 8) + bx / 8 : bx;
    unsigned char* ws = args.ws;
    const int lo = args.ph_lo, hi = args.ph_hi;
#define IN(k) (lo <= (k) && (k) < hi)
#define REPS(k) ((((REP_MASK) >> (k)) & 1) ? 2 : 1)
#define SEAM(k) do { if (IN(k) && IN((k) + 1)) { if (USE_CG_SYNC) grid.sync(); else xcd_barrier(xbar); } } while (0)
    volatile LAS unsigned* MISC = (volatile LAS unsigned*)(lds + MISC_OFF);
    if (tid < 32) MISC[tid] = 0u;
    __syncthreads();
    XcdBarrier xbar = xcd_barrier_post((unsigned*)(ws + WS_CTL) + 1024, MISC + 8);
    bf16* XB = (bf16*)(ws + WS_XB); bf16* HID = (bf16*)(ws + WS_HID); bf16* Zb = (bf16*)(ws + WS_Z); bf16* Yb = (bf16*)(ws + WS_Y);
    float* RSS = (float*)(ws + WS_RSS); float* X1 = args.out;

    if (hi < 0) grid.sync();
    if (IN(0)) { for (int rep = 0; rep < REPS(0); ++rep) p0_prologue(args, lds, vcu, G, tid); } SEAM(0);
    if (REPS(12) == 2) { for (int i = 0; i < 10; ++i) grid.sync(); }
    if (IN(1)) _Pragma("unroll") for (int rep = 0; rep < REPS(1); ++rep) {
        pg8::Gemm g{XB, (const bf16*)(ws + WS_WGU1), M, NGU, D}; pg8::StaticOrder S; S.init(M, NGU, G, bx);
        pg8::EpiGU E{HID, RSS, FF};
        pg8::gemm_phase<pg8::EpiGU, pg8::StaticOrder, GEMM_ALIGN, GEMM_SP2>(lds, g, S, E);
    } SEAM(1);
    if (IN(2)) {
        pg8::Gemm g{HID, (const bf16*)(ws + WS_WD1), M, D, FF}; pg8::StaticOrder S; S.init(M, D, G, bx);
        pg8::EpiRes<false> E{args.in[I_X], XB, RSS + M, 0.5f};
        pg8::gemm_phase<pg8::EpiRes<false>, pg8::StaticOrder, GEMM_ALIGN, GEMM_SP2>(lds, g, S, E);
    } SEAM(2);
    if (IN(3)) _Pragma("unroll") for (int rep = 0; rep < REPS(3); ++rep) {
        pg8::Gemm g{XB, (const bf16*)(ws + WS_WIN), M, NINP, D}; pg8::StaticOrder S; S.init(M, NINP, G, bx);
        pg8::EpiIn E{Zb, (float*)(ws + WS_GATES), RSS + M, ZW};
        pg8::gemm_phase<pg8::EpiIn, pg8::StaticOrder, GEMM_ALIGN, GEMM_SP2>(lds, g, S, E);
    } SEAM(3);
    if (IN(4)) {
        for (int rep = 0; rep < REPS(11); ++rep) for (int ch = vcu; ch < M / 128; ch += G) sgu_chunk(args, lds, ch, tid);
        { M1Pre P, Pn; int t = vcu; if (t < NTASK) m1_fetch(args, t, tid, P);
          for (; t < NTASK; t += G) { const int tn = t + G; m1_body(args, lds, t, tid, P, tn < NTASK, tn, Pn); P = Pn; } }
    } SEAM(4);
    if (IN(5)) { for (int vb = vcu; vb < 256; vb += G) scan_block(args, lds, vb, tid); } SEAM(5);
    if (IN(6)) { M3Pre P, Pn; int t = vcu; if (t < NTASK) m3_fetch(args, t, tid, P);
        for (; t < NTASK; t += G) { const int tn = t + G; m3_body(args, lds, t, tid, P, tn < NTASK, tn, Pn); P = Pn; } } SEAM(6);
    if (IN(7)) {
        pg8::Gemm g{Yb, (const bf16*)(ws + WS_WOUT), M, D, D}; pg8::StaticOrder S; S.init(M, D, G, bx);
        pg8::EpiRes<true> E{XB, XB, RSS + 2 * M, 1.0f};
        pg8::gemm_phase<pg8::EpiRes<true>, pg8::StaticOrder, GEMM_ALIGN, GEMM_SP2>(lds, g, S, E);
    } SEAM(7);
    if (IN(8)) {
        pg8::Gemm g{XB, (const bf16*)(ws + WS_WGU2), M, NGU, D}; pg8::StaticOrder S; S.init(M, NGU, G, bx);
        pg8::EpiGU E{HID, RSS + 2 * M, FF};
        pg8::gemm_phase<pg8::EpiGU, pg8::StaticOrder, GEMM_ALIGN, GEMM_SP2>(lds, g, S, E);
    } SEAM(8);
#if FUSE_FINAL
    if (IN(9)) {
        pg8::Gemm g{HID, (const bf16*)(ws + WS_WD2), M, D, FF}; pg8::StaticOrder S; S.init(M, D, G, bx);
        pg8::EpiResNorm E{X1, X1, RSS + 3 * M, (unsigned*)(ws + WS_CTL) + 8192, args.in[I_FINALN], 0.5f};
        pg8::gemm_phase<pg8::EpiResNorm, pg8::StaticOrder, GEMM_ALIGN, GEMM_SP2>(lds, g, S, E);
    }
#else
    if (IN(9)) {
        pg8::Gemm g{HID, (const bf16*)(ws + WS_WD2), M, D, FF}; pg8::StaticOrder S; S.init(M, D, G, bx);
        pg8::EpiRes<true> E{XB, XB, RSS + 3 * M, 0.5f};
        pg8::gemm_phase<pg8::EpiRes<true>, pg8::StaticOrder, GEMM_ALIGN, GEMM_SP2>(lds, g, S, E);
    } SEAM(9);
    if (IN(10)) {
        const int gw = vcu * NWAVES + wave, NGW = G * NWAVES; const float* rss3 = RSS + 3 * M; const f32x4* gn = (const f32x4*)args.in[I_FINALN];
        const f32x4 g0 = gn[2 * lane], g1 = gn[2 * lane + 1], g2 = gn[128 + 2 * lane], g3 = gn[128 + 2 * lane + 1];
        for (int m0 = gw * 4; m0 < M; m0 += NGW * 4) {
            u32x4 v[4][2]; float r[4];
#pragma unroll
            for (int q = 0; q < 4; ++q) { const u32x4* xr = (const u32x4*)(XB + (size_t)(m0 + q) * D); v[q][0] = xr[lane]; v[q][1] = xr[64 + lane]; r[q] = rss3[m0 + q]; }
#pragma unroll
            for (int q = 0; q < 4; ++q) { const float rs = __builtin_amdgcn_rsqf(r[q] * (1.f / 1024.f) + EPS); f32x4* o = (f32x4*)(X1 + (size_t)(m0 + q) * D);
                __builtin_nontemporal_store(((f32x4){bflo(v[q][0].x), bfhi(v[q][0].x), bflo(v[q][0].y), bfhi(v[q][0].y)}) * rs * g0, o + 2 * lane);
                __builtin_nontemporal_store(((f32x4){bflo(v[q][0].z), bfhi(v[q][0].z), bflo(v[q][0].w), bfhi(v[q][0].w)}) * rs * g1, o + 2 * lane + 1);
                __builtin_nontemporal_store(((f32x4){bflo(v[q][1].x), bfhi(v[q][1].x), bflo(v[q][1].y), bfhi(v[q][1].y)}) * rs * g2, o + 128 + 2 * lane);
                __builtin_nontemporal_store(((f32x4){bflo(v[q][1].z), bfhi(v[q][1].z), bflo(v[q][1].w), bfhi(v[q][1].w)}) * rs * g3, o + 128 + 2 * lane + 1); }
        }
    }
#endif
#undef IN
#undef SEAM
}

#ifndef MK_N_LAUNCHES
#define MK_N_LAUNCHES 1
#endif
constexpr int N_PHASES = FUSE_FINAL ? 10 : 11;
extern "C" void kernel_launch(void* const* d_in, const int* in_sizes, int n_in, void* d_out, int out_size, void* d_ws, size_t ws_size, hipStream_t stream) {
    static int grid = 0;
    if (grid == 0) {
        if (n_in != 22 || in_sizes[0] != M * D || out_size != M * D || ws_size < WS_END) { fprintf(stderr, "kernel_launch: unexpected shapes (n_in %d, in0 %d, out %d, ws %zu)\n", n_in, n_in > 0 ? in_sizes[0] : -1, out_size, ws_size); grid = -1; return; }
        int dev = 0, cus = 0, per_cu = 0;
        hipGetDevice(&dev); hipDeviceGetAttribute(&cus, hipDeviceAttributeMultiprocessorCount, dev);
        hipFuncSetAttribute((const void*)fwd_megakernel, hipFuncAttributeMaxDynamicSharedMemorySize, LDS_BYTES);
        if (hipOccupancyMaxActiveBlocksPerMultiprocessor(&per_cu, (const void*)fwd_megakernel, NTHR, LDS_BYTES) != hipSuccess || per_cu < 1) { fprintf(stderr, "kernel_launch: occupancy query gave %d\n", per_cu); per_cu = 1; }
        (void)hipGetLastError();
        grid = cus * per_cu;
    }
    if (grid < 0) return;
    if (hipMemsetAsync((char*)d_ws + WS_CTL, 0, CTL_ZERO_BYTES, stream) != hipSuccess) { fprintf(stderr, "kernel_launch: memset failed\n"); return; }
    Args a{};
    for (int i = 0; i < 22; ++i) a.in[i] = (const float*)d_in[i];
    a.out = (float*)d_out; a.ws = (unsigned char*)d_ws;
#if MK_N_LAUNCHES == 1
    a.ph_lo = 0; a.ph_hi = N_PHASES;
    void* kargs[] = {&a};
    hipError_t e = hipLaunchCooperativeKernel((const void*)fwd_megakernel, dim3(grid), dim3(NTHR), kargs, LDS_BYTES, stream);
    if (e != hipSuccess) fprintf(stderr, "cooperative launch failed: %s (grid %d)\n", hipGetErrorString(e), grid);
#else
    for (int p = 0; p < N_PHASES; ++p) { a.ph_lo = p; a.ph_hi = p + 1; hipLaunchKernelGGL(fwd_megakernel, dim3(grid), dim3(NTHR), LDS_BYTES, stream, a); }
#endif
}
```

```cpp
#include <hip/hip_runtime.h>
#include <hip/hip_cooperative_groups.h>
#include <cstdio>
#include <cstdint>
namespace cg = cooperative_groups;
#ifndef REP_MASK
#define REP_MASK 0
#endif
#ifndef USE_CG_SYNC
#define USE_CG_SYNC 0
#endif
#ifndef FUSE_FINAL
#define FUSE_FINAL 0
#endif
#ifndef PG8_STGMMA
#define PG8_STGMMA 0
#endif
#ifndef GEMM_SP2
#define GEMM_SP2 true
#endif
#ifndef GEMM_ALIGN
#define GEMM_ALIGN true
#endif
namespace pg8 {
#define PG8_LAS __attribute__((address_space(3)))
typedef unsigned short bf16_t;
typedef short bf16x8 __attribute__((ext_vector_type(8)));
typedef float f32x4 __attribute__((ext_vector_type(4)));
typedef unsigned u32x4 __attribute__((ext_vector_type(4)));
constexpr int BM = 256, BK = 64, HALF = 128, HTB = HALF * BK * 2  , STAGE_BYTES = 8 * HTB, NXCD = 8, WGM = 4;

__host__ __device__ __forceinline__ int lds_byte(int r, int c) { const int st = (r >> 4) * 2 + (c >> 5), rr = r & 15, cc = c & 31, ob = rr * 64 + cc * 2; return st * 1024 + (ob ^ (((ob >> 9) & 1) << 5)); }
__host__ __device__ __forceinline__ void stage_rc(int b, int& R, int& C) { const int st = b / 1024, sb = b % 1024, swz = sb ^ (((sb >> 9) & 1) << 5); R = (st >> 1) * 16 + swz / 64; C = (st & 1) * 32 + (swz % 64) / 2; }
__host__ __device__ __forceinline__ int perm32(int rho) { const int n = rho >> 4, i = rho & 15; return 8 * (i >> 2) + 4 * n + (i & 3); }

struct Unit { int pm, pn; };
struct Gemm { const bf16_t* A; const bf16_t* Bt; int M, N, K; };

struct StaticOrder {
    int nM, nN, nwg, G, c;
    __host__ __device__ void init(int M, int N, int G_, int c_) { nM = M / BM; nN = N / BM; nwg = nM * nN; G = G_; c = c_; }
    __host__ __device__ bool next(int i, Unit& u) const {
        const long L = (long)i * G + c; if (L >= nwg) return false;
        int wgid = (int)L; { const int q = nwg / NXCD, r = nwg % NXCD, xcd = wgid % NXCD, off = wgid / NXCD; wgid = (xcd < r ? xcd * (q + 1) : r * (q + 1) + (xcd - r) * q) + off; }
        const int nig = WGM * nN, gid = wgid / nig, fm = gid * WGM, gsz = (nM - fm) < WGM ? (nM - fm) : WGM;
        u.pm = fm + ((wgid % nig) % gsz); u.pn = (wgid % nig) / gsz; return true;
    }
    __device__ __forceinline__ void a_ready(const Unit&) const {}
    __device__ __forceinline__ void done(const Unit&) const {}
};

__device__ __forceinline__ unsigned cvt_pk_bf16(float lo, float hi) { unsigned r; asm volatile("v_cvt_pk_bf16_f32 %0, %1, %2" : "=v"(r) : "v"(lo), "v"(hi)); return r; }
typedef float f32x2 __attribute__((ext_vector_type(2)));
__device__ __forceinline__ float silu_f(float g) { return g * __builtin_amdgcn_rcpf(1.0f + __builtin_amdgcn_exp2f(-1.44269504f * g)); }
__device__ __forceinline__ float sigmoid_f(float g) { return __builtin_amdgcn_rcpf(1.0f + __builtin_amdgcn_exp2f(-1.44269504f * g)); }
__device__ __forceinline__ float gelu_tanh_f(float x) { const float t = x * (1.0f + 0.044715f * x * x); return x * __builtin_amdgcn_rcpf(1.0f + __builtin_amdgcn_exp2f(-2.302208198f * t)); }
__device__ __forceinline__ float row_rs(const float* rowss, int row) { return __builtin_amdgcn_rsqf(rowss[row] * (1.0f / 1024.0f) + 1e-6f); }

struct EpiGU {
    static constexpr bool PERM = true, AFTER_DRAIN = false;
    bf16_t* H; const float* rowss; int ldh;
    __device__ __forceinline__ void prefetch(const Unit& u, int wr, int fr, float (&pre)[8]) const {
        const int row0 = u.pm * BM + wr * 64 + fr;
#pragma unroll
        for (int i = 0; i < 8; ++i) pre[i] = rowss[row0 + (i >> 2) * HALF + (i & 3) * 16];
    }
    __device__ __forceinline__ void operator()(const f32x4 (&acc)[2][2][4][2], const Unit& u, int wr, int wc, int fr, int fq, const float (&pre)[8]) const {
        const int row0 = u.pm * BM + wr * 64 + fr, col0 = u.pn * 128 + wc * 32 + 8 * fq;
        float rr[2][4];
#pragma unroll
        for (int ai = 0; ai < 2; ++ai)
#pragma unroll
            for (int m = 0; m < 4; ++m) rr[ai][m] = pre[ai * 4 + m];
#pragma unroll
        for (int ai = 0; ai < 2; ++ai)
#pragma unroll
            for (int m = 0; m < 4; ++m) {
                const int row = row0 + ai * HALF + m * 16; const float r = __builtin_amdgcn_rsqf(rr[ai][m] * (1.0f / 1024.0f) + 1e-6f), rn = -1.44269504f * r, r2 = r * r;
                unsigned w[4];
#pragma unroll
                for (int n = 0; n < 2; ++n)
#pragma unroll
                    for (int j = 0; j < 2; ++j) {
                        const f32x2 g = (f32x2){acc[ai][0][m][n][2 * j], acc[ai][0][m][n][2 * j + 1]}, uu = (f32x2){acc[ai][1][m][n][2 * j], acc[ai][1][m][n][2 * j + 1]};
                        const f32x2 t = g * rn; f32x2 e; e.x = __builtin_amdgcn_exp2f(t.x); e.y = __builtin_amdgcn_exp2f(t.y);
                        const f32x2 d = e + 1.0f; f32x2 sg; sg.x = __builtin_amdgcn_rcpf(d.x); sg.y = __builtin_amdgcn_rcpf(d.y);
                        const f32x2 h = ((g * uu) * r2) * sg;
                        w[n * 2 + j] = cvt_pk_bf16(h.x, h.y);
                    }
                u32x4 wv; wv.x = w[0]; wv.y = w[1]; wv.z = w[2]; wv.w = w[3];
                __builtin_nontemporal_store(wv, (u32x4*)(H + (size_t)row * ldh + col0));
            }
    }
};
template <bool BASE_BF16> struct EpiRes {
    static constexpr bool PERM = true, AFTER_DRAIN = false;
    const void* base; bf16_t* outb; float* rowss_out; float scale;
    __device__ __forceinline__ void prefetch(const Unit&, int, int, float (&)[8]) const {}
    __device__ __forceinline__ void operator()(const f32x4 (&acc)[2][2][4][2], const Unit& u, int wr, int wc, int fr, int fq, const float (&)[8]) const {
        const int row0 = u.pm * BM + wr * 64 + fr, col0 = u.pn * BM + wc * 32 + 8 * fq;
#pragma unroll
        for (int ai = 0; ai < 2; ++ai)
#pragma unroll
            for (int m = 0; m < 4; ++m) {
                const int row = row0 + ai * HALF + m * 16; float ss = 0.f;
#pragma unroll
                for (int bj = 0; bj < 2; ++bj) {
                    const size_t off = (size_t)row * 1024 + col0 + bj * HALF;
                    f32x4 b0, b1;
                    if (BASE_BF16) { const u32x4 bb = *(const u32x4*)((const bf16_t*)base + off);
                        b0 = (f32x4){__builtin_bit_cast(float, bb.x << 16), __builtin_bit_cast(float, bb.x & 0xffff0000u), __builtin_bit_cast(float, bb.y << 16), __builtin_bit_cast(float, bb.y & 0xffff0000u)};
                        b1 = (f32x4){__builtin_bit_cast(float, bb.z << 16), __builtin_bit_cast(float, bb.z & 0xffff0000u), __builtin_bit_cast(float, bb.w << 16), __builtin_bit_cast(float, bb.w & 0xffff0000u)}; }
                    else { b0 = *(const f32x4*)((const float*)base + off); b1 = *(const f32x4*)((const float*)base + off + 4); }
                    const f32x4 v0 = b0 + acc[ai][bj][m][0] * scale, v1 = b1 + acc[ai][bj][m][1] * scale;
                    u32x4 w; w.x = cvt_pk_bf16(v0[0], v0[1]); w.y = cvt_pk_bf16(v0[2], v0[3]); w.z = cvt_pk_bf16(v1[0], v1[1]); w.w = cvt_pk_bf16(v1[2], v1[3]); *(u32x4*)(outb + off) = w;
                    ss += (v0[0] * v0[0] + v0[1] * v0[1]) + (v0[2] * v0[2] + v0[3] * v0[3]) + (v1[0] * v1[0] + v1[1] * v1[1]) + (v1[2] * v1[2] + v1[3] * v1[3]);
                }
                ss += __shfl_xor(ss, 16); ss += __shfl_xor(ss, 32);
                if (fq == 0) __hip_atomic_fetch_add(rowss_out + row, ss, __ATOMIC_RELAXED, __HIP_MEMORY_SCOPE_AGENT);
            }
    }
};
struct EpiResNorm {
    static constexpr bool PERM = true, AFTER_DRAIN = false;
    const float* base; float* out; float* rowss; unsigned* cnt; const float* gain; float scale;
    __device__ __forceinline__ void prefetch(const Unit&, int, int, float (&)[8]) const {}
    __device__ __forceinline__ void operator()(f32x4 (&acc)[2][2][4][2], const Unit& u, int wr, int wc, int fr, int fq, const float (&)[8]) const {
        const int row0 = u.pm * BM + wr * 64 + fr, col0 = u.pn * BM + wc * 32 + 8 * fq;
#pragma unroll
        for (int ai = 0; ai < 2; ++ai)
#pragma unroll
            for (int m = 0; m < 4; ++m) {
                const int row = row0 + ai * HALF + m * 16; float ss = 0.f;
#pragma unroll
                for (int bj = 0; bj < 2; ++bj) {
                    const size_t off = (size_t)row * 1024 + col0 + bj * HALF;
                    const f32x4 b0 = *(const f32x4*)(base + off), b1 = *(const f32x4*)(base + off + 4);
                    const f32x4 v0 = b0 + acc[ai][bj][m][0] * scale, v1 = b1 + acc[ai][bj][m][1] * scale;
                    acc[ai][bj][m][0] = v0; acc[ai][bj][m][1] = v1;
                    ss += (v0[0] * v0[0] + v0[1] * v0[1]) + (v0[2] * v0[2] + v0[3] * v0[3]) + (v1[0] * v1[0] + v1[1] * v1[1]) + (v1[2] * v1[2] + v1[3] * v1[3]);
                }
                ss += __shfl_xor(ss, 16); ss += __shfl_xor(ss, 32);
                if (fq == 0) __hip_atomic_fetch_add(rowss + row, ss, __ATOMIC_RELAXED, __HIP_MEMORY_SCOPE_AGENT);
            }
        asm volatile("s_waitcnt vmcnt(0)" ::: "memory");
        unsigned* c = cnt + 16 * u.pm;
        if (fr == 0 && fq == 0) __hip_atomic_fetch_add(c, 1u, __ATOMIC_RELAXED, __HIP_MEMORY_SCOPE_AGENT);
        { unsigned sp = 0;
          while ((unsigned)__builtin_amdgcn_readfirstlane(__hip_atomic_load(c, __ATOMIC_RELAXED, __HIP_MEMORY_SCOPE_AGENT)) < 32u) { __builtin_amdgcn_s_sleep(1); if (++sp > (1u << 22)) break; } }
        __builtin_amdgcn_fence(__ATOMIC_ACQUIRE, "agent");
#pragma unroll
        for (int ai = 0; ai < 2; ++ai)
#pragma unroll
            for (int m = 0; m < 4; ++m) {
                const int row = row0 + ai * HALF + m * 16;
                const float r = __builtin_amdgcn_rsqf(__hip_atomic_load(rowss + row, __ATOMIC_RELAXED, __HIP_MEMORY_SCOPE_AGENT) * (1.0f / 1024.0f) + 1e-6f);
#pragma unroll
                for (int bj = 0; bj < 2; ++bj) {
                    const int col = col0 + bj * HALF; const size_t off = (size_t)row * 1024 + col;
                    const f32x4 g0 = *(const f32x4*)(gain + col), g1 = *(const f32x4*)(gain + col + 4);
                    *(f32x4*)(out + off) = acc[ai][bj][m][0] * r * g0; *(f32x4*)(out + off + 4) = acc[ai][bj][m][1] * r * g1;
                }
            }
    }
};
struct EpiIn {
    static constexpr bool PERM = true, AFTER_DRAIN = false;
    bf16_t* Z; float* gates; const float* rowss; int ldz;
    __device__ __forceinline__ void prefetch(const Unit& u, int wr, int fr, float (&pre)[8]) const {
        const int row0 = u.pm * BM + wr * 64 + fr;
#pragma unroll
        for (int i = 0; i < 8; ++i) pre[i] = rowss[row0 + (i >> 2) * HALF + (i & 3) * 16];
    }
    __device__ __forceinline__ void operator()(const f32x4 (&acc)[2][2][4][2], const Unit& u, int wr, int wc, int fr, int fq, const float (&pre)[8]) const {
        const int row0 = u.pm * BM + wr * 64 + fr, col0 = u.pn * BM + wc * 32 + 8 * fq;
        if (u.pn == 10) {
            if (wc == 0 && fq == 0) {
#pragma unroll
                for (int ai = 0; ai < 2; ++ai)
#pragma unroll
                    for (int m = 0; m < 4; ++m) {
                        const int row = row0 + ai * HALF + m * 16; const float r = __builtin_amdgcn_rsqf(pre[ai * 4 + m] * (1.0f / 1024.0f) + 1e-6f);
                        *(f32x4*)(gates + (size_t)row * 8) = acc[ai][0][m][0] * r; *(f32x4*)(gates + (size_t)row * 8 + 4) = acc[ai][0][m][1] * r;
                    }
            }
            return;
        }
        const bool act = u.pn < 4;
#pragma unroll
        for (int ai = 0; ai < 2; ++ai)
#pragma unroll
            for (int m = 0; m < 4; ++m) {
                const int row = row0 + ai * HALF + m * 16; const float r = __builtin_amdgcn_rsqf(pre[ai * 4 + m] * (1.0f / 1024.0f) + 1e-6f);
#pragma unroll
                for (int bj = 0; bj < 2; ++bj) {
                    f32x4 v0 = acc[ai][bj][m][0] * r, v1 = acc[ai][bj][m][1] * r;
                    if (act) {
#pragma unroll
                        for (int j = 0; j < 2; ++j) {
                            f32x2 x0 = (f32x2){v0[2 * j], v0[2 * j + 1]}, x1 = (f32x2){v1[2 * j], v1[2 * j + 1]};
                            const f32x2 t0 = (x0 * x0 * 0.044715f + 1.0f) * x0 * (-2.302208198f), t1 = (x1 * x1 * 0.044715f + 1.0f) * x1 * (-2.302208198f);
                            f32x2 e0, e1; e0.x = __builtin_amdgcn_exp2f(t0.x); e0.y = __builtin_amdgcn_exp2f(t0.y); e1.x = __builtin_amdgcn_exp2f(t1.x); e1.y = __builtin_amdgcn_exp2f(t1.y);
                            e0 = e0 + 1.0f; e1 = e1 + 1.0f;
                            v0[2 * j] = x0.x * __builtin_amdgcn_rcpf(e0.x); v0[2 * j + 1] = x0.y * __builtin_amdgcn_rcpf(e0.y); v1[2 * j] = x1.x * __builtin_amdgcn_rcpf(e1.x); v1[2 * j + 1] = x1.y * __builtin_amdgcn_rcpf(e1.y);
                        }
                    }
                    u32x4 w; w.x = cvt_pk_bf16(v0[0], v0[1]); w.y = cvt_pk_bf16(v0[2], v0[3]); w.z = cvt_pk_bf16(v1[0], v1[1]); w.w = cvt_pk_bf16(v1[2], v1[3]);
                    __builtin_nontemporal_store(w, (u32x4*)(Z + (size_t)row * ldz + col0 + bj * HALF));
                }
            }
    }
};

template <class Epi, class Sched, bool ALIGN_EPI = false, bool SP2 = false>
__device__ __forceinline__ void gemm_phase(PG8_LAS unsigned char* lds, const Gemm g, const Sched& S, const Epi& E) {
    const int tid = threadIdx.x, wid = __builtin_amdgcn_readfirstlane(tid >> 6), lane = tid & 63, wr = wid >> 2, wc = wid & 3, fr = lane & 15, fq = lane >> 4;
    const int K = g.K, nt = K / BK;
    unsigned voffA[2], voffB[2];
#pragma unroll
    for (int i = 0; i < 2; ++i) { int R, C; stage_rc(tid * 16 + i * 8192, R, C); const int Rb = Epi::PERM ? ((R & ~31) + perm32(R & 31)) : R;
        voffA[i] = (unsigned)(R * K + C) * 2u; voffB[i] = (unsigned)(Rb * K + C) * 2u; }
    const size_t kstep = (size_t)(BK * 2);
    const size_t hstep = (size_t)HALF * K * 2;
    const size_t tstep = 2 * hstep;
    const unsigned ldsw = (unsigned)wid * 1024u;
    const int aoff = lds_byte(wr * 64 + fr, fq * 8), boff = lds_byte(wc * 32 + fr, fq * 8);
#define PG8_SA(b, h) (((b) * 2 + (h)) * HTB)
#define PG8_SB(b, h) ((4 + (b) * 2 + (h)) * HTB)
#define PG8_STAGE(bufoff, gbase, voff) do { _Pragma("unroll") for (int _i = 0; _i < 2; ++_i) \
        __builtin_amdgcn_global_load_lds((const unsigned*)((const char*)(gbase) + (voff)[_i]), (PG8_LAS unsigned*)(lds + (bufoff) + ldsw + _i * 8192), 16, 0, 0); } while (0)
#define PG8_LDA(dst, b, h) do { _Pragma("unroll") for (int m = 0; m < 4; ++m) _Pragma("unroll") for (int k = 0; k < 2; ++k) dst[m][k] = *(const PG8_LAS bf16x8*)(lds + PG8_SA(b, h) + aoff + m * 2048 + k * 1024); } while (0)
#define PG8_LDB(dst, b, h) do { _Pragma("unroll") for (int n = 0; n < 2; ++n) _Pragma("unroll") for (int k = 0; k < 2; ++k) dst[n][k] = *(const PG8_LAS bf16x8*)(lds + PG8_SB(b, h) + boff + n * 2048 + k * 1024); } while (0)
#define PG8_MMA(ai, bj, At, Bt) do { __builtin_amdgcn_s_setprio(1); _Pragma("unroll") for (int m = 0; m < 4; ++m) _Pragma("unroll") for (int n = 0; n < 2; ++n) _Pragma("unroll") for (int k = 0; k < 2; ++k) \
        acc[ai][bj][m][n] = __builtin_amdgcn_mfma_f32_16x16x32_bf16(Bt[n][k], At[m][k], acc[ai][bj][m][n], 0, 0, 0); __builtin_amdgcn_s_setprio(0); } while (0)
#define PG8_STAGE1(bufoff, gbase, voff, i) __builtin_amdgcn_global_load_lds((const unsigned*)((const char*)(gbase) + (voff)[i]), (PG8_LAS unsigned*)(lds + (bufoff) + ldsw + (i) * 8192), 16, 0, 0)
#define PG8_MMAQ(ai, bj, At, Bt, m) do { _Pragma("unroll") for (int n = 0; n < 2; ++n) _Pragma("unroll") for (int k = 0; k < 2; ++k) \
        acc[ai][bj][m][n] = __builtin_amdgcn_mfma_f32_16x16x32_bf16(Bt[n][k], At[m][k], acc[ai][bj][m][n], 0, 0, 0); } while (0)
#define PG8_M1(At, B0, B1, bufoff, gbase, voff) do { __builtin_amdgcn_s_setprio(1); \
        PG8_MMAQ(0, 0, At, B0, 0); PG8_MMAQ(0, 0, At, B0, 1); PG8_SCHED; PG8_STAGE1(bufoff, gbase, voff, 0); PG8_SCHED; \
        PG8_MMAQ(0, 0, At, B0, 2); PG8_MMAQ(0, 0, At, B0, 3); PG8_SCHED; PG8_STAGE1(bufoff, gbase, voff, 1); PG8_SCHED; \
        PG8_MMAQ(0, 1, At, B1, 0); PG8_MMAQ(0, 1, At, B1, 1); PG8_MMAQ(0, 1, At, B1, 2); PG8_MMAQ(0, 1, At, B1, 3); __builtin_amdgcn_s_setprio(0); } while (0)
#define PG8_M2(At, B0, B1, o0, g0, v0, o1, g1, v1, o2, g2, v2) do { __builtin_amdgcn_s_setprio(1); \
        PG8_MMAQ(1, 0, At, B0, 0); PG8_SCHED; PG8_STAGE1(o0, g0, v0, 0); PG8_SCHED; PG8_MMAQ(1, 0, At, B0, 1); PG8_SCHED; PG8_STAGE1(o0, g0, v0, 1); PG8_SCHED; \
        PG8_MMAQ(1, 0, At, B0, 2); PG8_SCHED; PG8_STAGE1(o1, g1, v1, 0); PG8_SCHED; PG8_MMAQ(1, 0, At, B0, 3); PG8_SCHED; PG8_STAGE1(o1, g1, v1, 1); PG8_SCHED; \
        PG8_MMAQ(1, 1, At, B1, 0); PG8_SCHED; PG8_STAGE1(o2, g2, v2, 0); PG8_SCHED; PG8_MMAQ(1, 1, At, B1, 1); PG8_SCHED; PG8_STAGE1(o2, g2, v2, 1); PG8_SCHED; \
        PG8_MMAQ(1, 1, At, B1, 2); PG8_MMAQ(1, 1, At, B1, 3); __builtin_amdgcn_s_setprio(0); } while (0)
#define PG8_WAIT_V(n) asm volatile("s_waitcnt vmcnt(" #n ")" ::: "memory")
#define PG8_WAIT_L(n) asm volatile("s_waitcnt lgkmcnt(" #n ")" ::: "memory")
#define PG8_BAR __builtin_amdgcn_s_barrier()
#define PG8_SCHED __builtin_amdgcn_sched_barrier(0)
    Unit cur, nxt; int ui = 0;
    if (!S.next(0, cur)) return;
    float pre[8]; E.prefetch(cur, wr, fr, pre);
    f32x4 acc[2][2][4][2];
#pragma unroll
    for (int a = 0; a < 2; ++a)
#pragma unroll
        for (int b = 0; b < 2; ++b)
#pragma unroll
            for (int m = 0; m < 4; ++m)
#pragma unroll
                for (int n = 0; n < 2; ++n) acc[a][b][m][n] = (f32x4){0.f, 0.f, 0.f, 0.f};
    bf16x8 At[4][2], B0[2][2], B1[2][2];
    const char* cA = (const char*)g.A + (size_t)cur.pm * tstep; const char* cB = (const char*)g.Bt + (size_t)cur.pn * tstep;
    S.a_ready(cur);
    if constexpr (SP2) {
        PG8_STAGE(PG8_SB(0, 0), cB, voffB); PG8_STAGE(PG8_SB(0, 1), cB + hstep, voffB); PG8_STAGE(PG8_SA(0, 0), cA, voffA); PG8_STAGE(PG8_SA(0, 1), cA + hstep, voffA);
        if (wr == 1) PG8_BAR;
        PG8_WAIT_V(2); PG8_BAR;
        PG8_STAGE(PG8_SB(1, 0), cB + kstep, voffB); PG8_STAGE(PG8_SA(1, 0), cA + kstep, voffA); PG8_STAGE(PG8_SB(1, 1), cB + hstep + kstep, voffB);
        PG8_WAIT_V(6); PG8_BAR;
    } else {
        PG8_STAGE(PG8_SB(0, 0), cB, voffB); PG8_STAGE(PG8_SA(0, 0), cA, voffA); PG8_STAGE(PG8_SB(0, 1), cB + hstep, voffB); PG8_STAGE(PG8_SA(0, 1), cA + hstep, voffA);
        if (wr == 1) PG8_BAR;
        PG8_WAIT_V(4); PG8_BAR;
        PG8_STAGE(PG8_SB(1, 0), cB + kstep, voffB); PG8_STAGE(PG8_SA(1, 0), cA + kstep, voffA); PG8_STAGE(PG8_SB(1, 1), cB + hstep + kstep, voffB);
        PG8_WAIT_V(6); PG8_BAR;
    }
    for (;;) {
        const bool has_next = S.next(ui + 1, nxt);
        const char* nA = has_next ? (const char*)g.A + (size_t)nxt.pm * tstep : cA; const char* nB = has_next ? (const char*)g.Bt + (size_t)nxt.pn * tstep : cB;
        for (int t = 0; t < nt; t += 2) {
            const bool last = (t == nt - 2);
            const char* a1 = cA + (size_t)(t + 1) * kstep;
            const char* a2 = last ? nA : cA + (size_t)(t + 2) * kstep; const char* b2 = last ? nB : cB + (size_t)(t + 2) * kstep;
            const char* a3 = a2 + kstep; const char* b3 = b2 + kstep;
            if (last && has_next) S.a_ready(nxt);
            if constexpr (SP2) {
#if PG8_STGMMA
            PG8_LDB(B0, 0, 0); PG8_LDB(B1, 0, 1); PG8_SCHED; PG8_LDA(At, 0, 0);
            PG8_WAIT_V(6); PG8_WAIT_L(0); PG8_BAR; PG8_M1(At, B0, B1, PG8_SA(1, 1), a1 + hstep, voffA); PG8_BAR; PG8_SCHED;
            PG8_LDA(At, 0, 1);
            PG8_WAIT_V(2); PG8_WAIT_L(0); PG8_BAR; PG8_M2(At, B0, B1, PG8_SB(0, 0), b2, voffB, PG8_SB(0, 1), b2 + hstep, voffB, PG8_SA(0, 0), a2, voffA); PG8_BAR; PG8_SCHED;
            PG8_LDB(B0, 1, 0); PG8_LDB(B1, 1, 1); PG8_SCHED; PG8_LDA(At, 1, 0);
            PG8_WAIT_V(6); PG8_WAIT_L(0); PG8_BAR; PG8_M1(At, B0, B1, PG8_SA(0, 1), a2 + hstep, voffA); PG8_BAR; PG8_SCHED;
            PG8_LDA(At, 1, 1);
            PG8_WAIT_V(2); PG8_WAIT_L(0); PG8_BAR; PG8_M2(At, B0, B1, PG8_SB(1, 0), b3, voffB, PG8_SB(1, 1), b3 + hstep, voffB, PG8_SA(1, 0), a3, voffA); PG8_BAR; PG8_SCHED;
#else
            PG8_LDB(B0, 0, 0); PG8_LDB(B1, 0, 1); PG8_SCHED; PG8_LDA(At, 0, 0); PG8_STAGE(PG8_SA(1, 1), a1 + hstep, voffA);
            PG8_WAIT_V(8); PG8_WAIT_L(0); PG8_BAR; PG8_MMA(0, 0, At, B0); PG8_MMA(0, 1, At, B1); PG8_BAR; PG8_SCHED;
            PG8_LDA(At, 0, 1); PG8_STAGE(PG8_SB(0, 0), b2, voffB); PG8_STAGE(PG8_SB(0, 1), b2 + hstep, voffB); PG8_STAGE(PG8_SA(0, 0), a2, voffA);
            PG8_WAIT_V(8); PG8_WAIT_L(0); PG8_BAR; PG8_MMA(1, 0, At, B0); PG8_MMA(1, 1, At, B1); PG8_BAR; PG8_SCHED;
            PG8_LDB(B0, 1, 0); PG8_LDB(B1, 1, 1); PG8_SCHED; PG8_LDA(At, 1, 0); PG8_STAGE(PG8_SA(0, 1), a2 + hstep, voffA);
            PG8_WAIT_V(8); PG8_WAIT_L(0); PG8_BAR; PG8_MMA(0, 0, At, B0); PG8_MMA(0, 1, At, B1); PG8_BAR; PG8_SCHED;
            PG8_LDA(At, 1, 1); PG8_STAGE(PG8_SB(1, 0), b3, voffB); PG8_STAGE(PG8_SB(1, 1), b3 + hstep, voffB); PG8_STAGE(PG8_SA(1, 0), a3, voffA);
            PG8_WAIT_V(8); PG8_WAIT_L(0); PG8_BAR; PG8_MMA(1, 0, At, B0); PG8_MMA(1, 1, At, B1); PG8_BAR; PG8_SCHED;
#endif
            } else {
            PG8_LDB(B0, 0, 0); PG8_SCHED; PG8_LDA(At, 0, 0); PG8_STAGE(PG8_SA(1, 1), a1 + hstep, voffA);
            PG8_WAIT_L(8); PG8_BAR; PG8_WAIT_L(0); PG8_MMA(0, 0, At, B0); PG8_BAR; PG8_SCHED;
            PG8_LDB(B1, 0, 1); PG8_STAGE(PG8_SB(0, 0), b2, voffB);
            PG8_BAR; PG8_WAIT_L(0); PG8_MMA(0, 1, At, B1); PG8_BAR;
            PG8_LDA(At, 0, 1); PG8_STAGE(PG8_SA(0, 0), a2, voffA);
            PG8_BAR; PG8_WAIT_L(0); PG8_MMA(1, 0, At, B0); PG8_BAR; PG8_SCHED;
            PG8_STAGE(PG8_SB(0, 1), b2 + hstep, voffB);
            PG8_WAIT_V(6); PG8_BAR; PG8_MMA(1, 1, At, B1); PG8_BAR;
            PG8_LDB(B0, 1, 0); PG8_SCHED; PG8_LDA(At, 1, 0); PG8_STAGE(PG8_SA(0, 1), a2 + hstep, voffA);
            PG8_WAIT_L(8); PG8_BAR; PG8_WAIT_L(0); PG8_MMA(0, 0, At, B0); PG8_BAR; PG8_SCHED;
            PG8_LDB(B1, 1, 1); PG8_STAGE(PG8_SB(1, 0), b3, voffB);
            PG8_BAR; PG8_WAIT_L(0); PG8_MMA(0, 1, At, B1); PG8_BAR;
            PG8_LDA(At, 1, 1); PG8_STAGE(PG8_SA(1, 0), a3, voffA);
            PG8_BAR; PG8_WAIT_L(0); PG8_MMA(1, 0, At, B0); PG8_BAR; PG8_SCHED;
            PG8_STAGE(PG8_SB(1, 1), b3 + hstep, voffB);
            PG8_WAIT_V(6); PG8_BAR; PG8_MMA(1, 1, At, B1); PG8_BAR;
            }
        }
        if constexpr (ALIGN_EPI) { if (wr == 0) PG8_BAR; }
        if constexpr (!Epi::AFTER_DRAIN) { E(acc, cur, wr, wc, fr, fq, pre); S.done(cur); }
        if (!has_next) break;
#pragma unroll
        for (int a = 0; a < 2; ++a)
#pragma unroll
            for (int b = 0; b < 2; ++b)
#pragma unroll
                for (int m = 0; m < 4; ++m)
#pragma unroll
                    for (int n = 0; n < 2; ++n) acc[a][b][m][n] = (f32x4){0.f, 0.f, 0.f, 0.f};
        cur = nxt; cA = nA; cB = nB; ++ui;
        E.prefetch(cur, wr, fr, pre);
        if constexpr (ALIGN_EPI) { if (wr == 1) PG8_BAR; }
    }
    PG8_WAIT_V(0);
    if constexpr (!ALIGN_EPI) { if (wr == 0) PG8_BAR; }
    PG8_BAR;
    if constexpr (Epi::AFTER_DRAIN) { E.fused(acc, cur, wr, wc, fr, fq, lds, wid, lane); S.done(cur); }
#undef PG8_SA
#undef PG8_SB
#undef PG8_STAGE
#undef PG8_LDA
#undef PG8_LDB
#undef PG8_MMA
#undef PG8_MMAQ
#undef PG8_M1
#undef PG8_M2
#undef PG8_STAGE1
#undef PG8_WAIT_V
#undef PG8_WAIT_L
#undef PG8_BAR
#undef PG8_SCHED
}
}

constexpr int NWAVES = 8, NTHR = 512;
constexpr int BATCH = 8, SEQ = 8192, D = 1024, M = BATCH * SEQ, FF = 2816, NGU = 2 * FF, NIN = 2568, NINP = 2816, ZW = 2560, NCHK = SEQ / 64, NHEAD = 4;
constexpr int NTASK = BATCH * NHEAD * NCHK;
constexpr float EPS = 1e-6f;
constexpr size_t MiB = 1u << 20;
constexpr size_t WS_WGU1 = 2 * MiB, WS_WD1 = 13 * MiB, WS_WIN = 19 * MiB, WS_WOUT = 25 * MiB, WS_WGU2 = 27 * MiB, WS_WD2 = 38 * MiB, WS_SGUW = 44 * MiB;
constexpr size_t WS_RSS = 45 * MiB, WS_GATES = 46 * MiB, WS_ML = 48 * MiB, WS_NST = 49 * MiB;
constexpr size_t WS_XB = 64 * MiB, WS_HID = 192 * MiB, WS_Z = 192 * MiB, WS_Y = 544 * MiB, WS_CST = 672 * MiB, WS_END = 800 * MiB;
constexpr int LDS_BYTES = 147456, MISC_OFF = LDS_BYTES - 128;
constexpr size_t WS_CTL = 0, CTL_ZERO_BYTES = 65536;

#define LAS __attribute__((address_space(3)))
typedef unsigned short bf16;
typedef unsigned u32x4 __attribute__((ext_vector_type(4)));
typedef unsigned u32x2 __attribute__((ext_vector_type(2)));
typedef float f32x4 __attribute__((ext_vector_type(4)));
typedef short bf16x8 __attribute__((ext_vector_type(8)));
#define LDS_WAIT() asm volatile("s_waitcnt lgkmcnt(0)" ::: "memory")
#define LBAR() do { asm volatile("s_waitcnt lgkmcnt(0)" ::: "memory"); __builtin_amdgcn_s_barrier(); asm volatile("" ::: "memory"); } while (0)
__device__ __forceinline__ unsigned f2bf(float f) { unsigned u = __builtin_bit_cast(unsigned, f); return (u + 0x7fffu + ((u >> 16) & 1u)) >> 16; }
__device__ __forceinline__ unsigned pk2(float lo, float hi) { return f2bf(lo) | (f2bf(hi) << 16); }
__device__ __forceinline__ float bflo(unsigned w) { return __builtin_bit_cast(float, w << 16); }
__device__ __forceinline__ float bfhi(unsigned w) { return __builtin_bit_cast(float, w & 0xffff0000u); }
__device__ __forceinline__ float wave_sum(float v) {
#pragma unroll
    for (int o = 1; o < 64; o <<= 1) v += __shfl_xor(v, o);
    return v;
}
__device__ __forceinline__ float wave_max(float v) {
#pragma unroll
    for (int o = 1; o < 64; o <<= 1) v = fmaxf(v, __shfl_xor(v, o));
    return v;
}
template <int CTRL, int ROWMASK> __device__ __forceinline__ float dpp_mov(float ident, float src) {
    return __builtin_bit_cast(float, __builtin_amdgcn_update_dpp(__builtin_bit_cast(int, ident), __builtin_bit_cast(int, src), CTRL, ROWMASK, 0xf, false));
}
__device__ __forceinline__ float scan_add(float v, int) {
    v += dpp_mov<0x111, 0xf>(0.f, v); v += dpp_mov<0x112, 0xf>(0.f, v); v += dpp_mov<0x114, 0xf>(0.f, v); v += dpp_mov<0x118, 0xf>(0.f, v);
    v += dpp_mov<0x142, 0xa>(0.f, v); v += dpp_mov<0x143, 0xc>(0.f, v);
    return v;
}
__device__ __forceinline__ float scan_max(float v, int) {
    const float ninf = -__builtin_inff();
    v = fmaxf(v, dpp_mov<0x111, 0xf>(ninf, v)); v = fmaxf(v, dpp_mov<0x112, 0xf>(ninf, v)); v = fmaxf(v, dpp_mov<0x114, 0xf>(ninf, v)); v = fmaxf(v, dpp_mov<0x118, 0xf>(ninf, v));
    v = fmaxf(v, dpp_mov<0x142, 0xa>(ninf, v)); v = fmaxf(v, dpp_mov<0x143, 0xc>(ninf, v));
    return v;
}
__device__ __forceinline__ float logsigmoid_f(float x) { const float e = __expf(-fabsf(x)); return fminf(x, 0.f) - ((e < 1e-4f) ? e * (1.0f - 0.5f * e) : __logf(1.0f + e)); }

struct Args {
    const float* in[22]; float* out; unsigned char* ws; int ph_lo, ph_hi;
};
enum { I_X = 0, I_N1, I_G1, I_U1, I_D1, I_MIXN, I_WIN, I_LNG, I_LNB, I_SGUW, I_SGUB, I_CONVW, I_CONVB, I_IGB, I_FGB, I_MHN, I_WOUT, I_N2, I_G2, I_U2, I_D2, I_FINALN };

__device__ __forceinline__ void tr_item(const float* __restrict__ W, int K, int N, const float* __restrict__ gain, bf16* WT, int drow0, int k0, int n0, LAS float* scr, int lane) {
    const int kk8 = lane >> 3, c4 = (lane & 7) * 4; const bool ok = (n0 + c4) < N;
    f32x4 v[8];
#pragma unroll
    for (int i = 0; i < 8; ++i) { const int kk = 8 * i + kk8; v[i] = ok ? *(const f32x4*)(W + (size_t)(k0 + kk) * N + n0 + c4) : (f32x4){0.f, 0.f, 0.f, 0.f}; }
#pragma unroll
    for (int i = 0; i < 8; ++i) { const int kk = 8 * i + kk8; const float g = gain ? gain[k0 + kk] : 1.0f; LAS float* d = scr + kk * 33 + c4;
        d[0] = v[i][0] * g; d[1] = v[i][1] * g; d[2] = v[i][2] * g; d[3] = v[i][3] * g; }
    LDS_WAIT(); asm volatile("" ::: "memory");
    const int c = lane & 7;
#pragma unroll
    for (int j = 0; j < 4; ++j) { const int nn = (lane >> 3) + 8 * j; const LAS float* s = scr + (8 * c) * 33 + nn;
        u32x4 o; o.x = pk2(s[0 * 33], s[1 * 33]); o.y = pk2(s[2 * 33], s[3 * 33]); o.z = pk2(s[4 * 33], s[5 * 33]); o.w = pk2(s[6 * 33], s[7 * 33]);
        *(u32x4*)(WT + (size_t)(drow0 + nn) * K + k0 + 8 * c) = o; }
    LDS_WAIT(); asm volatile("" ::: "memory");
}
__device__ __forceinline__ void p0_prologue(const Args& a, LAS unsigned char* lds, int vcu, int G, int tid) {
    const int wave = __builtin_amdgcn_readfirstlane(tid >> 6), lane = tid & 63;
    unsigned char* ws = a.ws;
    LAS float* scr = (LAS float*)(lds + wave * 16384);
    const int gw = vcu * NWAVES + wave, NGW = G * NWAVES;
    constexpr int IT_GU = 16 * 88, IT_D = 44 * 32, IT_IN = 16 * 88, IT_OUT = 16 * 32;
    constexpr int NITEMS = 4 * IT_GU + 2 * IT_D + IT_IN + IT_OUT;
    for (int it = gw; it < NITEMS; it += NGW) {
        int r = it;
        if (r < 2 * IT_GU) {
            const int s = r / IT_GU; r -= s * IT_GU; const int kb = r / 88, nb = r % 88, n0 = nb * 32;
            tr_item(a.in[s ? I_U1 : I_G1], D, FF, a.in[I_N1], (bf16*)(ws + WS_WGU1), 256 * (n0 >> 7) + 128 * s + (n0 & 127), kb * 64, n0, scr, lane); continue; }
        r -= 2 * IT_GU;
        if (r < 2 * IT_GU) {
            const int s = r / IT_GU; r -= s * IT_GU; const int kb = r / 88, nb = r % 88, n0 = nb * 32;
            tr_item(a.in[s ? I_U2 : I_G2], D, FF, a.in[I_N2], (bf16*)(ws + WS_WGU2), 256 * (n0 >> 7) + 128 * s + (n0 & 127), kb * 64, n0, scr, lane); continue; }
        r -= 2 * IT_GU;
        if (r < 2 * IT_D) {
            const int s = r / IT_D; r -= s * IT_D; const int kb = r / 32, nb = r % 32, n0 = nb * 32;
            tr_item(a.in[s ? I_D2 : I_D1], FF, D, nullptr, (bf16*)(ws + (s ? WS_WD2 : WS_WD1)), n0, kb * 64, n0, scr, lane); continue; }
        r -= 2 * IT_D;
        if (r < IT_IN) { const int kb = r / 88, nb = r % 88, n0 = nb * 32;
            tr_item(a.in[I_WIN], D, NIN, a.in[I_MIXN], (bf16*)(ws + WS_WIN), n0, kb * 64, n0, scr, lane); continue; }
        r -= IT_IN;
        { const int kb = r / 32, nb = r % 32, n0 = nb * 32;
            tr_item(a.in[I_WOUT], D, D, nullptr, (bf16*)(ws + WS_WOUT), n0, kb * 64, n0, scr, lane); }
    }
    {
        float* rss0 = (float*)(ws + WS_RSS); bf16* XB = (bf16*)(ws + WS_XB); const float* x = a.in[I_X];
        for (int m0 = gw * 4; m0 < M; m0 += NGW * 4) {
            f32x4 v[4][4];
#pragma unroll
            for (int r = 0; r < 4; ++r) { const f32x4* xr = (const f32x4*)(x + (size_t)(m0 + r) * D) + lane;
#pragma unroll
                for (int j = 0; j < 4; ++j) v[r][j] = __builtin_nontemporal_load(xr + 64 * j); }
#pragma unroll
            for (int r = 0; r < 4; ++r) { unsigned long long* o8 = (unsigned long long*)(XB + (size_t)(m0 + r) * D) + lane; float s = 0.f;
#pragma unroll
                for (int j = 0; j < 4; ++j) { s += (v[r][j].x * v[r][j].x + v[r][j].y * v[r][j].y) + (v[r][j].z * v[r][j].z + v[r][j].w * v[r][j].w);
                    o8[64 * j] = (unsigned long long)pk2(v[r][j].x, v[r][j].y) | ((unsigned long long)pk2(v[r][j].z, v[r][j].w) << 32); }
                s = wave_sum(s); if (lane == 0) rss0[m0 + r] = s; }
        }
    }
    {
        float* rss = (float*)(ws + WS_RSS) + M; const int gt = vcu * NTHR + tid, NGT = G * NTHR;
        for (int i = gt; i < 3 * M; i += NGT) rss[i] = 0.f;
        bf16* sw = (bf16*)(ws + WS_SGUW); const float* w = a.in[I_SGUW];
        for (int i = gt; i < 4 * 128 * 128; i += NGT) { const int t = (i >> 7) & 127, s = i & 127; sw[i] = (bf16)(((t >> 6) >= (s >> 6)) ? f2bf(w[i]) : 0u); }
    }
}

__device__ __forceinline__ void sgu_chunk(const Args& a, LAS unsigned char* lds, int chunk, int tid) {
    const int wave = __builtin_amdgcn_readfirstlane(tid >> 6), lane = tid & 63, fr = lane & 15, fq = lane >> 4;
    unsigned char* ws = a.ws;
    const bf16* Z = (const bf16*)(ws + WS_Z); bf16* Y = (bf16*)(ws + WS_Y); const bf16* SW = (const bf16*)(ws + WS_SGUW);
    constexpr int VS = 136;
    LAS bf16* vT = (LAS bf16*)lds;
    LAS float* st = (LAS float*)(lds + 512 * VS * 2);
    bf16x8 wfr[4][4]; float bsv[4];
    { const int tt = 16 * wave + fr;
#pragma unroll
      for (int g = 0; g < 4; ++g) { bsv[g] = a.in[I_SGUB][g * 128 + tt];
#pragma unroll
          for (int ks = 0; ks < 4; ++ks) wfr[g][ks] = *(const bf16x8*)(SW + ((size_t)(g * 128 + tt) * 128 + 32 * ks + 8 * fq)); } }
    {
        const int t = tid & 127, g = tid >> 7;
        const u32x4* zr = (const u32x4*)(Z + ((size_t)chunk * 128 + t) * ZW + 512 + g * 128);
        u32x4 raw[16]; float s = 0.f, ss = 0.f;
#pragma unroll
        for (int i = 0; i < 16; ++i) { raw[i] = zr[i];
#pragma unroll
            for (int j = 0; j < 4; ++j) { const float lo = bflo(raw[i][j]), hi = bfhi(raw[i][j]); s += lo + hi; ss += lo * lo + hi * hi; } }
        st[(g * 128 + t) * 2] = s; st[(g * 128 + t) * 2 + 1] = ss;
        __syncthreads();
        float S = 0.f, SS = 0.f;
#pragma unroll
        for (int gg = 0; gg < 4; ++gg) { S += st[(gg * 128 + t) * 2]; SS += st[(gg * 128 + t) * 2 + 1]; }
        const float mu = S * (1.f / 512.f), var = fmaxf(SS * (1.f / 512.f) - mu * mu, 0.f), rstd = 1.0f / sqrtf(var + EPS);
        const float* lg = a.in[I_LNG] + g * 128; const float* lb = a.in[I_LNB] + g * 128;
#pragma unroll
        for (int i = 0; i < 16; ++i)
#pragma unroll
            for (int j = 0; j < 4; ++j) { const int d = 8 * i + 2 * j;
                const float y0 = (bflo(raw[i][j]) - mu) * rstd * lg[d] + lb[d], y1 = (bfhi(raw[i][j]) - mu) * rstd * lg[d + 1] + lb[d + 1];
                vT[(g * 128 + d) * VS + t] = (bf16)f2bf(y0); vT[(g * 128 + d + 1) * VS + t] = (bf16)f2bf(y1); }
    }
    __syncthreads();
    {
        const int tb = wave, tt = 16 * tb + fr; const size_t row = (size_t)chunk * 128 + tt; const bool full = tb >= 4;
#pragma unroll
        for (int g = 0; g < 4; ++g) {
            f32x4 acc[4][2];
#pragma unroll
            for (int p = 0; p < 4; ++p) { acc[p][0] = (f32x4){0.f, 0.f, 0.f, 0.f}; acc[p][1] = (f32x4){0.f, 0.f, 0.f, 0.f}; }
            u32x4 uu[4];
#pragma unroll
            for (int p = 0; p < 4; ++p) uu[p] = *(const u32x4*)(Z + row * ZW + g * 128 + 32 * p + 8 * fq);
#pragma unroll
            for (int ks = 0; ks < 4; ++ks) {
                if (ks < 2 || full) {
                    const bf16x8 wf = wfr[g][ks];
#pragma unroll
                    for (int p = 0; p < 4; ++p)
#pragma unroll
                        for (int n = 0; n < 2; ++n) { const int drow = g * 128 + 32 * p + 8 * (fr >> 2) + 4 * n + (fr & 3);
                            const bf16x8 vf = *(const LAS bf16x8*)(vT + drow * VS + 32 * ks + 8 * fq);
                            acc[p][n] = __builtin_amdgcn_mfma_f32_16x16x32_bf16(vf, wf, acc[p][n], 0, 0, 0); }
                }
            }
            const float bias = bsv[g];
#pragma unroll
            for (int p = 0; p < 4; ++p) { const int d0 = g * 128 + 32 * p + 8 * fq; const u32x4 u = uu[p];
                u32x4 o;
                o.x = pk2(bflo(u.x) * (acc[p][0][0] + bias), bfhi(u.x) * (acc[p][0][1] + bias)); o.y = pk2(bflo(u.y) * (acc[p][0][2] + bias), bfhi(u.y) * (acc[p][0][3] + bias));
                o.z = pk2(bflo(u.z) * (acc[p][1][0] + bias), bfhi(u.z) * (acc[p][1][1] + bias)); o.w = pk2(bflo(u.w) * (acc[p][1][2] + bias), bfhi(u.w) * (acc[p][1][3] + bias));
                *(u32x4*)(Y + row * 1024 + d0) = o; }
        }
    }
    __syncthreads();
}

__device__ __forceinline__ void conv8_fetch(const bf16* Z, int b, int pos, int ch, u32x4 (&z)[4]) {
#pragma unroll
    for (int j = 0; j < 4; ++j) { const int tt = pos - 3 + j; z[j] = (tt >= 0) ? *(const u32x4*)(Z + ((size_t)b * SEQ + tt) * ZW + 1024 + ch) : (u32x4){0u, 0u, 0u, 0u}; }
}
__device__ __forceinline__ void conv8_math(const Args& a, int ch, const u32x4 (&zz)[4], float (&o)[8]) {
    const float* cw = a.in[I_CONVW]; const float* cb = a.in[I_CONVB];
    const f32x4 b0 = *(const f32x4*)(cb + ch), b1 = *(const f32x4*)(cb + ch + 4);
    float acc[8] = {b0[0], b0[1], b0[2], b0[3], b1[0], b1[1], b1[2], b1[3]};
#pragma unroll
    for (int j = 0; j < 4; ++j) { const u32x4 z = zz[j];
        const f32x4 w0 = *(const f32x4*)(cw + j * 512 + ch), w1 = *(const f32x4*)(cw + j * 512 + ch + 4);
        acc[0] += w0[0] * bflo(z.x); acc[1] += w0[1] * bfhi(z.x); acc[2] += w0[2] * bflo(z.y); acc[3] += w0[3] * bfhi(z.y);
        acc[4] += w1[0] * bflo(z.z); acc[5] += w1[1] * bfhi(z.z); acc[6] += w1[2] * bflo(z.w); acc[7] += w1[3] * bfhi(z.w); }
#pragma unroll
    for (int i = 0; i < 8; ++i) o[i] = pg8::silu_f(acc[i]);
}

struct M1Pre { u32x4 zk[4]; u32x4 vv[2]; float fpre, ipre; };
__device__ __forceinline__ void m1_fetch(const Args& a, int task, int tid, M1Pre& P) {
    const int wave = __builtin_amdgcn_readfirstlane(tid >> 6), lane = tid & 63;
    const bf16* Z = (const bf16*)(a.ws + WS_Z); const float* gates = (const float*)(a.ws + WS_GATES);
    const int b = task / (NHEAD * NCHK), h = (task / NCHK) % NHEAD, c = task % NCHK; const size_t row0 = (size_t)b * SEQ + c * 64;
    if (wave == 0) { P.fpre = gates[(row0 + lane) * 8 + 4 + h]; P.ipre = gates[(row0 + lane) * 8 + h]; }
    const int l = tid & 63, c8 = wave * 8, v16 = wave * 16;
    conv8_fetch(Z, b, c * 64 + l, 256 + h * 64 + c8, P.zk);
    const u32x4* vr = (const u32x4*)(Z + (row0 + l) * ZW + 1536 + h * 128 + v16); P.vv[0] = vr[0]; P.vv[1] = vr[1];
}
__device__ __forceinline__ void m1_body(const Args& a, LAS unsigned char* lds, int task, int tid, M1Pre& P, bool has_next, int next_task, M1Pre& Pn) {
    const int wave = __builtin_amdgcn_readfirstlane(tid >> 6), lane = tid & 63, fr = lane & 15, fq = lane >> 4;
    unsigned char* ws = a.ws;
    float* ML = (float*)(ws + WS_ML); float* BL = ML + NTASK; bf16* CST = (bf16*)(ws + WS_CST); float* NST = (float*)(ws + WS_NST);
    const int h = (task / NCHK) % NHEAD;
    constexpr int KS = 72;
    LAS float* wg = (LAS float*)lds;
    LAS bf16* kwT = (LAS bf16*)(lds + 256);
    LAS bf16* vT = (LAS bf16*)(lds + 256 + 64 * KS * 2);
    if (wave == 0) {
        const float fpre = P.fpre + a.in[I_FGB][h], ipre = P.ipre + a.in[I_IGB][h];
        const float bc = scan_add(logsigmoid_f(fpre), lane), blast = __shfl(bc, 63);
        const float g = blast - bc + ipre, mloc = wave_max(g);
        wg[lane] = expf(g - mloc);
        if (lane == 0) { ML[task] = mloc; BL[task] = blast; }
    }
    const int l = tid & 63, c8 = wave * 8, v16 = wave * 16;
    float kv[8]; conv8_math(a, 256 + h * 64 + c8, P.zk, kv);
#pragma unroll
    for (int q = 0; q < 2; ++q) { const u32x4 z = P.vv[q];
#pragma unroll
        for (int j = 0; j < 4; ++j) { vT[(v16 + 8 * q + 2 * j) * KS + l] = (bf16)(z[j] & 0xffffu); vT[(v16 + 8 * q + 2 * j + 1) * KS + l] = (bf16)(z[j] >> 16); } }
    LBAR();
    {
        const float sc = 0.125f * wg[l];
#pragma unroll
        for (int i = 0; i < 8; ++i) kwT[(c8 + i) * KS + l] = (bf16)f2bf(kv[i] * sc);
    }
    LBAR();
    if (has_next) m1_fetch(a, next_task, tid, Pn);
    {
        f32x4 acc[4];
#pragma unroll
        for (int kb = 0; kb < 4; ++kb) acc[kb] = (f32x4){0.f, 0.f, 0.f, 0.f};
#pragma unroll
        for (int ks = 0; ks < 2; ++ks) { const bf16x8 yf = *(const LAS bf16x8*)(vT + (16 * wave + fr) * KS + 32 * ks + 8 * fq);
#pragma unroll
            for (int kb = 0; kb < 4; ++kb) { const bf16x8 xf = *(const LAS bf16x8*)(kwT + (16 * kb + fr) * KS + 32 * ks + 8 * fq);
                acc[kb] = __builtin_amdgcn_mfma_f32_16x16x32_bf16(xf, yf, acc[kb], 0, 0, 0); } }
        bf16* cp = CST + (size_t)task * 8192 + (16 * wave + fr) * 64 + 4 * fq;
#pragma unroll
        for (int kb = 0; kb < 4; ++kb) { u32x2 o; o.x = pk2(acc[kb][0], acc[kb][1]); o.y = pk2(acc[kb][2], acc[kb][3]); *(u32x2*)(cp + 16 * kb) = o; }
        if (tid < 64) { float s = 0.f;
#pragma unroll 8
            for (int ll = 0; ll < 64; ++ll) s += __builtin_bit_cast(float, (unsigned)kwT[tid * KS + ll] << 16);
            NST[(size_t)task * 64 + tid] = s; }
    }
    LBAR();
}

__device__ __forceinline__ void scan_block(const Args& a, LAS unsigned char* lds, int vb, int tid) {
    unsigned char* ws = a.ws;
    float* ML = (float*)(ws + WS_ML); float* BL = ML + NTASK; float* MP = ML + 2 * NTASK; bf16* CST = (bf16*)(ws + WS_CST); float* NST = (float*)(ws + WS_NST);
    const int bh = vb >> 3, part = vb & 7;
    LAS float* sm = (LAS float*)lds;
    if (tid < 128) { sm[tid] = ML[bh * NCHK + tid]; sm[128 + tid] = BL[bh * NCHK + tid]; }
    typedef float f32x2v __attribute__((ext_vector_type(2)));
    unsigned* cp = (unsigned*)(CST + (size_t)bh * NCHK * 8192) + part * 512 + tid;
    const bool hasn = (part == 0 && tid < 64); float* np = NST + (size_t)bh * NCHK * 64 + tid;
    f32x2v cs = (f32x2v){0.f, 0.f}; float ns = 0.f, ms = 0.f;
    unsigned cl[8], cn[8]; float nl[8], nn[8];
#pragma unroll
    for (int i = 0; i < 8; ++i) { cl[i] = cp[(size_t)i * 4096]; nl[i] = hasn ? np[i * 64] : 0.f; }
    LBAR();
    for (int c0 = 0; c0 < NCHK; c0 += 8) {
        if (c0 + 8 < NCHK) {
#pragma unroll
            for (int i = 0; i < 8; ++i) { cn[i] = cp[(size_t)(c0 + 8 + i) * 4096]; nn[i] = hasn ? np[(c0 + 8 + i) * 64] : 0.f; }
        }
#pragma unroll
        for (int i = 0; i < 8; ++i) {
            const float ml = sm[c0 + i], bl = sm[128 + c0 + i];
            const float mn = fmaxf(bl + ms, ml), aa = __expf(bl + ms - mn), ee = __expf(ml - mn);
            cp[(size_t)(c0 + i) * 4096] = pk2(cs.x, cs.y); if (hasn) np[(c0 + i) * 64] = ns;
            if (part == 0 && tid == 0) MP[bh * NCHK + c0 + i] = ms;
            cs = cs * aa + (f32x2v){bflo(cl[i]), bfhi(cl[i])} * ee; ns = ns * aa + nl[i] * ee; ms = mn;
        }
#pragma unroll
        for (int i = 0; i < 8; ++i) { cl[i] = cn[i]; nl[i] = nn[i]; }
    }
    LBAR();
}

struct M3Pre { u32x4 zq[2][4]; u32x4 vv[2]; u32x4 cc[2]; u32x4 ov[2]; float fpre, ipre, mp, nst; };
__device__ __forceinline__ void m3_fetch(const Args& a, int task, int tid, M3Pre& P) {
    const int wave = __builtin_amdgcn_readfirstlane(tid >> 6), lane = tid & 63, fr = lane & 15, fq = lane >> 4;
    unsigned char* ws = a.ws;
    const bf16* Z = (const bf16*)(ws + WS_Z); const float* gates = (const float*)(ws + WS_GATES);
    const float* MP = (const float*)(ws + WS_ML) + 2 * NTASK; const bf16* CST = (const bf16*)(ws + WS_CST); const float* NST = (const float*)(ws + WS_NST);
    const int b = task / (NHEAD * NCHK), h = (task / NCHK) % NHEAD, c = task % NCHK; const size_t row0 = (size_t)b * SEQ + c * 64;
    if (wave == 0) { P.fpre = gates[(row0 + lane) * 8 + 4 + h]; P.ipre = gates[(row0 + lane) * 8 + h]; P.mp = MP[task]; P.nst = NST[(size_t)task * 64 + lane]; }
    { const int mat = tid >> 8, l = (tid & 255) >> 2, c16 = (tid & 3) * 16;
#pragma unroll
      for (int q = 0; q < 2; ++q) conv8_fetch(Z, b, c * 64 + l, mat * 256 + h * 64 + c16 + 8 * q, P.zq[q]); }
    { const int l = tid & 63, v16 = wave * 16; const u32x4* vr = (const u32x4*)(Z + (row0 + l) * ZW + 1536 + h * 128 + v16); P.vv[0] = vr[0]; P.vv[1] = vr[1]; }
    { const int v = tid >> 2, k16 = (tid & 3) * 16; const u32x4* cr = (const u32x4*)(CST + (size_t)task * 8192 + v * 64 + k16); P.cc[0] = cr[0]; P.cc[1] = cr[1]; }
    { const int tb = wave & 3, vh = wave >> 2, t = 16 * tb + fr;
#pragma unroll
      for (int p = 0; p < 2; ++p) P.ov[p] = *(const u32x4*)(Z + (row0 + t) * ZW + 2048 + h * 128 + vh * 64 + 32 * p + 8 * fq); }
}
__device__ __forceinline__ void m3_body(const Args& a, LAS unsigned char* lds, int task, int tid, M3Pre& P, bool has_next, int next_task, M3Pre& Pn) {
    const int wave = __builtin_amdgcn_readfirstlane(tid >> 6), lane = tid & 63, fr = lane & 15, fq = lane >> 4;
    unsigned char* ws = a.ws;
    bf16* Y = (bf16*)(ws + WS_Y);
    const int b = task / (NHEAD * NCHK), h = (task / NCHK) % NHEAD, c = task % NCHK; const size_t row0 = (size_t)b * SEQ + c * 64;
    constexpr int QS = 72, PS = 136;
    LAS float* bm = (LAS float*)lds; LAS float* ib = bm + 64; LAS float* ai = bm + 128; LAS float* emt = bm + 192;
    LAS float* hs = (LAS float*)(lds + 1024);
    LAS bf16* Qs = (LAS bf16*)(lds + 2048);
    LAS bf16* Ks = (LAS bf16*)(lds + 2048 + 9216);
    LAS bf16* Ps = (LAS bf16*)(lds + 20480);
    LAS bf16* Rs = (LAS bf16*)(lds + 37888);
    if (wave == 0) {
        const float fpre = P.fpre + a.in[I_FGB][h], ipre = P.ipre + a.in[I_IGB][h];
        const float bc = scan_add(logsigmoid_f(fpre), lane), ibv = ipre - bc, cm = scan_max(ibv, lane), mp = P.mp;
        const float mx = fmaxf(mp, cm), mt = bc + mx;
        bm[lane] = -mx; ib[lane] = ibv; ai[lane] = expf(mp - mx); emt[lane] = expf(-mt);
        Rs[128 * PS + lane] = (bf16)0x3f80u; Rs[128 * PS + 64 + lane] = (bf16)f2bf(P.nst);
    }
    {
        const int mat = tid >> 8, l = (tid & 255) >> 2, c16 = (tid & 3) * 16; LAS bf16* dst = (mat ? Ks : Qs) + l * QS + c16; const float sc = mat ? 0.125f : 1.0f;
#pragma unroll
        for (int q = 0; q < 2; ++q) { float kv[8]; conv8_math(a, mat * 256 + h * 64 + c16 + 8 * q, P.zq[q], kv);
            u32x4 o; o.x = pk2(kv[0] * sc, kv[1] * sc); o.y = pk2(kv[2] * sc, kv[3] * sc); o.z = pk2(kv[4] * sc, kv[5] * sc); o.w = pk2(kv[6] * sc, kv[7] * sc);
            *(LAS u32x4*)(dst + 8 * q) = o; }
    }
    {
        const int l = tid & 63, v16 = wave * 16;
#pragma unroll
        for (int q = 0; q < 2; ++q) { const u32x4 z = P.vv[q];
#pragma unroll
            for (int j = 0; j < 4; ++j) { Rs[(v16 + 8 * q + 2 * j) * PS + l] = (bf16)(z[j] & 0xffffu); Rs[(v16 + 8 * q + 2 * j + 1) * PS + l] = (bf16)(z[j] >> 16); } }
        const int v = tid >> 2, k16 = (tid & 3) * 16;
        *(LAS u32x4*)(Rs + v * PS + 64 + k16) = P.cc[0]; *(LAS u32x4*)(Rs + v * PS + 64 + k16 + 8) = P.cc[1];
    }
    const u32x4 ov0 = P.ov[0], ov1 = P.ov[1];
    LBAR();
    if (has_next) m3_fetch(a, next_task, tid, Pn);
    f32x4 gn[2][2];
    { const int vh = wave >> 2;
#pragma unroll
      for (int p = 0; p < 2; ++p) { const int v0 = h * 128 + vh * 64 + 32 * p + 8 * fq; gn[p][0] = *(const f32x4*)(a.in[I_MHN] + v0); gn[p][1] = *(const f32x4*)(a.in[I_MHN] + v0 + 4); } }
    {
        const int tb = wave & 3, sb2 = wave >> 2, t = 16 * tb + fr; const float bmt = bm[t];
#pragma unroll
        for (int e = 0; e < 2; ++e) { const int sb = 2 * sb2 + e; u32x2 o = (u32x2){0u, 0u};
            if (sb <= tb) { f32x4 acc = (f32x4){0.f, 0.f, 0.f, 0.f};
#pragma unroll
                for (int ks = 0; ks < 2; ++ks) { const bf16x8 xf = *(const LAS bf16x8*)(Ks + (16 * sb + fr) * QS + 32 * ks + 8 * fq), yf = *(const LAS bf16x8*)(Qs + t * QS + 32 * ks + 8 * fq);
                    acc = __builtin_amdgcn_mfma_f32_16x16x32_bf16(xf, yf, acc, 0, 0, 0); }
                float w[4];
#pragma unroll
                for (int j = 0; j < 4; ++j) { const int s = 16 * sb + 4 * fq + j; w[j] = (s <= t) ? __expf(bmt + ib[s]) * acc[j] : 0.f; }
                o.x = pk2(w[0], w[1]); o.y = pk2(w[2], w[3]); }
            *(LAS u32x2*)(Ps + t * PS + 16 * sb + 4 * fq) = o; }
        const int t2 = tid >> 3, k8 = (tid & 7) * 8; const float av = ai[t2]; const u32x4 qv = *(const LAS u32x4*)(Qs + t2 * QS + k8);
        u32x4 o; o.x = pk2(bflo(qv.x) * av, bfhi(qv.x) * av); o.y = pk2(bflo(qv.y) * av, bfhi(qv.y) * av); o.z = pk2(bflo(qv.z) * av, bfhi(qv.z) * av); o.w = pk2(bflo(qv.w) * av, bfhi(qv.w) * av);
        *(LAS u32x4*)(Ps + t2 * PS + 64 + k8) = o;
    }
    LBAR();
    {
        const int tb = wave & 3, vh = wave >> 2, t = 16 * tb + fr;
        f32x4 acc[2][2], accd = (f32x4){0.f, 0.f, 0.f, 0.f};
#pragma unroll
        for (int p = 0; p < 2; ++p) { acc[p][0] = (f32x4){0.f, 0.f, 0.f, 0.f}; acc[p][1] = (f32x4){0.f, 0.f, 0.f, 0.f}; }
#pragma unroll
        for (int ks = 0; ks < 4; ++ks) { const bf16x8 yf = *(const LAS bf16x8*)(Ps + t * PS + 32 * ks + 8 * fq);
#pragma unroll
            for (int p = 0; p < 2; ++p)
#pragma unroll
                for (int n = 0; n < 2; ++n) { const int vrow = vh * 64 + 32 * p + 8 * (fr >> 2) + 4 * n + (fr & 3);
                    const bf16x8 xf = *(const LAS bf16x8*)(Rs + vrow * PS + 32 * ks + 8 * fq);
                    acc[p][n] = __builtin_amdgcn_mfma_f32_16x16x32_bf16(xf, yf, acc[p][n], 0, 0, 0); }
            const bf16x8 xd = *(const LAS bf16x8*)(Rs + 128 * PS + 32 * ks + 8 * fq);
            accd = __builtin_amdgcn_mfma_f32_16x16x32_bf16(xd, yf, accd, 0, 0, 0); }
        const float den = accd[0], inv = 1.0f / fmaxf(fabsf(den), emt[t]);
        float ssq = 0.f;
#pragma unroll
        for (int p = 0; p < 2; ++p)
#pragma unroll
            for (int n = 0; n < 2; ++n) { acc[p][n] = acc[p][n] * inv; ssq += (acc[p][n][0] * acc[p][n][0] + acc[p][n][1] * acc[p][n][1]) + (acc[p][n][2] * acc[p][n][2] + acc[p][n][3] * acc[p][n][3]); }
        ssq += __shfl_xor(ssq, 16); ssq += __shfl_xor(ssq, 32);
        if (fq == 0) hs[t * 2 + vh] = ssq;
        LBAR();
        const float rs = __builtin_amdgcn_rsqf((hs[t * 2] + hs[t * 2 + 1]) * (1.f / 128.f) + EPS);
#pragma unroll
        for (int p = 0; p < 2; ++p) { const int v0 = h * 128 + vh * 64 + 32 * p + 8 * fq;
            const u32x4 ov = p ? ov1 : ov0; const f32x4 g0 = gn[p][0], g1 = gn[p][1];
            u32x4 o;
            o.x = pk2(acc[p][0][0] * rs * g0[0] * pg8::sigmoid_f(bflo(ov.x)), acc[p][0][1] * rs * g0[1] * pg8::sigmoid_f(bfhi(ov.x)));
            o.y = pk2(acc[p][0][2] * rs * g0[2] * pg8::sigmoid_f(bflo(ov.y)), acc[p][0][3] * rs * g0[3] * pg8::sigmoid_f(bfhi(ov.y)));
            o.z = pk2(acc[p][1][0] * rs * g1[0] * pg8::sigmoid_f(bflo(ov.z)), acc[p][1][1] * rs * g1[1] * pg8::sigmoid_f(bfhi(ov.z)));
            o.w = pk2(acc[p][1][2] * rs * g1[2] * pg8::sigmoid_f(bflo(ov.w)), acc[p][1][3] * rs * g1[3] * pg8::sigmoid_f(bfhi(ov.w)));
            *(u32x4*)(Y + (row0 + t) * 1024 + 512 + v0) = o; }
    }
    LBAR();
}

#define XB_TMO      128
#define XB_XCNT(j)  (256  + 64 * (j))
#define XB_XSUB(j)  (1280 + 64 * (j))
#define XB_XGEN(j)  (2304 + 64 * (j))
#define XB_TOP      3328
#define XB_TOPGEN   3392
#define XCD_BAR_WORDS 3456
#define XB_SPIN_CAP (1u << 18)

__device__ __forceinline__ unsigned xb_ld(unsigned* p)              { return __hip_atomic_load(p, __ATOMIC_RELAXED, __HIP_MEMORY_SCOPE_AGENT); }
__device__ __forceinline__ unsigned xb_add(unsigned* p, unsigned v) { return __hip_atomic_fetch_add(p, v, __ATOMIC_RELAXED, __HIP_MEMORY_SCOPE_AGENT); }
__device__ __forceinline__ unsigned xb_xcc_id() { return (unsigned)__builtin_amdgcn_s_getreg((3 << 11) | 20) & 0xFu; }
#define XB_SPIN(cond, bar) do { unsigned _sp = 0; while (cond) { __builtin_amdgcn_s_sleep(1); \
    if ((++_sp & 255u) == 0u) { if (xb_ld(&(bar)[XB_TMO])) break; if (_sp > XB_SPIN_CAP) { atomicAdd(&(bar)[XB_TMO], 1u); break; } } } } while (0)

struct XcdBarrier {
    unsigned* bar; unsigned x;
    volatile LAS unsigned* st;
};

__device__ __forceinline__ XcdBarrier xcd_barrier_post(unsigned* bar, volatile LAS unsigned* st) {
    XcdBarrier b; b.bar = bar; b.x = xb_xcc_id(); b.st = st;
    if (threadIdx.x == 0) (void)xb_add(&bar[XB_XCNT(b.x)], 1u);
    return b;
}
__device__ __forceinline__ void xcd_barrier_complete(unsigned* bar, unsigned x, unsigned& nloc, unsigned& nx) {
    const unsigned G = gridDim.x * gridDim.y * gridDim.z;
    unsigned sum, cnt, mine, sp = 0u;
    for (;;) {
        sum = 0u; cnt = 0u; mine = 0u;
#pragma unroll
        for (unsigned j = 0; j < 16; ++j) { const unsigned c = xb_ld(&bar[XB_XCNT(j)]); sum += c; cnt += (c > 0u) ? 1u : 0u; mine = (j == x) ? c : mine; }
        if (sum == G) break;
        __builtin_amdgcn_s_sleep(1);
        if ((++sp & 255u) == 0u) { if (xb_ld(&bar[XB_TMO])) break; if (sp > XB_SPIN_CAP) { atomicAdd(&bar[XB_TMO], 1u); break; } }
    }
    nloc = mine > 0u ? mine : 1u; nx = cnt > 0u ? cnt : 1u;
}

__device__ __forceinline__ void xcd_barrier(const XcdBarrier& b) {
    asm volatile("s_waitcnt vmcnt(0)" ::: "memory");
    __syncthreads();
    if (threadIdx.x == 0) {
        unsigned* bar = b.bar;
        __builtin_amdgcn_s_waitcnt(0);
        unsigned nloc = b.st[0], nx = b.st[1];
        if (nloc == 0u) { xcd_barrier_complete(bar, b.x, nloc, nx); b.st[0] = nloc; b.st[1] = nx; }
        const unsigned old = xb_add(&bar[XB_XSUB(b.x)], 1u);
        const unsigned gen = old / nloc;
        if (old + 1u == (gen + 1u) * nloc) {
            __builtin_amdgcn_fence(__ATOMIC_RELEASE, "agent");
            asm volatile("s_waitcnt vmcnt(0)" ::: "memory");
            const unsigned og = xb_add(&bar[XB_TOP], 1u);
            const unsigned tg = og / nx;
            if (og + 1u == (tg + 1u) * nx) xb_add(&bar[XB_TOPGEN], 1u);
            else XB_SPIN(xb_ld(&bar[XB_TOPGEN]) == tg, bar);
            __builtin_amdgcn_fence(__ATOMIC_ACQUIRE, "agent");
            xb_add(&bar[XB_XGEN(b.x)], 1u);
            asm volatile("s_waitcnt vmcnt(0)" ::: "memory");
        } else {
            XB_SPIN(xb_ld(&bar[XB_XGEN(b.x)]) == gen, bar);
            __builtin_amdgcn_fence(__ATOMIC_ACQUIRE, "agent");
            asm volatile("s_waitcnt vmcnt(0)" ::: "memory");
        }
    }
    __syncthreads();
}
__global__ void __launch_bounds__(NTHR, 2) fwd_megakernel(Args args) {
    extern __shared__ __attribute__((aligned(16))) unsigned char lds_raw[];
    LAS unsigned char* lds = (LAS unsigned char*)lds_raw;
    cg::grid_group grid = cg::this_grid();
    const int tid = threadIdx.x, wave = __builtin_amdgcn_readfirstlane(tid >> 6), lane = tid & 63;
    const int G = gridDim.x, bx = blockIdx.x, vcu = (G % 8 == 0) ? (bx % 8) * (G / 8) + bx / 8 : bx;
    unsigned char* ws = args.ws;
    const int lo = args.ph_lo, hi = args.ph_hi;
#define IN(k) (lo <= (k) && (k) < hi)
#define REPS(k) ((((REP_MASK) >> (k)) & 1) ? 2 : 1)
#define SEAM(k) do { if (IN(k) && IN((k) + 1)) { if (USE_CG_SYNC) grid.sync(); else xcd_barrier(xbar); } } while (0)
    volatile LAS unsigned* MISC = (volatile LAS unsigned*)(lds + MISC_OFF);
    if (tid < 32) MISC[tid] = 0u;
    __syncthreads();
    XcdBarrier xbar = xcd_barrier_post((unsigned*)(ws + WS_CTL) + 1024, MISC + 8);
    bf16* XB = (bf16*)(ws + WS_XB); bf16* HID = (bf16*)(ws + WS_HID); bf16* Zb = (bf16*)(ws + WS_Z); bf16* Yb = (bf16*)(ws + WS_Y);
    float* RSS = (float*)(ws + WS_RSS); float* X1 = args.out;

    if (hi < 0) grid.sync();
    if (IN(0)) { for (int rep = 0; rep < REPS(0); ++rep) p0_prologue(args, lds, vcu, G, tid); } SEAM(0);
    if (REPS(12) == 2) { for (int i = 0; i < 10; ++i) grid.sync(); }
    if (IN(1)) _Pragma("unroll") for (int rep = 0; rep < REPS(1); ++rep) {
        pg8::Gemm g{XB, (const bf16*)(ws + WS_WGU1), M, NGU, D}; pg8::StaticOrder S; S.init(M, NGU, G, bx);
        pg8::EpiGU E{HID, RSS, FF};
        pg8::gemm_phase<pg8::EpiGU, pg8::StaticOrder, GEMM_ALIGN, GEMM_SP2>(lds, g, S, E);
    } SEAM(1);
    if (IN(2)) {
        pg8::Gemm g{HID, (const bf16*)(ws + WS_WD1), M, D, FF}; pg8::StaticOrder S; S.init(M, D, G, bx);
        pg8::EpiRes<false> E{args.in[I_X], XB, RSS + M, 0.5f};
        pg8::gemm_phase<pg8::EpiRes<false>, pg8::StaticOrder, GEMM_ALIGN, GEMM_SP2>(lds, g, S, E);
    } SEAM(2);
    if (IN(3)) _Pragma("unroll") for (int rep = 0; rep < REPS(3); ++rep) {
        pg8::Gemm g{XB, (const bf16*)(ws + WS_WIN), M, NINP, D}; pg8::StaticOrder S; S.init(M, NINP, G, bx);
        pg8::EpiIn E{Zb, (float*)(ws + WS_GATES), RSS + M, ZW};
        pg8::gemm_phase<pg8::EpiIn, pg8::StaticOrder, GEMM_ALIGN, GEMM_SP2>(lds, g, S, E);
    } SEAM(3);
    if (IN(4)) {
        for (int rep = 0; rep < REPS(11); ++rep) for (int ch = vcu; ch < M / 128; ch += G) sgu_chunk(args, lds, ch, tid);
        { M1Pre P, Pn; int t = vcu; if (t < NTASK) m1_fetch(args, t, tid, P);
          for (; t < NTASK; t += G) { const int tn = t + G; m1_body(args, lds, t, tid, P, tn < NTASK, tn, Pn); P = Pn; } }
    } SEAM(4);
    if (IN(5)) { for (int vb = vcu; vb < 256; vb += G) scan_block(args, lds, vb, tid); } SEAM(5);
    if (IN(6)) { M3Pre P, Pn; int t = vcu; if (t < NTASK) m3_fetch(args, t, tid, P);
        for (; t < NTASK; t += G) { const int tn = t + G; m3_body(args, lds, t, tid, P, tn < NTASK, tn, Pn); P = Pn; } } SEAM(6);
    if (IN(7)) {
        pg8::Gemm g{Yb, (const bf16*)(ws + WS_WOUT), M, D, D}; pg8::StaticOrder S; S.init(M, D, G, bx);
        pg8::EpiRes<true> E{XB, XB, RSS + 2 * M, 1.0f};
        pg8::gemm_phase<pg8::EpiRes<true>, pg8::StaticOrder, GEMM_ALIGN, GEMM_SP2>(lds, g, S, E);
    } SEAM(7);
    if (IN(8)) {
        pg8::Gemm g{XB, (const bf16*)(ws + WS_WGU2), M, NGU, D}; pg8::StaticOrder S; S.init(M, NGU, G, bx);
        pg8::EpiGU E{HID, RSS + 2 * M, FF};
        pg8::gemm_phase<pg8::EpiGU, pg8::StaticOrder, GEMM_ALIGN, GEMM_SP2>(lds, g, S, E);
    } SEAM(8);
#if FUSE_FINAL
    if (IN(9)) {
        pg8::Gemm g{HID, (const bf16*)(ws + WS_WD2), M, D, FF}; pg8::StaticOrder S; S.init(M, D, G, bx);
        pg8::EpiResNorm E{X1, X1, RSS + 3 * M, (unsigned*)(ws + WS_CTL) + 8192, args.in[I_FINALN], 0.5f};
        pg8::gemm_phase<pg8::EpiResNorm, pg8::StaticOrder, GEMM_ALIGN, GEMM_SP2>(lds, g, S, E);
    }
#else
    if (IN(9)) {
        pg8::Gemm g{HID, (const bf16*)(ws + WS_WD2), M, D, FF}; pg8::StaticOrder S; S.init(M, D, G, bx);
        pg8::EpiRes<true> E{XB, XB, RSS + 3 * M, 0.5f};
        pg8::gemm_phase<pg8::EpiRes<true>, pg8::StaticOrder, GEMM_ALIGN, GEMM_SP2>(lds, g, S, E);
    } SEAM(9);
    if (IN(10)) {
        const int gw = vcu * NWAVES + wave, NGW = G * NWAVES; const float* rss3 = RSS + 3 * M; const f32x4* gn = (const f32x4*)args.in[I_FINALN];
        const f32x4 g0 = gn[2 * lane], g1 = gn[2 * lane + 1], g2 = gn[128 + 2 * lane], g3 = gn[128 + 2 * lane + 1];
        for (int m0 = gw * 4; m0 < M; m0 += NGW * 4) {
            u32x4 v[4][2]; float r[4];
#pragma unroll
            for (int q = 0; q < 4; ++q) { const u32x4* xr = (const u32x4*)(XB + (size_t)(m0 + q) * D); v[q][0] = xr[lane]; v[q][1] = xr[64 + lane]; r[q] = rss3[m0 + q]; }
#pragma unroll
            for (int q = 0; q < 4; ++q) { const float rs = __builtin_amdgcn_rsqf(r[q] * (1.f / 1024.f) + EPS); f32x4* o = (f32x4*)(X1 + (size_t)(m0 + q) * D);
                __builtin_nontemporal_store(((f32x4){bflo(v[q][0].x), bfhi(v[q][0].x), bflo(v[q][0].y), bfhi(v[q][0].y)}) * rs * g0, o + 2 * lane);
                __builtin_nontemporal_store(((f32x4){bflo(v[q][0].z), bfhi(v[q][0].z), bflo(v[q][0].w), bfhi(v[q][0].w)}) * rs * g1, o + 2 * lane + 1);
                __builtin_nontemporal_store(((f32x4){bflo(v[q][1].x), bfhi(v[q][1].x), bflo(v[q][1].y), bfhi(v[q][1].y)}) * rs * g2, o + 128 + 2 * lane);
                __builtin_nontemporal_store(((f32x4){bflo(v[q][1].z), bfhi(v[q][1].z), bflo(v[q][1].w), bfhi(v[q][1].w)}) * rs * g3, o + 128 + 2 * lane + 1); }
        }
    }
#endif
#undef IN
#undef SEAM
}

#ifndef MK_N_LAUNCHES
#define MK_N_LAUNCHES 1
#endif
constexpr int N_PHASES = FUSE_FINAL ? 10 : 11;
extern "C" void kernel_launch(void* const* d_in, const int* in_sizes, int n_in, void* d_out, int out_size, void* d_ws, size_t ws_size, hipStream_t stream) {
    static int grid = 0;
    if (grid == 0) {
        if (n_in != 22 || in_sizes[0] != M * D || out_size != M * D || ws_size < WS_END) { fprintf(stderr, "kernel_launch: unexpected shapes (n_in %d, in0 %d, out %d, ws %zu)\n", n_in, n_in > 0 ? in_sizes[0] : -1, out_size, ws_size); grid = -1; return; }
        int dev = 0, cus = 0, per_cu = 0;
        hipGetDevice(&dev); hipDeviceGetAttribute(&cus, hipDeviceAttributeMultiprocessorCount, dev);
        hipFuncSetAttribute((const void*)fwd_megakernel, hipFuncAttributeMaxDynamicSharedMemorySize, LDS_BYTES);
        if (hipOccupancyMaxActiveBlocksPerMultiprocessor(&per_cu, (const void*)fwd_megakernel, NTHR, LDS_BYTES) != hipSuccess || per_cu < 1) { fprintf(stderr, "kernel_launch: occupancy query gave %d\n", per_cu); per_cu = 1; }
        (void)hipGetLastError();
        grid = cus * per_cu;
    }
    if (grid < 0) return;
    if (hipMemsetAsync((char*)d_ws + WS_CTL, 0, CTL_ZERO_BYTES, stream) != hipSuccess) { fprintf(stderr, "kernel_launch: memset failed\n"); return; }
    Args a{};
    for (int i = 0; i < 22; ++i) a.in[i] = (const float*)d_in[i];
    a.out = (float*)d_out; a.ws = (unsigned char*)d_ws;
#if MK_N_LAUNCHES == 1
    a.ph_lo = 0; a.ph_hi = N_PHASES;
    void* kargs[] = {&a};
    hipError_t e = hipLaunchCooperativeKernel((const void*)fwd_megakernel, dim3(grid), dim3(NTHR), kargs, LDS_BYTES, stream);
    if (e != hipSuccess) fprintf(stderr, "cooperative launch failed: %s (grid %d)\n", hipGetErrorString(e), grid);
#else
    for (int p = 0; p < N_PHASES; ++p) { a.ph_lo = p; a.ph_hi = p + 1; hipLaunchKernelGGL(fwd_megakernel, dim3(grid), dim3(NTHR), LDS_BYTES, stream, a); }
#endif
}
```

```cpp
#include <hip/hip_runtime.h>
#include <hip/hip_cooperative_groups.h>
#include <cstdio>
#include <cstdint>
namespace cg = cooperative_groups;
#ifndef REP_MASK
#define REP_MASK 0
#endif
#ifndef USE_CG_SYNC
#define USE_CG_SYNC 0
#endif
#ifndef FUSE_FINAL
#define FUSE_FINAL 0
#endif
#ifndef PG8_STGMMA
#define PG8_STGMMA 0
#endif
#ifndef GEMM_SP2
#define GEMM_SP2 true
#endif
#ifndef GEMM_ALIGN
#define GEMM_ALIGN true
#endif
namespace pg8 {
#define PG8_LAS __attribute__((address_space(3)))
typedef unsigned short bf16_t;
typedef short bf16x8 __attribute__((ext_vector_type(8)));
typedef float f32x4 __attribute__((ext_vector_type(4)));
typedef unsigned u32x4 __attribute__((ext_vector_type(4)));
constexpr int BM = 256, BK = 64, HALF = 128, HTB = HALF * BK * 2  , STAGE_BYTES = 8 * HTB, NXCD = 8, WGM = 4;

__host__ __device__ __forceinline__ int lds_byte(int r, int c) { const int st = (r >> 4) * 2 + (c >> 5), rr = r & 15, cc = c & 31, ob = rr * 64 + cc * 2; return st * 1024 + (ob ^ (((ob >> 9) & 1) << 5)); }
__host__ __device__ __forceinline__ void stage_rc(int b, int& R, int& C) { const int st = b / 1024, sb = b % 1024, swz = sb ^ (((sb >> 9) & 1) << 5); R = (st >> 1) * 16 + swz / 64; C = (st & 1) * 32 + (swz % 64) / 2; }
__host__ __device__ __forceinline__ int perm32(int rho) { const int n = rho >> 4, i = rho & 15; return 8 * (i >> 2) + 4 * n + (i & 3); }

struct Unit { int pm, pn; };
struct Gemm { const bf16_t* A; const bf16_t* Bt; int M, N, K; };

struct StaticOrder {
    int nM, nN, nwg, G, c;
    __host__ __device__ void init(int M, int N, int G_, int c_) { nM = M / BM; nN = N / BM; nwg = nM * nN; G = G_; c = c_; }
    __host__ __device__ bool next(int i, Unit& u) const {
        const long L = (long)i * G + c; if (L >= nwg) return false;
        int wgid = (int)L; { const int q = nwg / NXCD, r = nwg % NXCD, xcd = wgid % NXCD, off = wgid / NXCD; wgid = (xcd < r ? xcd * (q + 1) : r * (q + 1) + (xcd - r) * q) + off; }
        const int nig = WGM * nN, gid = wgid / nig, fm = gid * WGM, gsz = (nM - fm) < WGM ? (nM - fm) : WGM;
        u.pm = fm + ((wgid % nig) % gsz); u.pn = (wgid % nig) / gsz; return true;
    }
    __device__ __forceinline__ void a_ready(const Unit&) const {}
    __device__ __forceinline__ void done(const Unit&) const {}
};

__device__ __forceinline__ unsigned cvt_pk_bf16(float lo, float hi) { unsigned r; asm volatile("v_cvt_pk_bf16_f32 %0, %1, %2" : "=v"(r) : "v"(lo), "v"(hi)); return r; }
typedef float f32x2 __attribute__((ext_vector_type(2)));
__device__ __forceinline__ float silu_f(float g) { return g * __builtin_amdgcn_rcpf(1.0f + __builtin_amdgcn_exp2f(-1.44269504f * g)); }
__device__ __forceinline__ float sigmoid_f(float g) { return __builtin_amdgcn_rcpf(1.0f + __builtin_amdgcn_exp2f(-1.44269504f * g)); }
__device__ __forceinline__ float gelu_tanh_f(float x) { const float t = x * (1.0f + 0.044715f * x * x); return x * __builtin_amdgcn_rcpf(1.0f + __builtin_amdgcn_exp2f(-2.302208198f * t)); }
__device__ __forceinline__ float row_rs(const float* rowss, int row) { return __builtin_amdgcn_rsqf(rowss[row] * (1.0f / 1024.0f) + 1e-6f); }

struct EpiGU {
    static constexpr bool PERM = true, AFTER_DRAIN = false;
    bf16_t* H; const float* rowss; int ldh;
    __device__ __forceinline__ void prefetch(const Unit& u, int wr, int fr, float (&pre)[8]) const {
        const int row0 = u.pm * BM + wr * 64 + fr;
#pragma unroll
        for (int i = 0; i < 8; ++i) pre[i] = rowss[row0 + (i >> 2) * HALF + (i & 3) * 16];
    }
    __device__ __forceinline__ void operator()(const f32x4 (&acc)[2][2][4][2], const Unit& u, int wr, int wc, int fr, int fq, const float (&pre)[8]) const {
        const int row0 = u.pm * BM + wr * 64 + fr, col0 = u.pn * 128 + wc * 32 + 8 * fq;
        float rr[2][4];
#pragma unroll
        for (int ai = 0; ai < 2; ++ai)
#pragma unroll
            for (int m = 0; m < 4; ++m) rr[ai][m] = pre[ai * 4 + m];
#pragma unroll
        for (int ai = 0; ai < 2; ++ai)
#pragma unroll
            for (int m = 0; m < 4; ++m) {
                const int row = row0 + ai * HALF + m * 16; const float r = __builtin_amdgcn_rsqf(rr[ai][m] * (1.0f / 1024.0f) + 1e-6f), rn = -1.44269504f * r, r2 = r * r;
                unsigned w[4];
#pragma unroll
                for (int n = 0; n < 2; ++n)
#pragma unroll
                    for (int j = 0; j < 2; ++j) {
                        const f32x2 g = (f32x2){acc[ai][0][m][n][2 * j], acc[ai][0][m][n][2 * j + 1]}, uu = (f32x2){acc[ai][1][m][n][2 * j], acc[ai][1][m][n][2 * j + 1]};
                        const f32x2 t = g * rn; f32x2 e; e.x = __builtin_amdgcn_exp2f(t.x); e.y = __builtin_amdgcn_exp2f(t.y);
                        const f32x2 d = e + 1.0f; f32x2 sg; sg.x = __builtin_amdgcn_rcpf(d.x); sg.y = __builtin_amdgcn_rcpf(d.y);
                        const f32x2 h = ((g * uu) * r2) * sg;
                        w[n * 2 + j] = cvt_pk_bf16(h.x, h.y);
                    }
                u32x4 wv; wv.x = w[0]; wv.y = w[1]; wv.z = w[2]; wv.w = w[3];
                __builtin_nontemporal_store(wv, (u32x4*)(H + (size_t)row * ldh + col0));
            }
    }
};
template <bool BASE_BF16> struct EpiRes {
    static constexpr bool PERM = true, AFTER_DRAIN = false;
    const void* base; bf16_t* outb; float* rowss_out; float scale;
    __device__ __forceinline__ void prefetch(const Unit&, int, int, float (&)[8]) const {}
    __device__ __forceinline__ void operator()(const f32x4 (&acc)[2][2][4][2], const Unit& u, int wr, int wc, int fr, int fq, const float (&)[8]) const {
        const int row0 = u.pm * BM + wr * 64 + fr, col0 = u.pn * BM + wc * 32 + 8 * fq;
#pragma unroll
        for (int ai = 0; ai < 2; ++ai)
#pragma unroll
            for (int m = 0; m < 4; ++m) {
                const int row = row0 + ai * HALF + m * 16; float ss = 0.f;
#pragma unroll
                for (int bj = 0; bj < 2; ++bj) {
                    const size_t off = (size_t)row * 1024 + col0 + bj * HALF;
                    f32x4 b0, b1;
                    if (BASE_BF16) { const u32x4 bb = *(const u32x4*)((const bf16_t*)base + off);
                        b0 = (f32x4){__builtin_bit_cast(float, bb.x << 16), __builtin_bit_cast(float, bb.x & 0xffff0000u), __builtin_bit_cast(float, bb.y << 16), __builtin_bit_cast(float, bb.y & 0xffff0000u)};
                        b1 = (f32x4){__builtin_bit_cast(float, bb.z << 16), __builtin_bit_cast(float, bb.z & 0xffff0000u), __builtin_bit_cast(float, bb.w << 16), __builtin_bit_cast(float, bb.w & 0xffff0000u)}; }
                    else { b0 = *(const f32x4*)((const float*)base + off); b1 = *(const f32x4*)((const float*)base + off + 4); }
                    const f32x4 v0 = b0 + acc[ai][bj][m][0] * scale, v1 = b1 + acc[ai][bj][m][1] * scale;
                    u32x4 w; w.x = cvt_pk_bf16(v0[0], v0[1]); w.y = cvt_pk_bf16(v0[2], v0[3]); w.z = cvt_pk_bf16(v1[0], v1[1]); w.w = cvt_pk_bf16(v1[2], v1[3]); *(u32x4*)(outb + off) = w;
                    ss += (v0[0] * v0[0] + v0[1] * v0[1]) + (v0[2] * v0[2] + v0[3] * v0[3]) + (v1[0] * v1[0] + v1[1] * v1[1]) + (v1[2] * v1[2] + v1[3] * v1[3]);
                }
                ss += __shfl_xor(ss, 16); ss += __shfl_xor(ss, 32);
                if (fq == 0) __hip_atomic_fetch_add(rowss_out + row, ss, __ATOMIC_RELAXED, __HIP_MEMORY_SCOPE_AGENT);
            }
    }
};
struct EpiResNorm {
    static constexpr bool PERM = true, AFTER_DRAIN = false;
    const float* base; float* out; float* rowss; unsigned* cnt; const float* gain; float scale;
    __device__ __forceinline__ void prefetch(const Unit&, int, int, float (&)[8]) const {}
    __device__ __forceinline__ void operator()(f32x4 (&acc)[2][2][4][2], const Unit& u, int wr, int wc, int fr, int fq, const float (&)[8]) const {
        const int row0 = u.pm * BM + wr * 64 + fr, col0 = u.pn * BM + wc * 32 + 8 * fq;
#pragma unroll
        for (int ai = 0; ai < 2; ++ai)
#pragma unroll
            for (int m = 0; m < 4; ++m) {
                const int row = row0 + ai * HALF + m * 16; float ss = 0.f;
#pragma unroll
                for (int bj = 0; bj < 2; ++bj) {
                    const size_t off = (size_t)row * 1024 + col0 + bj * HALF;
                    const f32x4 b0 = *(const f32x4*)(base + off), b1 = *(const f32x4*)(base + off + 4);
                    const f32x4 v0 = b0 + acc[ai][bj][m][0] * scale, v1 = b1 + acc[ai][bj][m][1] * scale;
                    acc[ai][bj][m][0] = v0; acc[ai][bj][m][1] = v1;
                    ss += (v0[0] * v0[0] + v0[1] * v0[1]) + (v0[2] * v0[2] + v0[3] * v0[3]) + (v1[0] * v1[0] + v1[1] * v1[1]) + (v1[2] * v1[2] + v1[3] * v1[3]);
                }
                ss += __shfl_xor(ss, 16); ss += __shfl_xor(ss, 32);
                if (fq == 0) __hip_atomic_fetch_add(rowss + row, ss, __ATOMIC_RELAXED, __HIP_MEMORY_SCOPE_AGENT);
            }
        asm volatile("s_waitcnt vmcnt(0)" ::: "memory");
        unsigned* c = cnt + 16 * u.pm;
        if (fr == 0 && fq == 0) __hip_atomic_fetch_add(c, 1u, __ATOMIC_RELAXED, __HIP_MEMORY_SCOPE_AGENT);
        { unsigned sp = 0;
          while ((unsigned)__builtin_amdgcn_readfirstlane(__hip_atomic_load(c, __ATOMIC_RELAXED, __HIP_MEMORY_SCOPE_AGENT)) < 32u) { __builtin_amdgcn_s_sleep(1); if (++sp > (1u << 22)) break; } }
        __builtin_amdgcn_fence(__ATOMIC_ACQUIRE, "agent");
#pragma unroll
        for (int ai = 0; ai < 2; ++ai)
#pragma unroll
            for (int m = 0; m < 4; ++m) {
                const int row = row0 + ai * HALF + m * 16;
                const float r = __builtin_amdgcn_rsqf(__hip_atomic_load(rowss + row, __ATOMIC_RELAXED, __HIP_MEMORY_SCOPE_AGENT) * (1.0f / 1024.0f) + 1e-6f);
#pragma unroll
                for (int bj = 0; bj < 2; ++bj) {
                    const int col = col0 + bj * HALF; const size_t off = (size_t)row * 1024 + col;
                    const f32x4 g0 = *(const f32x4*)(gain + col), g1 = *(const f32x4*)(gain + col + 4);
                    *(f32x4*)(out + off) = acc[ai][bj][m][0] * r * g0; *(f32x4*)(out + off + 4) = acc[ai][bj][m][1] * r * g1;
                }
            }
    }
};
struct EpiIn {
    static constexpr bool PERM = true, AFTER_DRAIN = false;
    bf16_t* Z; float* gates; const float* rowss; int ldz;
    __device__ __forceinline__ void prefetch(const Unit& u, int wr, int fr, float (&pre)[8]) const {
        const int row0 = u.pm * BM + wr * 64 + fr;
#pragma unroll
        for (int i = 0; i < 8; ++i) pre[i] = rowss[row0 + (i >> 2) * HALF + (i & 3) * 16];
    }
    __device__ __forceinline__ void operator()(const f32x4 (&acc)[2][2][4][2], const Unit& u, int wr, int wc, int fr, int fq, const float (&pre)[8]) const {
        const int row0 = u.pm * BM + wr * 64 + fr, col0 = u.pn * BM + wc * 32 + 8 * fq;
        if (u.pn == 10) {
            if (wc == 0 && fq == 0) {
#pragma unroll
                for (int ai = 0; ai < 2; ++ai)
#pragma unroll
                    for (int m = 0; m < 4; ++m) {
                        const int row = row0 + ai * HALF + m * 16; const float r = __builtin_amdgcn_rsqf(pre[ai * 4 + m] * (1.0f / 1024.0f) + 1e-6f);
                        *(f32x4*)(gates + (size_t)row * 8) = acc[ai][0][m][0] * r; *(f32x4*)(gates + (size_t)row * 8 + 4) = acc[ai][0][m][1] * r;
                    }
            }
            return;
        }
        const bool act = u.pn < 4;
#pragma unroll
        for (int ai = 0; ai < 2; ++ai)
#pragma unroll
            for (int m = 0; m < 4; ++m) {
                const int row = row0 + ai * HALF + m * 16; const float r = __builtin_amdgcn_rsqf(pre[ai * 4 + m] * (1.0f / 1024.0f) + 1e-6f);
#pragma unroll
                for (int bj = 0; bj < 2; ++bj) {
                    f32x4 v0 = acc[ai][bj][m][0] * r, v1 = acc[ai][bj][m][1] * r;
                    if (act) {
#pragma unroll
                        for (int j = 0; j < 2; ++j) {
                            f32x2 x0 = (f32x2){v0[2 * j], v0[2 * j + 1]}, x1 = (f32x2){v1[2 * j], v1[2 * j + 1]};
                            const f32x2 t0 = (x0 * x0 * 0.044715f + 1.0f) * x0 * (-2.302208198f), t1 = (x1 * x1 * 0.044715f + 1.0f) * x1 * (-2.302208198f);
                            f32x2 e0, e1; e0.x = __builtin_amdgcn_exp2f(t0.x); e0.y = __builtin_amdgcn_exp2f(t0.y); e1.x = __builtin_amdgcn_exp2f(t1.x); e1.y = __builtin_amdgcn_exp2f(t1.y);
                            e0 = e0 + 1.0f; e1 = e1 + 1.0f;
                            v0[2 * j] = x0.x * __builtin_amdgcn_rcpf(e0.x); v0[2 * j + 1] = x0.y * __builtin_amdgcn_rcpf(e0.y); v1[2 * j] = x1.x * __builtin_amdgcn_rcpf(e1.x); v1[2 * j + 1] = x1.y * __builtin_amdgcn_rcpf(e1.y);
                        }
                    }
                    u32x4 w; w.x = cvt_pk_bf16(v0[0], v0[1]); w.y = cvt_pk_bf16(v0[2], v0[3]); w.z = cvt_pk_bf16(v1[0], v1[1]); w.w = cvt_pk_bf16(v1[2], v1[3]);
                    __builtin_nontemporal_store(w, (u32x4*)(Z + (size_t)row * ldz + col0 + bj * HALF));
                }
            }
    }
};

template <class Epi, class Sched, bool ALIGN_EPI = false, bool SP2 = false>
__device__ __forceinline__ void gemm_phase(PG8_LAS unsigned char* lds, const Gemm g, const Sched& S, const Epi& E) {
    const int tid = threadIdx.x, wid = __builtin_amdgcn_readfirstlane(tid >> 6), lane = tid & 63, wr = wid >> 2, wc = wid & 3, fr = lane & 15, fq = lane >> 4;
    const int K = g.K, nt = K / BK;
    unsigned voffA[2], voffB[2];
#pragma unroll
    for (int i = 0; i < 2; ++i) { int R, C; stage_rc(tid * 16 + i * 8192, R, C); const int Rb = Epi::PERM ? ((R & ~31) + perm32(R & 31)) : R;
        voffA[i] = (unsigned)(R * K + C) * 2u; voffB[i] = (unsigned)(Rb * K + C) * 2u; }
    const size_t kstep = (size_t)(BK * 2);
    const size_t hstep = (size_t)HALF * K * 2;
    const size_t tstep = 2 * hstep;
    const unsigned ldsw = (unsigned)wid * 1024u;
    const int aoff = lds_byte(wr * 64 + fr, fq * 8), boff = lds_byte(wc * 32 + fr, fq * 8);
#define PG8_SA(b, h) (((b) * 2 + (h)) * HTB)
#define PG8_SB(b, h) ((4 + (b) * 2 + (h)) * HTB)
#define PG8_STAGE(bufoff, gbase, voff) do { _Pragma("unroll") for (int _i = 0; _i < 2; ++_i) \
        __builtin_amdgcn_global_load_lds((const unsigned*)((const char*)(gbase) + (voff)[_i]), (PG8_LAS unsigned*)(lds + (bufoff) + ldsw + _i * 8192), 16, 0, 0); } while (0)
#define PG8_LDA(dst, b, h) do { _Pragma("unroll") for (int m = 0; m < 4; ++m) _Pragma("unroll") for (int k = 0; k < 2; ++k) dst[m][k] = *(const PG8_LAS bf16x8*)(lds + PG8_SA(b, h) + aoff + m * 2048 + k * 1024); } while (0)
#define PG8_LDB(dst, b, h) do { _Pragma("unroll") for (int n = 0; n < 2; ++n) _Pragma("unroll") for (int k = 0; k < 2; ++k) dst[n][k] = *(const PG8_LAS bf16x8*)(lds + PG8_SB(b, h) + boff + n * 2048 + k * 1024); } while (0)
#define PG8_MMA(ai, bj, At, Bt) do { __builtin_amdgcn_s_setprio(1); _Pragma("unroll") for (int m = 0; m < 4; ++m) _Pragma("unroll") for (int n = 0; n < 2; ++n) _Pragma("unroll") for (int k = 0; k < 2; ++k) \
        acc[ai][bj][m][n] = __builtin_amdgcn_mfma_f32_16x16x32_bf16(Bt[n][k], At[m][k], acc[ai][bj][m][n], 0, 0, 0); __builtin_amdgcn_s_setprio(0); } while (0)
#define PG8_STAGE1(bufoff, gbase, voff, i) __builtin_amdgcn_global_load_lds((const unsigned*)((const char*)(gbase) + (voff)[i]), (PG8_LAS unsigned*)(lds + (bufoff) + ldsw + (i) * 8192), 16, 0, 0)
#define PG8_MMAQ(ai, bj, At, Bt, m) do { _Pragma("unroll") for (int n = 0; n < 2; ++n) _Pragma("unroll") for (int k = 0; k < 2; ++k) \
        acc[ai][bj][m][n] = __builtin_amdgcn_mfma_f32_16x16x32_bf16(Bt[n][k], At[m][k], acc[ai][bj][m][n], 0, 0, 0); } while (0)
#define PG8_M1(At, B0, B1, bufoff, gbase, voff) do { __builtin_amdgcn_s_setprio(1); \
        PG8_MMAQ(0, 0, At, B0, 0); PG8_MMAQ(0, 0, At, B0, 1); PG8_SCHED; PG8_STAGE1(bufoff, gbase, voff, 0); PG8_SCHED; \
        PG8_MMAQ(0, 0, At, B0, 2); PG8_MMAQ(0, 0, At, B0, 3); PG8_SCHED; PG8_STAGE1(bufoff, gbase, voff, 1); PG8_SCHED; \
        PG8_MMAQ(0, 1, At, B1, 0); PG8_MMAQ(0, 1, At, B1, 1); PG8_MMAQ(0, 1, At, B1, 2); PG8_MMAQ(0, 1, At, B1, 3); __builtin_amdgcn_s_setprio(0); } while (0)
#define PG8_M2(At, B0, B1, o0, g0, v0, o1, g1, v1, o2, g2, v2) do { __builtin_amdgcn_s_setprio(1); \
        PG8_MMAQ(1, 0, At, B0, 0); PG8_SCHED; PG8_STAGE1(o0, g0, v0, 0); PG8_SCHED; PG8_MMAQ(1, 0, At, B0, 1); PG8_SCHED; PG8_STAGE1(o0, g0, v0, 1); PG8_SCHED; \
        PG8_MMAQ(1, 0, At, B0, 2); PG8_SCHED; PG8_STAGE1(o1, g1, v1, 0); PG8_SCHED; PG8_MMAQ(1, 0, At, B0, 3); PG8_SCHED; PG8_STAGE1(o1, g1, v1, 1); PG8_SCHED; \
        PG8_MMAQ(1, 1, At, B1, 0); PG8_SCHED; PG8_STAGE1(o2, g2, v2, 0); PG8_SCHED; PG8_MMAQ(1, 1, At, B1, 1); PG8_SCHED; PG8_STAGE1(o2, g2, v2, 1); PG8_SCHED; \
        PG8_MMAQ(1, 1, At, B1, 2); PG8_MMAQ(1, 1, At, B1, 3); __builtin_amdgcn_s_setprio(0); } while (0)
#define PG8_WAIT_V(n) asm volatile("s_waitcnt vmcnt(" #n ")" ::: "memory")
#define PG8_WAIT_L(n) asm volatile("s_waitcnt lgkmcnt(" #n ")" ::: "memory")
#define PG8_BAR __builtin_amdgcn_s_barrier()
#define PG8_SCHED __builtin_amdgcn_sched_barrier(0)
    Unit cur, nxt; int ui = 0;
    if (!S.next(0, cur)) return;
    float pre[8]; E.prefetch(cur, wr, fr, pre);
    f32x4 acc[2][2][4][2];
#pragma unroll
    for (int a = 0; a < 2; ++a)
#pragma unroll
        for (int b = 0; b < 2; ++b)
#pragma unroll
            for (int m = 0; m < 4; ++m)
#pragma unroll
                for (int n = 0; n < 2; ++n) acc[a][b][m][n] = (f32x4){0.f, 0.f, 0.f, 0.f};
    bf16x8 At[4][2], B0[2][2], B1[2][2];
    const char* cA = (const char*)g.A + (size_t)cur.pm * tstep; const char* cB = (const char*)g.Bt + (size_t)cur.pn * tstep;
    S.a_ready(cur);
    if constexpr (SP2) {
        PG8_STAGE(PG8_SB(0, 0), cB, voffB); PG8_STAGE(PG8_SB(0, 1), cB + hstep, voffB); PG8_STAGE(PG8_SA(0, 0), cA, voffA); PG8_STAGE(PG8_SA(0, 1), cA + hstep, voffA);
        if (wr == 1) PG8_BAR;
        PG8_WAIT_V(2); PG8_BAR;
        PG8_STAGE(PG8_SB(1, 0), cB + kstep, voffB); PG8_STAGE(PG8_SA(1, 0), cA + kstep, voffA); PG8_STAGE(PG8_SB(1, 1), cB + hstep + kstep, voffB);
        PG8_WAIT_V(6); PG8_BAR;
    } else {
        PG8_STAGE(PG8_SB(0, 0), cB, voffB); PG8_STAGE(PG8_SA(0, 0), cA, voffA); PG8_STAGE(PG8_SB(0, 1), cB + hstep, voffB); PG8_STAGE(PG8_SA(0, 1), cA + hstep, voffA);
        if (wr == 1) PG8_BAR;
        PG8_WAIT_V(4); PG8_BAR;
        PG8_STAGE(PG8_SB(1, 0), cB + kstep, voffB); PG8_STAGE(PG8_SA(1, 0), cA + kstep, voffA); PG8_STAGE(PG8_SB(1, 1), cB + hstep + kstep, voffB);
        PG8_WAIT_V(6); PG8_BAR;
    }
    for (;;) {
        const bool has_next = S.next(ui + 1, nxt);
        const char* nA = has_next ? (const char*)g.A + (size_t)nxt.pm * tstep : cA; const char* nB = has_next ? (const char*)g.Bt + (size_t)nxt.pn * tstep : cB;
        for (int t = 0; t < nt; t += 2) {
            const bool last = (t == nt - 2);
            const char* a1 = cA + (size_t)(t + 1) * kstep;
            const char* a2 = last ? nA : cA + (size_t)(t + 2) * kstep; const char* b2 = last ? nB : cB + (size_t)(t + 2) * kstep;
            const char* a3 = a2 + kstep; const char* b3 = b2 + kstep;
            if (last && has_next) S.a_ready(nxt);
            if constexpr (SP2) {
#if PG8_STGMMA
            PG8_LDB(B0, 0, 0); PG8_LDB(B1, 0, 1); PG8_SCHED; PG8_LDA(At, 0, 0);
            PG8_WAIT_V(6); PG8_WAIT_L(0); PG8_BAR; PG8_M1(At, B0, B1, PG8_SA(1, 1), a1 + hstep, voffA); PG8_BAR; PG8_SCHED;
            PG8_LDA(At, 0, 1);
            PG8_WAIT_V(2); PG8_WAIT_L(0); PG8_BAR; PG8_M2(At, B0, B1, PG8_SB(0, 0), b2, voffB, PG8_SB(0, 1), b2 + hstep, voffB, PG8_SA(0, 0), a2, voffA); PG8_BAR; PG8_SCHED;
            PG8_LDB(B0, 1, 0); PG8_LDB(B1, 1, 1); PG8_SCHED; PG8_LDA(At, 1, 0);
            PG8_WAIT_V(6); PG8_WAIT_L(0); PG8_BAR; PG8_M1(At, B0, B1, PG8_SA(0, 1), a2 + hstep, voffA); PG8_BAR; PG8_SCHED;
            PG8_LDA(At, 1, 1);
            PG8_WAIT_V(2); PG8_WAIT_L(0); PG8_BAR; PG8_M2(At, B0, B1, PG8_SB(1, 0), b3, voffB, PG8_SB(1, 1), b3 + hstep, voffB, PG8_SA(1, 0), a3, voffA); PG8_BAR; PG8_SCHED;
#else
            PG8_LDB(B0, 0, 0); PG8_LDB(B1, 0, 1); PG8_SCHED; PG8_LDA(At, 0, 0); PG8_STAGE(PG8_SA(1, 1), a1 + hstep, voffA);
            PG8_WAIT_V(8); PG8_WAIT_L(0); PG8_BAR; PG8_MMA(0, 0, At, B0); PG8_MMA(0, 1, At, B1); PG8_BAR; PG8_SCHED;
            PG8_LDA(At, 0, 1); PG8_STAGE(PG8_SB(0, 0), b2, voffB); PG8_STAGE(PG8_SB(0, 1), b2 + hstep, voffB); PG8_STAGE(PG8_SA(0, 0), a2, voffA);
            PG8_WAIT_V(8); PG8_WAIT_L(0); PG8_BAR; PG8_MMA(1, 0, At, B0); PG8_MMA(1, 1, At, B1); PG8_BAR; PG8_SCHED;
            PG8_LDB(B0, 1, 0); PG8_LDB(B1, 1, 1); PG8_SCHED; PG8_LDA(At, 1, 0); PG8_STAGE(PG8_SA(0, 1), a2 + hstep, voffA);
            PG8_WAIT_V(8); PG8_WAIT_L(0); PG8_BAR; PG8_MMA(0, 0, At, B0); PG8_MMA(0, 1, At, B1); PG8_BAR; PG8_SCHED;
            PG8_LDA(At, 1, 1); PG8_STAGE(PG8_SB(1, 0), b3, voffB); PG8_STAGE(PG8_SB(1, 1), b3 + hstep, voffB); PG8_STAGE(PG8_SA(1, 0), a3, voffA);
            PG8_WAIT_V(8); PG8_WAIT_L(0); PG8_BAR; PG8_MMA(1, 0, At, B0); PG8_MMA(1, 1, At, B1); PG8_BAR; PG8_SCHED;
#endif
            } else {
            PG8_LDB(B0, 0, 0); PG8_SCHED; PG8_LDA(At, 0, 0); PG8_STAGE(PG8_SA(1, 1), a1 + hstep, voffA);
            PG8_WAIT_L(8); PG8_BAR; PG8_WAIT_L(0); PG8_MMA(0, 0, At, B0); PG8_BAR; PG8_SCHED;
            PG8_LDB(B1, 0, 1); PG8_STAGE(PG8_SB(0, 0), b2, voffB);
            PG8_BAR; PG8_WAIT_L(0); PG8_MMA(0, 1, At, B1); PG8_BAR;
            PG8_LDA(At, 0, 1); PG8_STAGE(PG8_SA(0, 0), a2, voffA);
            PG8_BAR; PG8_WAIT_L(0); PG8_MMA(1, 0, At, B0); PG8_BAR; PG8_SCHED;
            PG8_STAGE(PG8_SB(0, 1), b2 + hstep, voffB);
            PG8_WAIT_V(6); PG8_BAR; PG8_MMA(1, 1, At, B1); PG8_BAR;
            PG8_LDB(B0, 1, 0); PG8_SCHED; PG8_LDA(At, 1, 0); PG8_STAGE(PG8_SA(0, 1), a2 + hstep, voffA);
            PG8_WAIT_L(8); PG8_BAR; PG8_WAIT_L(0); PG8_MMA(0, 0, At, B0); PG8_BAR; PG8_SCHED;
            PG8_LDB(B1, 1, 1); PG8_STAGE(PG8_SB(1, 0), b3, voffB);
            PG8_BAR; PG8_WAIT_L(0); PG8_MMA(0, 1, At, B1); PG8_BAR;
            PG8_LDA(At, 1, 1); PG8_STAGE(PG8_SA(1, 0), a3, voffA);
            PG8_BAR; PG8_WAIT_L(0); PG8_MMA(1, 0, At, B0); PG8_BAR; PG8_SCHED;
            PG8_STAGE(PG8_SB(1, 1), b3 + hstep, voffB);
            PG8_WAIT_V(6); PG8_BAR; PG8_MMA(1, 1, At, B1); PG8_BAR;
            }
        }
        if constexpr (ALIGN_EPI) { if (wr == 0) PG8_BAR; }
        if constexpr (!Epi::AFTER_DRAIN) { E(acc, cur, wr, wc, fr, fq, pre); S.done(cur); }
        if (!has_next) break;
#pragma unroll
        for (int a = 0; a < 2; ++a)
#pragma unroll
            for (int b = 0; b < 2; ++b)
#pragma unroll
                for (int m = 0; m < 4; ++m)
#pragma unroll
                    for (int n = 0; n < 2; ++n) acc[a][b][m][n] = (f32x4){0.f, 0.f, 0.f, 0.f};
        cur = nxt; cA = nA; cB = nB; ++ui;
        E.prefetch(cur, wr, fr, pre);
        if constexpr (ALIGN_EPI) { if (wr == 1) PG8_BAR; }
    }
    PG8_WAIT_V(0);
    if constexpr (!ALIGN_EPI) { if (wr == 0) PG8_BAR; }
    PG8_BAR;
    if constexpr (Epi::AFTER_DRAIN) { E.fused(acc, cur, wr, wc, fr, fq, lds, wid, lane); S.done(cur); }
#undef PG8_SA
#undef PG8_SB
#undef PG8_STAGE
#undef PG8_LDA
#undef PG8_LDB
#undef PG8_MMA
#undef PG8_MMAQ
#undef PG8_M1
#undef PG8_M2
#undef PG8_STAGE1
#undef PG8_WAIT_V
#undef PG8_WAIT_L
#undef PG8_BAR
#undef PG8_SCHED
}
}

constexpr int NWAVES = 8, NTHR = 512;
constexpr int BATCH = 8, SEQ = 8192, D = 1024, M = BATCH * SEQ, FF = 2816, NGU = 2 * FF, NIN = 2568, NINP = 2816, ZW = 2560, NCHK = SEQ / 64, NHEAD = 4;
constexpr int NTASK = BATCH * NHEAD * NCHK;
constexpr float EPS = 1e-6f;
constexpr size_t MiB = 1u << 20;
constexpr size_t WS_WGU1 = 2 * MiB, WS_WD1 = 13 * MiB, WS_WIN = 19 * MiB, WS_WOUT = 25 * MiB, WS_WGU2 = 27 * MiB, WS_WD2 = 38 * MiB, WS_SGUW = 44 * MiB;
constexpr size_t WS_RSS = 45 * MiB, WS_GATES = 46 * MiB, WS_ML = 48 * MiB, WS_NST = 49 * MiB;
constexpr size_t WS_XB = 64 * MiB, WS_HID = 192 * MiB, WS_Z = 192 * MiB, WS_Y = 544 * MiB, WS_CST = 672 * MiB, WS_END = 800 * MiB;
constexpr int LDS_BYTES = 147456, MISC_OFF = LDS_BYTES - 128;
constexpr size_t WS_CTL = 0, CTL_ZERO_BYTES = 65536;

#define LAS __attribute__((address_space(3)))
typedef unsigned short bf16;
typedef unsigned u32x4 __attribute__((ext_vector_type(4)));
typedef unsigned u32x2 __attribute__((ext_vector_type(2)));
typedef float f32x4 __attribute__((ext_vector_type(4)));
typedef short bf16x8 __attribute__((ext_vector_type(8)));
#define LDS_WAIT() asm volatile("s_waitcnt lgkmcnt(0)" ::: "memory")
#define LBAR() do { asm volatile("s_waitcnt lgkmcnt(0)" ::: "memory"); __builtin_amdgcn_s_barrier(); asm volatile("" ::: "memory"); } while (0)
__device__ __forceinline__ unsigned f2bf(float f) { unsigned u = __builtin_bit_cast(unsigned, f); return (u + 0x7fffu + ((u >> 16) & 1u)) >> 16; }
__device__ __forceinline__ unsigned pk2(float lo, float hi) { return f2bf(lo) | (f2bf(hi) << 16); }
__device__ __forceinline__ float bflo(unsigned w) { return __builtin_bit_cast(float, w << 16); }
__device__ __forceinline__ float bfhi(unsigned w) { return __builtin_bit_cast(float, w & 0xffff0000u); }
__device__ __forceinline__ float wave_sum(float v) {
#pragma unroll
    for (int o = 1; o < 64; o <<= 1) v += __shfl_xor(v, o);
    return v;
}
__device__ __forceinline__ float wave_max(float v) {
#pragma unroll
    for (int o = 1; o < 64; o <<= 1) v = fmaxf(v, __shfl_xor(v, o));
    return v;
}
template <int CTRL, int ROWMASK> __device__ __forceinline__ float dpp_mov(float ident, float src) {
    return __builtin_bit_cast(float, __builtin_amdgcn_update_dpp(__builtin_bit_cast(int, ident), __builtin_bit_cast(int, src), CTRL, ROWMASK, 0xf, false));
}
__device__ __forceinline__ float scan_add(float v, int) {
    v += dpp_mov<0x111, 0xf>(0.f, v); v += dpp_mov<0x112, 0xf>(0.f, v); v += dpp_mov<0x114, 0xf>(0.f, v); v += dpp_mov<0x118, 0xf>(0.f, v);
    v += dpp_mov<0x142, 0xa>(0.f, v); v += dpp_mov<0x143, 0xc>(0.f, v);
    return v;
}
__device__ __forceinline__ float scan_max(float v, int) {
    const float ninf = -__builtin_inff();
    v = fmaxf(v, dpp_mov<0x111, 0xf>(ninf, v)); v = fmaxf(v, dpp_mov<0x112, 0xf>(ninf, v)); v = fmaxf(v, dpp_mov<0x114, 0xf>(ninf, v)); v = fmaxf(v, dpp_mov<0x118, 0xf>(ninf, v));
    v = fmaxf(v, dpp_mov<0x142, 0xa>(ninf, v)); v = fmaxf(v, dpp_mov<0x143, 0xc>(ninf, v));
    return v;
}
__device__ __forceinline__ float logsigmoid_f(float x) { const float e = __expf(-fabsf(x)); return fminf(x, 0.f) - ((e < 1e-4f) ? e * (1.0f - 0.5f * e) : __logf(1.0f + e)); }

struct Args {
    const float* in[22]; float* out; unsigned char* ws; int ph_lo, ph_hi;
};
enum { I_X = 0, I_N1, I_G1, I_U1, I_D1, I_MIXN, I_WIN, I_LNG, I_LNB, I_SGUW, I_SGUB, I_CONVW, I_CONVB, I_IGB, I_FGB, I_MHN, I_WOUT, I_N2, I_G2, I_U2, I_D2, I_FINALN };

__device__ __forceinline__ void tr_item(const float* __restrict__ W, int K, int N, const float* __restrict__ gain, bf16* WT, int drow0, int k0, int n0, LAS float* scr, int lane) {
    const int kk8 = lane >> 3, c4 = (lane & 7) * 4; const bool ok = (n0 + c4) < N;
    f32x4 v[8];
#pragma unroll
    for (int i = 0; i < 8; ++i) { const int kk = 8 * i + kk8; v[i] = ok ? *(const f32x4*)(W + (size_t)(k0 + kk) * N + n0 + c4) : (f32x4){0.f, 0.f, 0.f, 0.f}; }
#pragma unroll
    for (int i = 0; i < 8; ++i) { const int kk = 8 * i + kk8; const float g = gain ? gain[k0 + kk] : 1.0f; LAS float* d = scr + kk * 33 + c4;
        d[0] = v[i][0] * g; d[1] = v[i][1] * g; d[2] = v[i][2] * g; d[3] = v[i][3] * g; }
    LDS_WAIT(); asm volatile("" ::: "memory");
    const int c = lane & 7;
#pragma unroll
    for (int j = 0; j < 4; ++j) { const int nn = (lane >> 3) + 8 * j; const LAS float* s = scr + (8 * c) * 33 + nn;
        u32x4 o; o.x = pk2(s[0 * 33], s[1 * 33]); o.y = pk2(s[2 * 33], s[3 * 33]); o.z = pk2(s[4 * 33], s[5 * 33]); o.w = pk2(s[6 * 33], s[7 * 33]);
        *(u32x4*)(WT + (size_t)(drow0 + nn) * K + k0 + 8 * c) = o; }
    LDS_WAIT(); asm volatile("" ::: "memory");
}
__device__ __forceinline__ void p0_prologue(const Args& a, LAS unsigned char* lds, int vcu, int G, int tid) {
    const int wave = __builtin_amdgcn_readfirstlane(tid >> 6), lane = tid & 63;
    unsigned char* ws = a.ws;
    LAS float* scr = (LAS float*)(lds + wave * 16384);
    const int gw = vcu * NWAVES + wave, NGW = G * NWAVES;
    constexpr int IT_GU = 16 * 88, IT_D = 44 * 32, IT_IN = 16 * 88, IT_OUT = 16 * 32;
    constexpr int NITEMS = 4 * IT_GU + 2 * IT_D + IT_IN + IT_OUT;
    for (int it = gw; it < NITEMS; it += NGW) {
        int r = it;
        if (r < 2 * IT_GU) {
            const int s = r / IT_GU; r -= s * IT_GU; const int kb = r / 88, nb = r % 88, n0 = nb * 32;
            tr_item(a.in[s ? I_U1 : I_G1], D, FF, a.in[I_N1], (bf16*)(ws + WS_WGU1), 256 * (n0 >> 7) + 128 * s + (n0 & 127), kb * 64, n0, scr, lane); continue; }
        r -= 2 * IT_GU;
        if (r < 2 * IT_GU) {
            const int s = r / IT_GU; r -= s * IT_GU; const int kb = r / 88, nb = r % 88, n0 = nb * 32;
            tr_item(a.in[s ? I_U2 : I_G2], D, FF, a.in[I_N2], (bf16*)(ws + WS_WGU2), 256 * (n0 >> 7) + 128 * s + (n0 & 127), kb * 64, n0, scr, lane); continue; }
        r -= 2 * IT_GU;
        if (r < 2 * IT_D) {
            const int s = r / IT_D; r -= s * IT_D; const int kb = r / 32, nb = r % 32, n0 = nb * 32;
            tr_item(a.in[s ? I_D2 : I_D1], FF, D, nullptr, (bf16*)(ws + (s ? WS_WD2 : WS_WD1)), n0, kb * 64, n0, scr, lane); continue; }
        r -= 2 * IT_D;
        if (r < IT_IN) { const int kb = r / 88, nb = r % 88, n0 = nb * 32;
            tr_item(a.in[I_WIN], D, NIN, a.in[I_MIXN], (bf16*)(ws + WS_WIN), n0, kb * 64, n0, scr, lane); continue; }
        r -= IT_IN;
        { const int kb = r / 32, nb = r % 32, n0 = nb * 32;
            tr_item(a.in[I_WOUT], D, D, nullptr, (bf16*)(ws + WS_WOUT), n0, kb * 64, n0, scr, lane); }
    }
    {
        float* rss0 = (float*)(ws + WS_RSS); bf16* XB = (bf16*)(ws + WS_XB); const float* x = a.in[I_X];
        for (int m0 = gw * 4; m0 < M; m0 += NGW * 4) {
            f32x4 v[4][4];
#pragma unroll
            for (int r = 0; r < 4; ++r) { const f32x4* xr = (const f32x4*)(x + (size_t)(m0 + r) * D) + lane;
#pragma unroll
                for (int j = 0; j < 4; ++j) v[r][j] = __builtin_nontemporal_load(xr + 64 * j); }
#pragma unroll
            for (int r = 0; r < 4; ++r) { unsigned long long* o8 = (unsigned long long*)(XB + (size_t)(m0 + r) * D) + lane; float s = 0.f;
#pragma unroll
                for (int j = 0; j < 4; ++j) { s += (v[r][j].x * v[r][j].x + v[r][j].y * v[r][j].y) + (v[r][j].z * v[r][j].z + v[r][j].w * v[r][j].w);
                    o8[64 * j] = (unsigned long long)pk2(v[r][j].x, v[r][j].y) | ((unsigned long long)pk2(v[r][j].z, v[r][j].w) << 32); }
                s = wave_sum(s); if (lane == 0) rss0[m0 + r] = s; }
        }
    }
    {
        float* rss = (float*)(ws + WS_RSS) + M; const int gt = vcu * NTHR + tid, NGT = G * NTHR;
        for (int i = gt; i < 3 * M; i += NGT) rss[i] = 0.f;
        bf16* sw = (bf16*)(ws + WS_SGUW); const float* w = a.in[I_SGUW];
        for (int i = gt; i < 4 * 128 * 128; i += NGT) { const int t = (i >> 7) & 127, s = i & 127; sw[i] = (bf16)(((t >> 6) >= (s >> 6)) ? f2bf(w[i]) : 0u); }
    }
}

__device__ __forceinline__ void sgu_chunk(const Args& a, LAS unsigned char* lds, int chunk, int tid) {
    const int wave = __builtin_amdgcn_readfirstlane(tid >> 6), lane = tid & 63, fr = lane & 15, fq = lane >> 4;
    unsigned char* ws = a.ws;
    const bf16* Z = (const bf16*)(ws + WS_Z); bf16* Y = (bf16*)(ws + WS_Y); const bf16* SW = (const bf16*)(ws + WS_SGUW);
    constexpr int VS = 136;
    LAS bf16* vT = (LAS bf16*)lds;
    LAS float* st = (LAS float*)(lds + 512 * VS * 2);
    bf16x8 wfr[4][4]; float bsv[4];
    { const int tt = 16 * wave + fr;
#pragma unroll
      for (int g = 0; g < 4; ++g) { bsv[g] = a.in[I_SGUB][g * 128 + tt];
#pragma unroll
          for (int ks = 0; ks < 4; ++ks) wfr[g][ks] = *(const bf16x8*)(SW + ((size_t)(g * 128 + tt) * 128 + 32 * ks + 8 * fq)); } }
    {
        const int t = tid & 127, g = tid >> 7;
        const u32x4* zr = (const u32x4*)(Z + ((size_t)chunk * 128 + t) * ZW + 512 + g * 128);
        u32x4 raw[16]; float s = 0.f, ss = 0.f;
#pragma unroll
        for (int i = 0; i < 16; ++i) { raw[i] = zr[i];
#pragma unroll
            for (int j = 0; j < 4; ++j) { const float lo = bflo(raw[i][j]), hi = bfhi(raw[i][j]); s += lo + hi; ss += lo * lo + hi * hi; } }
        st[(g * 128 + t) * 2] = s; st[(g * 128 + t) * 2 + 1] = ss;
        __syncthreads();
        float S = 0.f, SS = 0.f;
#pragma unroll
        for (int gg = 0; gg < 4; ++gg) { S += st[(gg * 128 + t) * 2]; SS += st[(gg * 128 + t) * 2 + 1]; }
        const float mu = S * (1.f / 512.f), var = fmaxf(SS * (1.f / 512.f) - mu * mu, 0.f), rstd = 1.0f / sqrtf(var + EPS);
        const float* lg = a.in[I_LNG] + g * 128; const float* lb = a.in[I_LNB] + g * 128;
#pragma unroll
        for (int i = 0; i < 16; ++i)
#pragma unroll
            for (int j = 0; j < 4; ++j) { const int d = 8 * i + 2 * j;
                const float y0 = (bflo(raw[i][j]) - mu) * rstd * lg[d] + lb[d], y1 = (bfhi(raw[i][j]) - mu) * rstd * lg[d + 1] + lb[d + 1];
                vT[(g * 128 + d) * VS + t] = (bf16)f2bf(y0); vT[(g * 128 + d + 1) * VS + t] = (bf16)f2bf(y1); }
    }
    __syncthreads();
    {
        const int tb = wave, tt = 16 * tb + fr; const size_t row = (size_t)chunk * 128 + tt; const bool full = tb >= 4;
#pragma unroll
        for (int g = 0; g < 4; ++g) {
            f32x4 acc[4][2];
#pragma unroll
            for (int p = 0; p < 4; ++p) { acc[p][0] = (f32x4){0.f, 0.f, 0.f, 0.f}; acc[p][1] = (f32x4){0.f, 0.f, 0.f, 0.f}; }
            u32x4 uu[4];
#pragma unroll
            for (int p = 0; p < 4; ++p) uu[p] = *(const u32x4*)(Z + row * ZW + g * 128 + 32 * p + 8 * fq);
#pragma unroll
            for (int ks = 0; ks < 4; ++ks) {
                if (ks < 2 || full) {
                    const bf16x8 wf = wfr[g][ks];
#pragma unroll
                    for (int p = 0; p < 4; ++p)
#pragma unroll
                        for (int n = 0; n < 2; ++n) { const int drow = g * 128 + 32 * p + 8 * (fr >> 2) + 4 * n + (fr & 3);
                            const bf16x8 vf = *(const LAS bf16x8*)(vT + drow * VS + 32 * ks + 8 * fq);
                            acc[p][n] = __builtin_amdgcn_mfma_f32_16x16x32_bf16(vf, wf, acc[p][n], 0, 0, 0); }
                }
            }
            const float bias = bsv[g];
#pragma unroll
            for (int p = 0; p < 4; ++p) { const int d0 = g * 128 + 32 * p + 8 * fq; const u32x4 u = uu[p];
                u32x4 o;
                o.x = pk2(bflo(u.x) * (acc[p][0][0] + bias), bfhi(u.x) * (acc[p][0][1] + bias)); o.y = pk2(bflo(u.y) * (acc[p][0][2] + bias), bfhi(u.y) * (acc[p][0][3] + bias));
                o.z = pk2(bflo(u.z) * (acc[p][1][0] + bias), bfhi(u.z) * (acc[p][1][1] + bias)); o.w = pk2(bflo(u.w) * (acc[p][1][2] + bias), bfhi(u.w) * (acc[p][1][3] + bias));
                *(u32x4*)(Y + row * 1024 + d0) = o; }
        }
    }
    __syncthreads();
}

__device__ __forceinline__ void conv8_fetch(const bf16* Z, int b, int pos, int ch, u32x4 (&z)[4]) {
#pragma unroll
    for (int j = 0; j < 4; ++j) { const int tt = pos - 3 + j; z[j] = (tt >= 0) ? *(const u32x4*)(Z + ((size_t)b * SEQ + tt) * ZW + 1024 + ch) : (u32x4){0u, 0u, 0u, 0u}; }
}
__device__ __forceinline__ void conv8_math(const Args& a, int ch, const u32x4 (&zz)[4], float (&o)[8]) {
    const float* cw = a.in[I_CONVW]; const float* cb = a.in[I_CONVB];
    const f32x4 b0 = *(const f32x4*)(cb + ch), b1 = *(const f32x4*)(cb + ch + 4);
    float acc[8] = {b0[0], b0[1], b0[2], b0[3], b1[0], b1[1], b1[2], b1[3]};
#pragma unroll
    for (int j = 0; j < 4; ++j) { const u32x4 z = zz[j];
        const f32x4 w0 = *(const f32x4*)(cw + j * 512 + ch), w1 = *(const f32x4*)(cw + j * 512 + ch + 4);
        acc[0] += w0[0] * bflo(z.x); acc[1] += w0[1] * bfhi(z.x); acc[2] += w0[2] * bflo(z.y); acc[3] += w0[3] * bfhi(z.y);
        acc[4] += w1[0] * bflo(z.z); acc[5] += w1[1] * bfhi(z.z); acc[6] += w1[2] * bflo(z.w); acc[7] += w1[3] * bfhi(z.w); }
#pragma unroll
    for (int i = 0; i < 8; ++i) o[i] = pg8::silu_f(acc[i]);
}

struct M1Pre { u32x4 zk[4]; u32x4 vv[2]; float fpre, ipre; };
__device__ __forceinline__ void m1_fetch(const Args& a, int task, int tid, M1Pre& P) {
    const int wave = __builtin_amdgcn_readfirstlane(tid >> 6), lane = tid & 63;
    const bf16* Z = (const bf16*)(a.ws + WS_Z); const float* gates = (const float*)(a.ws + WS_GATES);
    const int b = task / (NHEAD * NCHK), h = (task / NCHK) % NHEAD, c = task % NCHK; const size_t row0 = (size_t)b * SEQ + c * 64;
    if (wave == 0) { P.fpre = gates[(row0 + lane) * 8 + 4 + h]; P.ipre = gates[(row0 + lane) * 8 + h]; }
    const int l = tid & 63, c8 = wave * 8, v16 = wave * 16;
    conv8_fetch(Z, b, c * 64 + l, 256 + h * 64 + c8, P.zk);
    const u32x4* vr = (const u32x4*)(Z + (row0 + l) * ZW + 1536 + h * 128 + v16); P.vv[0] = vr[0]; P.vv[1] = vr[1];
}
__device__ __forceinline__ void m1_body(const Args& a, LAS unsigned char* lds, int task, int tid, M1Pre& P, bool has_next, int next_task, M1Pre& Pn) {
    const int wave = __builtin_amdgcn_readfirstlane(tid >> 6), lane = tid & 63, fr = lane & 15, fq = lane >> 4;
    unsigned char* ws = a.ws;
    float* ML = (float*)(ws + WS_ML); float* BL = ML + NTASK; bf16* CST = (bf16*)(ws + WS_CST); float* NST = (float*)(ws + WS_NST);
    const int h = (task / NCHK) % NHEAD;
    constexpr int KS = 72;
    LAS float* wg = (LAS float*)lds;
    LAS bf16* kwT = (LAS bf16*)(lds + 256);
    LAS bf16* vT = (LAS bf16*)(lds + 256 + 64 * KS * 2);
    if (wave == 0) {
        const float fpre = P.fpre + a.in[I_FGB][h], ipre = P.ipre + a.in[I_IGB][h];
        const float bc = scan_add(logsigmoid_f(fpre), lane), blast = __shfl(bc, 63);
        const float g = blast - bc + ipre, mloc = wave_max(g);
        wg[lane] = expf(g - mloc);
        if (lane == 0) { ML[task] = mloc; BL[task] = blast; }
    }
    const int l = tid & 63, c8 = wave * 8, v16 = wave * 16;
    float kv[8]; conv8_math(a, 256 + h * 64 + c8, P.zk, kv);
#pragma unroll
    for (int q = 0; q < 2; ++q) { const u32x4 z = P.vv[q];
#pragma unroll
        for (int j = 0; j < 4; ++j) { vT[(v16 + 8 * q + 2 * j) * KS + l] = (bf16)(z[j] & 0xffffu); vT[(v16 + 8 * q + 2 * j + 1) * KS + l] = (bf16)(z[j] >> 16); } }
    LBAR();
    {
        const float sc = 0.125f * wg[l];
#pragma unroll
        for (int i = 0; i < 8; ++i) kwT[(c8 + i) * KS + l] = (bf16)f2bf(kv[i] * sc);
    }
    LBAR();
    if (has_next) m1_fetch(a, next_task, tid, Pn);
    {
        f32x4 acc[4];
#pragma unroll
        for (int kb = 0; kb < 4; ++kb) acc[kb] = (f32x4){0.f, 0.f, 0.f, 0.f};
#pragma unroll
        for (int ks = 0; ks < 2; ++ks) { const bf16x8 yf = *(const LAS bf16x8*)(vT + (16 * wave + fr) * KS + 32 * ks + 8 * fq);
#pragma unroll
            for (int kb = 0; kb < 4; ++kb) { const bf16x8 xf = *(const LAS bf16x8*)(kwT + (16 * kb + fr) * KS + 32 * ks + 8 * fq);
                acc[kb] = __builtin_amdgcn_mfma_f32_16x16x32_bf16(xf, yf, acc[kb], 0, 0, 0); } }
        bf16* cp = CST + (size_t)task * 8192 + (16 * wave + fr) * 64 + 4 * fq;
#pragma unroll
        for (int kb = 0; kb < 4; ++kb) { u32x2 o; o.x = pk2(acc[kb][0], acc[kb][1]); o.y = pk2(acc[kb][2], acc[kb][3]); *(u32x2*)(cp + 16 * kb) = o; }
        if (tid < 64) { float s = 0.f;
#pragma unroll 8
            for (int ll = 0; ll < 64; ++ll) s += __builtin_bit_cast(float, (unsigned)kwT[tid * KS + ll] << 16);
            NST[(size_t)task * 64 + tid] = s; }
    }
    LBAR();
}

__device__ __forceinline__ void scan_block(const Args& a, LAS unsigned char* lds, int vb, int tid) {
    unsigned char* ws = a.ws;
    float* ML = (float*)(ws + WS_ML); float* BL = ML + NTASK; float* MP = ML + 2 * NTASK; bf16* CST = (bf16*)(ws + WS_CST); float* NST = (float*)(ws + WS_NST);
    const int bh = vb >> 3, part = vb & 7;
    LAS float* sm = (LAS float*)lds;
    if (tid < 128) { sm[tid] = ML[bh * NCHK + tid]; sm[128 + tid] = BL[bh * NCHK + tid]; }
    typedef float f32x2v __attribute__((ext_vector_type(2)));
    unsigned* cp = (unsigned*)(CST + (size_t)bh * NCHK * 8192) + part * 512 + tid;
    const bool hasn = (part == 0 && tid < 64); float* np = NST + (size_t)bh * NCHK * 64 + tid;
    f32x2v cs = (f32x2v){0.f, 0.f}; float ns = 0.f, ms = 0.f;
    unsigned cl[8], cn[8]; float nl[8], nn[8];
#pragma unroll
    for (int i = 0; i < 8; ++i) { cl[i] = cp[(size_t)i * 4096]; nl[i] = hasn ? np[i * 64] : 0.f; }
    LBAR();
    for (int c0 = 0; c0 < NCHK; c0 += 8) {
        if (c0 + 8 < NCHK) {
#pragma unroll
            for (int i = 0; i < 8; ++i) { cn[i] = cp[(size_t)(c0 + 8 + i) * 4096]; nn[i] = hasn ? np[(c0 + 8 + i) * 64] : 0.f; }
        }
#pragma unroll
        for (int i = 0; i < 8; ++i) {
            const float ml = sm[c0 + i], bl = sm[128 + c0 + i];
            const float mn = fmaxf(bl + ms, ml), aa = __expf(bl + ms - mn), ee = __expf(ml - mn);
            cp[(size_t)(c0 + i) * 4096] = pk2(cs.x, cs.y); if (hasn) np[(c0 + i) * 64] = ns;
            if (part == 0 && tid == 0) MP[bh * NCHK + c0 + i] = ms;
            cs = cs * aa + (f32x2v){bflo(cl[i]), bfhi(cl[i])} * ee; ns = ns * aa + nl[i] * ee; ms = mn;
        }
#pragma unroll
        for (int i = 0; i < 8; ++i) { cl[i] = cn[i]; nl[i] = nn[i]; }
    }
    LBAR();
}

struct M3Pre { u32x4 zq[2][4]; u32x4 vv[2]; u32x4 cc[2]; u32x4 ov[2]; float fpre, ipre, mp, nst; };
__device__ __forceinline__ void m3_fetch(const Args& a, int task, int tid, M3Pre& P) {
    const int wave = __builtin_amdgcn_readfirstlane(tid >> 6), lane = tid & 63, fr = lane & 15, fq = lane >> 4;
    unsigned char* ws = a.ws;
    const bf16* Z = (const bf16*)(ws + WS_Z); const float* gates = (const float*)(ws + WS_GATES);
    const float* MP = (const float*)(ws + WS_ML) + 2 * NTASK; const bf16* CST = (const bf16*)(ws + WS_CST); const float* NST = (const float*)(ws + WS_NST);
    const int b = task / (NHEAD * NCHK), h = (task / NCHK) % NHEAD, c = task % NCHK; const size_t row0 = (size_t)b * SEQ + c * 64;
    if (wave == 0) { P.fpre = gates[(row0 + lane) * 8 + 4 + h]; P.ipre = gates[(row0 + lane) * 8 + h]; P.mp = MP[task]; P.nst = NST[(size_t)task * 64 + lane]; }
    { const int mat = tid >> 8, l = (tid & 255) >> 2, c16 = (tid & 3) * 16;
#pragma unroll
      for (int q = 0; q < 2; ++q) conv8_fetch(Z, b, c * 64 + l, mat * 256 + h * 64 + c16 + 8 * q, P.zq[q]); }
    { const int l = tid & 63, v16 = wave * 16; const u32x4* vr = (const u32x4*)(Z + (row0 + l) * ZW + 1536 + h * 128 + v16); P.vv[0] = vr[0]; P.vv[1] = vr[1]; }
    { const int v = tid >> 2, k16 = (tid & 3) * 16; const u32x4* cr = (const u32x4*)(CST + (size_t)task * 8192 + v * 64 + k16); P.cc[0] = cr[0]; P.cc[1] = cr[1]; }
    { const int tb = wave & 3, vh = wave >> 2, t = 16 * tb + fr;
#pragma unroll
      for (int p = 0; p < 2; ++p) P.ov[p] = *(const u32x4*)(Z + (row0 + t) * ZW + 2048 + h * 128 + vh * 64 + 32 * p + 8 * fq); }
}
__device__ __forceinline__ void m3_body(const Args& a, LAS unsigned char* lds, int task, int tid, M3Pre& P, bool has_next, int next_task, M3Pre& Pn) {
    const int wave = __builtin_amdgcn_readfirstlane(tid >> 6), lane = tid & 63, fr = lane & 15, fq = lane >> 4;
    unsigned char* ws = a.ws;
    bf16* Y = (bf16*)(ws + WS_Y);
    const int b = task / (NHEAD * NCHK), h = (task / NCHK) % NHEAD, c = task % NCHK; const size_t row0 = (size_t)b * SEQ + c * 64;
    constexpr int QS = 72, PS = 136;
    LAS float* bm = (LAS float*)lds; LAS float* ib = bm + 64; LAS float* ai = bm + 128; LAS float* emt = bm + 192;
    LAS float* hs = (LAS float*)(lds + 1024);
    LAS bf16* Qs = (LAS bf16*)(lds + 2048);
    LAS bf16* Ks = (LAS bf16*)(lds + 2048 + 9216);
    LAS bf16* Ps = (LAS bf16*)(lds + 20480);
    LAS bf16* Rs = (LAS bf16*)(lds + 37888);
    if (wave == 0) {
        const float fpre = P.fpre + a.in[I_FGB][h], ipre = P.ipre + a.in[I_IGB][h];
        const float bc = scan_add(logsigmoid_f(fpre), lane), ibv = ipre - bc, cm = scan_max(ibv, lane), mp = P.mp;
        const float mx = fmaxf(mp, cm), mt = bc + mx;
        bm[lane] = -mx; ib[lane] = ibv; ai[lane] = expf(mp - mx); emt[lane] = expf(-mt);
        Rs[128 * PS + lane] = (bf16)0x3f80u; Rs[128 * PS + 64 + lane] = (bf16)f2bf(P.nst);
    }
    {
        const int mat = tid >> 8, l = (tid & 255) >> 2, c16 = (tid & 3) * 16; LAS bf16* dst = (mat ? Ks : Qs) + l * QS + c16; const float sc = mat ? 0.125f : 1.0f;
#pragma unroll
        for (int q = 0; q < 2; ++q) { float kv[8]; conv8_math(a, mat * 256 + h * 64 + c16 + 8 * q, P.zq[q], kv);
            u32x4 o; o.x = pk2(kv[0] * sc, kv[1] * sc); o.y = pk2(kv[2] * sc, kv[3] * sc); o.z = pk2(kv[4] * sc, kv[5] * sc); o.w = pk2(kv[6] * sc, kv[7] * sc);
            *(LAS u32x4*)(dst + 8 * q) = o; }
    }
    {
        const int l = tid & 63, v16 = wave * 16;
#pragma unroll
        for (int q = 0; q < 2; ++q) { const u32x4 z = P.vv[q];
#pragma unroll
            for (int j = 0; j < 4; ++j) { Rs[(v16 + 8 * q + 2 * j) * PS + l] = (bf16)(z[j] & 0xffffu); Rs[(v16 + 8 * q + 2 * j + 1) * PS + l] = (bf16)(z[j] >> 16); } }
        const int v = tid >> 2, k16 = (tid & 3) * 16;
        *(LAS u32x4*)(Rs + v * PS + 64 + k16) = P.cc[0]; *(LAS u32x4*)(Rs + v * PS + 64 + k16 + 8) = P.cc[1];
    }
    const u32x4 ov0 = P.ov[0], ov1 = P.ov[1];
    LBAR();
    if (has_next) m3_fetch(a, next_task, tid, Pn);
    f32x4 gn[2][2];
    { const int vh = wave >> 2;
#pragma unroll
      for (int p = 0; p < 2; ++p) { const int v0 = h * 128 + vh * 64 + 32 * p + 8 * fq; gn[p][0] = *(const f32x4*)(a.in[I_MHN] + v0); gn[p][1] = *(const f32x4*)(a.in[I_MHN] + v0 + 4); } }
    {
        const int tb = wave & 3, sb2 = wave >> 2, t = 16 * tb + fr; const float bmt = bm[t];
#pragma unroll
        for (int e = 0; e < 2; ++e) { const int sb = 2 * sb2 + e; u32x2 o = (u32x2){0u, 0u};
            if (sb <= tb) { f32x4 acc = (f32x4){0.f, 0.f, 0.f, 0.f};
#pragma unroll
                for (int ks = 0; ks < 2; ++ks) { const bf16x8 xf = *(const LAS bf16x8*)(Ks + (16 * sb + fr) * QS + 32 * ks + 8 * fq), yf = *(const LAS bf16x8*)(Qs + t * QS + 32 * ks + 8 * fq);
                    acc = __builtin_amdgcn_mfma_f32_16x16x32_bf16(xf, yf, acc, 0, 0, 0); }
                float w[4];
#pragma unroll
                for (int j = 0; j < 4; ++j) { const int s = 16 * sb + 4 * fq + j; w[j] = (s <= t) ? __expf(bmt + ib[s]) * acc[j] : 0.f; }
                o.x = pk2(w[0], w[1]); o.y = pk2(w[2], w[3]); }
            *(LAS u32x2*)(Ps + t * PS + 16 * sb + 4 * fq) = o; }
        const int t2 = tid >> 3, k8 = (tid & 7) * 8; const float av = ai[t2]; const u32x4 qv = *(const LAS u32x4*)(Qs + t2 * QS + k8);
        u32x4 o; o.x = pk2(bflo(qv.x) * av, bfhi(qv.x) * av); o.y = pk2(bflo(qv.y) * av, bfhi(qv.y) * av); o.z = pk2(bflo(qv.z) * av, bfhi(qv.z) * av); o.w = pk2(bflo(qv.w) * av, bfhi(qv.w) * av);
        *(LAS u32x4*)(Ps + t2 * PS + 64 + k8) = o;
    }
    LBAR();
    {
        const int tb = wave & 3, vh = wave >> 2, t = 16 * tb + fr;
        f32x4 acc[2][2], accd = (f32x4){0.f, 0.f, 0.f, 0.f};
#pragma unroll
        for (int p = 0; p < 2; ++p) { acc[p][0] = (f32x4){0.f, 0.f, 0.f, 0.f}; acc[p][1] = (f32x4){0.f, 0.f, 0.f, 0.f}; }
#pragma unroll
        for (int ks = 0; ks < 4; ++ks) { const bf16x8 yf = *(const LAS bf16x8*)(Ps + t * PS + 32 * ks + 8 * fq);
#pragma unroll
            for (int p = 0; p < 2; ++p)
#pragma unroll
                for (int n = 0; n < 2; ++n) { const int vrow = vh * 64 + 32 * p + 8 * (fr >> 2) + 4 * n + (fr & 3);
                    const bf16x8 xf = *(const LAS bf16x8*)(Rs + vrow * PS + 32 * ks + 8 * fq);
                    acc[p][n] = __builtin_amdgcn_mfma_f32_16x16x32_bf16(xf, yf, acc[p][n], 0, 0, 0); }
            const bf16x8 xd = *(const LAS bf16x8*)(Rs + 128 * PS + 32 * ks + 8 * fq);
            accd = __builtin_amdgcn_mfma_f32_16x16x32_bf16(xd, yf, accd, 0, 0, 0); }
        const float den = accd[0], inv = 1.0f / fmaxf(fabsf(den), emt[t]);
        float ssq = 0.f;
#pragma unroll
        for (int p = 0; p < 2; ++p)
#pragma unroll
            for (int n = 0; n < 2; ++n) { acc[p][n] = acc[p][n] * inv; ssq += (acc[p][n][0] * acc[p][n][0] + acc[p][n][1] * acc[p][n][1]) + (acc[p][n][2] * acc[p][n][2] + acc[p][n][3] * acc[p][n][3]); }
        ssq += __shfl_xor(ssq, 16); ssq += __shfl_xor(ssq, 32);
        if (fq == 0) hs[t * 2 + vh] = ssq;
        LBAR();
        const float rs = __builtin_amdgcn_rsqf((hs[t * 2] + hs[t * 2 + 1]) * (1.f / 128.f) + EPS);
#pragma unroll
        for (int p = 0; p < 2; ++p) { const int v0 = h * 128 + vh * 64 + 32 * p + 8 * fq;
            const u32x4 ov = p ? ov1 : ov0; const f32x4 g0 = gn[p][0], g1 = gn[p][1];
            u32x4 o;
            o.x = pk2(acc[p][0][0] * rs * g0[0] * pg8::sigmoid_f(bflo(ov.x)), acc[p][0][1] * rs * g0[1] * pg8::sigmoid_f(bfhi(ov.x)));
            o.y = pk2(acc[p][0][2] * rs * g0[2] * pg8::sigmoid_f(bflo(ov.y)), acc[p][0][3] * rs * g0[3] * pg8::sigmoid_f(bfhi(ov.y)));
            o.z = pk2(acc[p][1][0] * rs * g1[0] * pg8::sigmoid_f(bflo(ov.z)), acc[p][1][1] * rs * g1[1] * pg8::sigmoid_f(bfhi(ov.z)));
            o.w = pk2(acc[p][1][2] * rs * g1[2] * pg8::sigmoid_f(bflo(ov.w)), acc[p][1][3] * rs * g1[3] * pg8::sigmoid_f(bfhi(ov.w)));
            *(u32x4*)(Y + (row0 + t) * 1024 + 512 + v0) = o; }
    }
    LBAR();
}

#define XB_TMO      128
#define XB_XCNT(j)  (256  + 64 * (j))
#define XB_XSUB(j)  (1280 + 64 * (j))
#define XB_XGEN(j)  (2304 + 64 * (j))
#define XB_TOP      3328
#define XB_TOPGEN   3392
#define XCD_BAR_WORDS 3456
#define XB_SPIN_CAP (1u << 18)

__device__ __forceinline__ unsigned xb_ld(unsigned* p)              { return __hip_atomic_load(p, __ATOMIC_RELAXED, __HIP_MEMORY_SCOPE_AGENT); }
__device__ __forceinline__ unsigned xb_add(unsigned* p, unsigned v) { return __hip_atomic_fetch_add(p, v, __ATOMIC_RELAXED, __HIP_MEMORY_SCOPE_AGENT); }
__device__ __forceinline__ unsigned xb_xcc_id() { return (unsigned)__builtin_amdgcn_s_getreg((3 << 11) | 20) & 0xFu; }
#define XB_SPIN(cond, bar) do { unsigned _sp = 0; while (cond) { __builtin_amdgcn_s_sleep(1); \
    if ((++_sp & 255u) == 0u) { if (xb_ld(&(bar)[XB_TMO])) break; if (_sp > XB_SPIN_CAP) { atomicAdd(&(bar)[XB_TMO], 1u); break; } } } } while (0)

struct XcdBarrier {
    unsigned* bar; unsigned x;
    volatile LAS unsigned* st;
};

__device__ __forceinline__ XcdBarrier xcd_barrier_post(unsigned* bar, volatile LAS unsigned* st) {
    XcdBarrier b; b.bar = bar; b.x = xb_xcc_id(); b.st = st;
    if (threadIdx.x == 0) (void)xb_add(&bar[XB_XCNT(b.x)], 1u);
    return b;
}
__device__ __forceinline__ void xcd_barrier_complete(unsigned* bar, unsigned x, unsigned& nloc, unsigned& nx) {
    const unsigned G = gridDim.x * gridDim.y * gridDim.z;
    unsigned sum, cnt, mine, sp = 0u;
    for (;;) {
        sum = 0u; cnt = 0u; mine = 0u;
#pragma unroll
        for (unsigned j = 0; j < 16; ++j) { const unsigned c = xb_ld(&bar[XB_XCNT(j)]); sum += c; cnt += (c > 0u) ? 1u : 0u; mine = (j == x) ? c : mine; }
        if (sum == G) break;
        __builtin_amdgcn_s_sleep(1);
        if ((++sp & 255u) == 0u) { if (xb_ld(&bar[XB_TMO])) break; if (sp > XB_SPIN_CAP) { atomicAdd(&bar[XB_TMO], 1u); break; } }
    }
    nloc = mine > 0u ? mine : 1u; nx = cnt > 0u ? cnt : 1u;
}

__device__ __forceinline__ void xcd_barrier(const XcdBarrier& b) {
    asm volatile("s_waitcnt vmcnt(0)" ::: "memory");
    __syncthreads();
    if (threadIdx.x == 0) {
        unsigned* bar = b.bar;
        __builtin_amdgcn_s_waitcnt(0);
        unsigned nloc = b.st[0], nx = b.st[1];
        if (nloc == 0u) { xcd_barrier_complete(bar, b.x, nloc, nx); b.st[0] = nloc; b.st[1] = nx; }
        const unsigned old = xb_add(&bar[XB_XSUB(b.x)], 1u);
        const unsigned gen = old / nloc;
        if (old + 1u == (gen + 1u) * nloc) {
            __builtin_amdgcn_fence(__ATOMIC_RELEASE, "agent");
            asm volatile("s_waitcnt vmcnt(0)" ::: "memory");
            const unsigned og = xb_add(&bar[XB_TOP], 1u);
            const unsigned tg = og / nx;
            if (og + 1u == (tg + 1u) * nx) xb_add(&bar[XB_TOPGEN], 1u);
            else XB_SPIN(xb_ld(&bar[XB_TOPGEN]) == tg, bar);
            __builtin_amdgcn_fence(__ATOMIC_ACQUIRE, "agent");
            xb_add(&bar[XB_XGEN(b.x)], 1u);
            asm volatile("s_waitcnt vmcnt(0)" ::: "memory");
        } else {
            XB_SPIN(xb_ld(&bar[XB_XGEN(b.x)]) == gen, bar);
            __builtin_amdgcn_fence(__ATOMIC_ACQUIRE, "agent");
            asm volatile("s_waitcnt vmcnt(0)" ::: "memory");
        }
    }
    __syncthreads();
}
__global__ void __launch_bounds__(NTHR, 2) fwd_megakernel(Args args) {
    extern __shared__ __attribute__((aligned(16))) unsigned char lds_raw[];
    LAS unsigned char* lds = (LAS unsigned char*)lds_raw;
    cg::grid_group grid = cg::this_grid();
    const int tid = threadIdx.x, wave = __builtin_amdgcn_readfirstlane(tid >> 6), lane = tid & 63;
    const int G = gridDim.x, bx = blockIdx.x, vcu = (G % 8 == 0) ? (bx % 8) * (G / 8) + bx / 8 : bx;
    unsigned char* ws = args.ws;
    const int lo = args.ph_lo, hi = args.ph_hi;
#define IN(k) (lo <= (k) && (k) < hi)
#define REPS(k) ((((REP_MASK) >> (k)) & 1) ? 2 : 1)
#define SEAM(k) do { if (IN(k) && IN((k) + 1)) { if (USE_CG_SYNC) grid.sync(); else xcd_barrier(xbar); } } while (0)
    volatile LAS unsigned* MISC = (volatile LAS unsigned*)(lds + MISC_OFF);
    if (tid < 32) MISC[tid] = 0u;
    __syncthreads();
    XcdBarrier xbar = xcd_barrier_post((unsigned*)(ws + WS_CTL) + 1024, MISC + 8);
    bf16* XB = (bf16*)(ws + WS_XB); bf16* HID = (bf16*)(ws + WS_HID); bf16* Zb = (bf16*)(ws + WS_Z); bf16* Yb = (bf16*)(ws + WS_Y);
    float* RSS = (float*)(ws + WS_RSS); float* X1 = args.out;

    if (hi < 0) grid.sync();
    if (IN(0)) { for (int rep = 0; rep < REPS(0); ++rep) p0_prologue(args, lds, vcu, G, tid); } SEAM(0);
    if (REPS(12) == 2) { for (int i = 0; i < 10; ++i) grid.sync(); }
    if (IN(1)) _Pragma("unroll") for (int rep = 0; rep < REPS(1); ++rep) {
        pg8::Gemm g{XB, (const bf16*)(ws + WS_WGU1), M, NGU, D}; pg8::StaticOrder S; S.init(M, NGU, G, bx);
        pg8::EpiGU E{HID, RSS, FF};
        pg8::gemm_phase<pg8::EpiGU, pg8::StaticOrder, GEMM_ALIGN, GEMM_SP2>(lds, g, S, E);
    } SEAM(1);
    if (IN(2)) {
        pg8::Gemm g{HID, (const bf16*)(ws + WS_WD1), M, D, FF}; pg8::StaticOrder S; S.init(M, D, G, bx);
        pg8::EpiRes<false> E{args.in[I_X], XB, RSS + M, 0.5f};
        pg8::gemm_phase<pg8::EpiRes<false>, pg8::StaticOrder, GEMM_ALIGN, GEMM_SP2>(lds, g, S, E);
    } SEAM(2);
    if (IN(3)) _Pragma("unroll") for (int rep = 0; rep < REPS(3); ++rep) {
        pg8::Gemm g{XB, (const bf16*)(ws + WS_WIN), M, NINP, D}; pg8::StaticOrder S; S.init(M, NINP, G, bx);
        pg8::EpiIn E{Zb, (float*)(ws + WS_GATES), RSS + M, ZW};
        pg8::gemm_phase<pg8::EpiIn, pg8::StaticOrder, GEMM_ALIGN, GEMM_SP2>(lds, g, S, E);
    } SEAM(3);
    if (IN(4)) {
        for (int rep = 0; rep < REPS(11); ++rep) for (int ch = vcu; ch < M / 128; ch += G) sgu_chunk(args, lds, ch, tid);
        { M1Pre P, Pn; int t = vcu; if (t < NTASK) m1_fetch(args, t, tid, P);
          for (; t < NTASK; t += G) { const int tn = t + G; m1_body(args, lds, t, tid, P, tn < NTASK, tn, Pn); P = Pn; } }
    } SEAM(4);
    if (IN(5)) { for (int vb = vcu; vb < 256; vb += G) scan_block(args, lds, vb, tid); } SEAM(5);
    if (IN(6)) { M3Pre P, Pn; int t = vcu; if (t < NTASK) m3_fetch(args, t, tid, P);
        for (; t < NTASK; t += G) { const int tn = t + G; m3_body(args, lds, t, tid, P, tn < NTASK, tn, Pn); P = Pn; } } SEAM(6);
    if (IN(7)) {
        pg8::Gemm g{Yb, (const bf16*)(ws + WS_WOUT), M, D, D}; pg8::StaticOrder S; S.init(M, D, G, bx);
        pg8::EpiRes<true> E{XB, XB, RSS + 2 * M, 1.0f};
        pg8::gemm_phase<pg8::EpiRes<true>, pg8::StaticOrder, GEMM_ALIGN, GEMM_SP2>(lds, g, S, E);
    } SEAM(7);
    if (IN(8)) {
        pg8::Gemm g{XB, (const bf16*)(ws + WS_WGU2), M, NGU, D}; pg8::StaticOrder S; S.init(M, NGU, G, bx);
        pg8::EpiGU E{HID, RSS + 2 * M, FF};
        pg8::gemm_phase<pg8::EpiGU, pg8::StaticOrder, GEMM_ALIGN, GEMM_SP2>(lds, g, S, E);
    } SEAM(8);
#if FUSE_FINAL
    if (IN(9)) {
        pg8::Gemm g{HID, (const bf16*)(ws + WS_WD2), M, D, FF}; pg8::StaticOrder S; S.init(M, D, G, bx);
        pg8::EpiResNorm E{X1, X1, RSS + 3 * M, (unsigned*)(ws + WS_CTL) + 8192, args.in[I_FINALN], 0.5f};
        pg8::gemm_phase<pg8::EpiResNorm, pg8::StaticOrder, GEMM_ALIGN, GEMM_SP2>(lds, g, S, E);
    }
#else
    if (IN(9)) {
        pg8::Gemm g{HID, (const bf16*)(ws + WS_WD2), M, D, FF}; pg8::StaticOrder S; S.init(M, D, G, bx);
        pg8::EpiRes<true> E{XB, XB, RSS + 3 * M, 0.5f};
        pg8::gemm_phase<pg8::EpiRes<true>, pg8::StaticOrder, GEMM_ALIGN, GEMM_SP2>(lds, g, S, E);
    } SEAM(9);
    if (IN(10)) {
        const int gw = vcu * NWAVES + wave, NGW = G * NWAVES; const float* rss3 = RSS + 3 * M; const f32x4* gn = (const f32x4*)args.in[I_FINALN];
        const f32x4 g0 = gn[lane], g1 = gn[64 + lane], g2 = gn[128 + lane], g3 = gn[192 + lane];
        for (int m0 = gw * 4; m0 < M; m0 += NGW * 4) {
            u32x2 v[4][4]; float r[4];
#pragma unroll
            for (int q = 0; q < 4; ++q) { const u32x2* xr = (const u32x2*)(XB + (size_t)(m0 + q) * D) + lane;
#pragma unroll
                for (int j = 0; j < 4; ++j) v[q][j] = __builtin_nontemporal_load(xr + 64 * j);
                r[q] = rss3[m0 + q]; }
#pragma unroll
            for (int q = 0; q < 4; ++q) { const float rs = __builtin_amdgcn_rsqf(r[q] * (1.f / 1024.f) + EPS); f32x4* o = (f32x4*)(X1 + (size_t)(m0 + q) * D) + lane;
                *(o) = ((f32x4){bflo(v[q][0].x), bfhi(v[q][0].x), bflo(v[q][0].y), bfhi(v[q][0].y)}) * rs * g0;
                *(o + 64) = ((f32x4){bflo(v[q][1].x), bfhi(v[q][1].x), bflo(v[q][1].y), bfhi(v[q][1].y)}) * rs * g1;
                *(o + 128) = ((f32x4){bflo(v[q][2].x), bfhi(v[q][2].x), bflo(v[q][2].y), bfhi(v[q][2].y)}) * rs * g2;
                *(o + 192) = ((f32x4){bflo(v[q][3].x), bfhi(v[q][3].x), bflo(v[q][3].y), bfhi(v[q][3].y)}) * rs * g3; }
        }
    }
#endif
#undef IN
#undef SEAM
}

#ifndef MK_N_LAUNCHES
#define MK_N_LAUNCHES 1
#endif
constexpr int N_PHASES = FUSE_FINAL ? 10 : 11;
extern "C" void kernel_launch(void* const* d_in, const int* in_sizes, int n_in, void* d_out, int out_size, void* d_ws, size_t ws_size, hipStream_t stream) {
    static int grid = 0;
    if (grid == 0) {
        if (n_in != 22 || in_sizes[0] != M * D || out_size != M * D || ws_size < WS_END) { fprintf(stderr, "kernel_launch: unexpected shapes (n_in %d, in0 %d, out %d, ws %zu)\n", n_in, n_in > 0 ? in_sizes[0] : -1, out_size, ws_size); grid = -1; return; }
        int dev = 0, cus = 0, per_cu = 0;
        hipGetDevice(&dev); hipDeviceGetAttribute(&cus, hipDeviceAttributeMultiprocessorCount, dev);
        hipFuncSetAttribute((const void*)fwd_megakernel, hipFuncAttributeMaxDynamicSharedMemorySize, LDS_BYTES);
        if (hipOccupancyMaxActiveBlocksPerMultiprocessor(&per_cu, (const void*)fwd_megakernel, NTHR, LDS_BYTES) != hipSuccess || per_cu < 1) { fprintf(stderr, "kernel_launch: occupancy query gave %d\n", per_cu); per_cu = 1; }
        (void)hipGetLastError();
        grid = cus * per_cu;
    }
    if (grid < 0) return;
    if (hipMemsetAsync((char*)d_ws + WS_CTL, 0, CTL_ZERO_BYTES, stream) != hipSuccess) { fprintf(stderr, "kernel_launch: memset failed\n"); return; }
    Args a{};
    for (int i = 0; i < 22; ++i) a.in[i] = (const float*)d_in[i];
    a.out = (float*)d_out; a.ws = (unsigned char*)d_ws;
#if MK_N_LAUNCHES == 1
    a.ph_lo = 0; a.ph_hi = N_PHASES;
    void* kargs[] = {&a};
    hipError_t e = hipLaunchCooperativeKernel((const void*)fwd_megakernel, dim3(grid), dim3(NTHR), kargs, LDS_BYTES, stream);
    if (e != hipSuccess) fprintf(stderr, "cooperative launch failed: %s (grid %d)\n", hipGetErrorString(e), grid);
#else
    for (int p = 0; p < N_PHASES; ++p) { a.ph_lo = p; a.ph_hi = p + 1; hipLaunchKernelGGL(fwd_megakernel, dim3(grid), dim3(NTHR), LDS_BYTES, stream, a); }
#endif
}
```

```cpp
#include <hip/hip_runtime.h>
#include <hip/hip_cooperative_groups.h>
#include <cstdio>
#include <cstdint>
namespace cg = cooperative_groups;
#ifndef REP_MASK
#define REP_MASK 0
#endif
#ifndef USE_CG_SYNC
#define USE_CG_SYNC 0
#endif
#ifndef FUSE_FINAL
#define FUSE_FINAL 1
#endif
#ifndef PG8_STGMMA
#define PG8_STGMMA 0
#endif
#ifndef GEMM_SP2
#define GEMM_SP2 true
#endif
#ifndef GEMM_ALIGN
#define GEMM_ALIGN true
#endif
namespace pg8 {
#define PG8_LAS __attribute__((address_space(3)))
typedef unsigned short bf16_t;
typedef short bf16x8 __attribute__((ext_vector_type(8)));
typedef float f32x4 __attribute__((ext_vector_type(4)));
typedef unsigned u32x4 __attribute__((ext_vector_type(4)));
constexpr int BM = 256, BK = 64, HALF = 128, HTB = HALF * BK * 2  , STAGE_BYTES = 8 * HTB, NXCD = 8, WGM = 4;

__host__ __device__ __forceinline__ int lds_byte(int r, int c) { const int st = (r >> 4) * 2 + (c >> 5), rr = r & 15, cc = c & 31, ob = rr * 64 + cc * 2; return st * 1024 + (ob ^ (((ob >> 9) & 1) << 5)); }
__host__ __device__ __forceinline__ void stage_rc(int b, int& R, int& C) { const int st = b / 1024, sb = b % 1024, swz = sb ^ (((sb >> 9) & 1) << 5); R = (st >> 1) * 16 + swz / 64; C = (st & 1) * 32 + (swz % 64) / 2; }
__host__ __device__ __forceinline__ int perm32(int rho) { const int n = rho >> 4, i = rho & 15; return 8 * (i >> 2) + 4 * n + (i & 3); }

struct Unit { int pm, pn; };
struct Gemm { const bf16_t* A; const bf16_t* Bt; int M, N, K; };

struct StaticOrder {
    int nM, nN, nwg, G, c;
    __host__ __device__ void init(int M, int N, int G_, int c_) { nM = M / BM; nN = N / BM; nwg = nM * nN; G = G_; c = c_; }
    __host__ __device__ bool next(int i, Unit& u) const {
        const long L = (long)i * G + c; if (L >= nwg) return false;
        int wgid = (int)L; { const int q = nwg / NXCD, r = nwg % NXCD, xcd = wgid % NXCD, off = wgid / NXCD; wgid = (xcd < r ? xcd * (q + 1) : r * (q + 1) + (xcd - r) * q) + off; }
        const int nig = WGM * nN, gid = wgid / nig, fm = gid * WGM, gsz = (nM - fm) < WGM ? (nM - fm) : WGM;
        u.pm = fm + ((wgid % nig) % gsz); u.pn = (wgid % nig) / gsz; return true;
    }
    __device__ __forceinline__ void a_ready(const Unit&) const {}
    __device__ __forceinline__ void done(const Unit&) const {}
};

__device__ __forceinline__ unsigned cvt_pk_bf16(float lo, float hi) { unsigned r; asm volatile("v_cvt_pk_bf16_f32 %0, %1, %2" : "=v"(r) : "v"(lo), "v"(hi)); return r; }
typedef float f32x2 __attribute__((ext_vector_type(2)));
__device__ __forceinline__ float silu_f(float g) { return g * __builtin_amdgcn_rcpf(1.0f + __builtin_amdgcn_exp2f(-1.44269504f * g)); }
__device__ __forceinline__ float sigmoid_f(float g) { return __builtin_amdgcn_rcpf(1.0f + __builtin_amdgcn_exp2f(-1.44269504f * g)); }
__device__ __forceinline__ float gelu_tanh_f(float x) { const float t = x * (1.0f + 0.044715f * x * x); return x * __builtin_amdgcn_rcpf(1.0f + __builtin_amdgcn_exp2f(-2.302208198f * t)); }
__device__ __forceinline__ float row_rs(const float* rowss, int row) { return __builtin_amdgcn_rsqf(rowss[row] * (1.0f / 1024.0f) + 1e-6f); }

struct EpiGU {
    static constexpr bool PERM = true, AFTER_DRAIN = false;
    bf16_t* H; const float* rowss; int ldh;
    __device__ __forceinline__ void prefetch(const Unit& u, int wr, int fr, float (&pre)[8]) const {
        const int row0 = u.pm * BM + wr * 64 + fr;
#pragma unroll
        for (int i = 0; i < 8; ++i) pre[i] = rowss[row0 + (i >> 2) * HALF + (i & 3) * 16];
    }
    __device__ __forceinline__ void operator()(const f32x4 (&acc)[2][2][4][2], const Unit& u, int wr, int wc, int fr, int fq, const float (&pre)[8]) const {
        const int row0 = u.pm * BM + wr * 64 + fr, col0 = u.pn * 128 + wc * 32 + 8 * fq;
        float rr[2][4];
#pragma unroll
        for (int ai = 0; ai < 2; ++ai)
#pragma unroll
            for (int m = 0; m < 4; ++m) rr[ai][m] = pre[ai * 4 + m];
#pragma unroll
        for (int ai = 0; ai < 2; ++ai)
#pragma unroll
            for (int m = 0; m < 4; ++m) {
                const int row = row0 + ai * HALF + m * 16; const float r = __builtin_amdgcn_rsqf(rr[ai][m] * (1.0f / 1024.0f) + 1e-6f), rn = -1.44269504f * r, r2 = r * r;
                unsigned w[4];
#pragma unroll
                for (int n = 0; n < 2; ++n)
#pragma unroll
                    for (int j = 0; j < 2; ++j) {
                        const f32x2 g = (f32x2){acc[ai][0][m][n][2 * j], acc[ai][0][m][n][2 * j + 1]}, uu = (f32x2){acc[ai][1][m][n][2 * j], acc[ai][1][m][n][2 * j + 1]};
                        const f32x2 t = g * rn; f32x2 e; e.x = __builtin_amdgcn_exp2f(t.x); e.y = __builtin_amdgcn_exp2f(t.y);
                        const f32x2 d = e + 1.0f; f32x2 sg; sg.x = __builtin_amdgcn_rcpf(d.x); sg.y = __builtin_amdgcn_rcpf(d.y);
                        const f32x2 h = ((g * uu) * r2) * sg;
                        w[n * 2 + j] = cvt_pk_bf16(h.x, h.y);
                    }
                u32x4 wv; wv.x = w[0]; wv.y = w[1]; wv.z = w[2]; wv.w = w[3];
                __builtin_nontemporal_store(wv, (u32x4*)(H + (size_t)row * ldh + col0));
            }
    }
};
template <bool BASE_BF16> struct EpiRes {
    static constexpr bool PERM = true, AFTER_DRAIN = false;
    const void* base; bf16_t* outb; float* rowss_out; float scale;
    __device__ __forceinline__ void prefetch(const Unit&, int, int, float (&)[8]) const {}
    __device__ __forceinline__ void operator()(const f32x4 (&acc)[2][2][4][2], const Unit& u, int wr, int wc, int fr, int fq, const float (&)[8]) const {
        const int row0 = u.pm * BM + wr * 64 + fr, col0 = u.pn * BM + wc * 32 + 8 * fq;
#pragma unroll
        for (int ai = 0; ai < 2; ++ai)
#pragma unroll
            for (int m = 0; m < 4; ++m) {
                const int row = row0 + ai * HALF + m * 16; float ss = 0.f;
#pragma unroll
                for (int bj = 0; bj < 2; ++bj) {
                    const size_t off = (size_t)row * 1024 + col0 + bj * HALF;
                    f32x4 b0, b1;
                    if (BASE_BF16) { const u32x4 bb = *(const u32x4*)((const bf16_t*)base + off);
                        b0 = (f32x4){__builtin_bit_cast(float, bb.x << 16), __builtin_bit_cast(float, bb.x & 0xffff0000u), __builtin_bit_cast(float, bb.y << 16), __builtin_bit_cast(float, bb.y & 0xffff0000u)};
                        b1 = (f32x4){__builtin_bit_cast(float, bb.z << 16), __builtin_bit_cast(float, bb.z & 0xffff0000u), __builtin_bit_cast(float, bb.w << 16), __builtin_bit_cast(float, bb.w & 0xffff0000u)}; }
                    else { b0 = *(const f32x4*)((const float*)base + off); b1 = *(const f32x4*)((const float*)base + off + 4); }
                    const f32x4 v0 = b0 + acc[ai][bj][m][0] * scale, v1 = b1 + acc[ai][bj][m][1] * scale;
                    u32x4 w; w.x = cvt_pk_bf16(v0[0], v0[1]); w.y = cvt_pk_bf16(v0[2], v0[3]); w.z = cvt_pk_bf16(v1[0], v1[1]); w.w = cvt_pk_bf16(v1[2], v1[3]); *(u32x4*)(outb + off) = w;
                    ss += (v0[0] * v0[0] + v0[1] * v0[1]) + (v0[2] * v0[2] + v0[3] * v0[3]) + (v1[0] * v1[0] + v1[1] * v1[1]) + (v1[2] * v1[2] + v1[3] * v1[3]);
                }
                ss += __shfl_xor(ss, 16); ss += __shfl_xor(ss, 32);
                if (fq == 0) __hip_atomic_fetch_add(rowss_out + row, ss, __ATOMIC_RELAXED, __HIP_MEMORY_SCOPE_AGENT);
            }
    }
};
struct EpiResNorm {
    static constexpr bool PERM = true, AFTER_DRAIN = false;
    const bf16_t* base; float* out; float* rowss; unsigned* cnt; const float* gain; float scale;
    __device__ __forceinline__ void prefetch(const Unit&, int, int, float (&)[8]) const {}
    __device__ __forceinline__ void operator()(f32x4 (&acc)[2][2][4][2], const Unit& u, int wr, int wc, int fr, int fq, const float (&)[8]) const {
        const int row0 = u.pm * BM + wr * 64 + fr, col0 = u.pn * BM + wc * 32 + 8 * fq;
#pragma unroll
        for (int ai = 0; ai < 2; ++ai)
#pragma unroll
            for (int m = 0; m < 4; ++m) {
                const int row = row0 + ai * HALF + m * 16; float ss = 0.f;
#pragma unroll
                for (int bj = 0; bj < 2; ++bj) {
                    const size_t off = (size_t)row * 1024 + col0 + bj * HALF;
                    const u32x4 bb = *(const u32x4*)(base + off);
                    const f32x4 b0 = (f32x4){__builtin_bit_cast(float, bb.x << 16), __builtin_bit_cast(float, bb.x & 0xffff0000u), __builtin_bit_cast(float, bb.y << 16), __builtin_bit_cast(float, bb.y & 0xffff0000u)};
                    const f32x4 b1 = (f32x4){__builtin_bit_cast(float, bb.z << 16), __builtin_bit_cast(float, bb.z & 0xffff0000u), __builtin_bit_cast(float, bb.w << 16), __builtin_bit_cast(float, bb.w & 0xffff0000u)};
                    const f32x4 v0 = b0 + acc[ai][bj][m][0] * scale, v1 = b1 + acc[ai][bj][m][1] * scale;
                    acc[ai][bj][m][0] = v0; acc[ai][bj][m][1] = v1;
                    ss += (v0[0] * v0[0] + v0[1] * v0[1]) + (v0[2] * v0[2] + v0[3] * v0[3]) + (v1[0] * v1[0] + v1[1] * v1[1]) + (v1[2] * v1[2] + v1[3] * v1[3]);
                }
                ss += __shfl_xor(ss, 16); ss += __shfl_xor(ss, 32);
                if (fq == 0) __hip_atomic_fetch_add(rowss + row, ss, __ATOMIC_RELAXED, __HIP_MEMORY_SCOPE_AGENT);
            }
        asm volatile("s_waitcnt vmcnt(0)" ::: "memory");
        unsigned* c = cnt + 16 * u.pm;
        if (fr == 0 && fq == 0) __hip_atomic_fetch_add(c, 1u, __ATOMIC_RELAXED, __HIP_MEMORY_SCOPE_AGENT);
        { unsigned sp = 0;
          while ((unsigned)__builtin_amdgcn_readfirstlane(__hip_atomic_load(c, __ATOMIC_RELAXED, __HIP_MEMORY_SCOPE_AGENT)) < 32u) { __builtin_amdgcn_s_sleep(2); if (++sp > (1u << 22)) break; } }
        asm volatile("" ::: "memory");
        float rsv[2][4];
#pragma unroll
        for (int ai = 0; ai < 2; ++ai)
#pragma unroll
            for (int m = 0; m < 4; ++m) rsv[ai][m] = __hip_atomic_load(rowss + row0 + ai * HALF + m * 16, __ATOMIC_RELAXED, __HIP_MEMORY_SCOPE_AGENT);
#pragma unroll
        for (int ai = 0; ai < 2; ++ai)
#pragma unroll
            for (int m = 0; m < 4; ++m) {
                const int row = row0 + ai * HALF + m * 16;
                const float r = __builtin_amdgcn_rsqf(rsv[ai][m] * (1.0f / 1024.0f) + 1e-6f);
#pragma unroll
                for (int bj = 0; bj < 2; ++bj) {
                    const int col = col0 + bj * HALF; const size_t off = (size_t)row * 1024 + col;
                    const f32x4 g0 = *(const f32x4*)(gain + col), g1 = *(const f32x4*)(gain + col + 4);
                    *(f32x4*)(out + off) = acc[ai][bj][m][0] * r * g0; *(f32x4*)(out + off + 4) = acc[ai][bj][m][1] * r * g1;
                }
            }
    }
};
struct EpiIn {
    static constexpr bool PERM = true, AFTER_DRAIN = false;
    bf16_t* Z; float* gates; const float* rowss; int ldz;
    __device__ __forceinline__ void prefetch(const Unit& u, int wr, int fr, float (&pre)[8]) const {
        const int row0 = u.pm * BM + wr * 64 + fr;
#pragma unroll
        for (int i = 0; i < 8; ++i) pre[i] = rowss[row0 + (i >> 2) * HALF + (i & 3) * 16];
    }
    __device__ __forceinline__ void operator()(const f32x4 (&acc)[2][2][4][2], const Unit& u, int wr, int wc, int fr, int fq, const float (&pre)[8]) const {
        const int row0 = u.pm * BM + wr * 64 + fr, col0 = u.pn * BM + wc * 32 + 8 * fq;
        if (u.pn == 10) {
            if (wc == 0 && fq == 0) {
#pragma unroll
                for (int ai = 0; ai < 2; ++ai)
#pragma unroll
                    for (int m = 0; m < 4; ++m) {
                        const int row = row0 + ai * HALF + m * 16; const float r = __builtin_amdgcn_rsqf(pre[ai * 4 + m] * (1.0f / 1024.0f) + 1e-6f);
                        *(f32x4*)(gates + (size_t)row * 8) = acc[ai][0][m][0] * r; *(f32x4*)(gates + (size_t)row * 8 + 4) = acc[ai][0][m][1] * r;
                    }
            }
            return;
        }
        const bool act = u.pn < 4;
#pragma unroll
        for (int ai = 0; ai < 2; ++ai)
#pragma unroll
            for (int m = 0; m < 4; ++m) {
                const int row = row0 + ai * HALF + m * 16; const float r = __builtin_amdgcn_rsqf(pre[ai * 4 + m] * (1.0f / 1024.0f) + 1e-6f);
#pragma unroll
                for (int bj = 0; bj < 2; ++bj) {
                    f32x4 v0 = acc[ai][bj][m][0] * r, v1 = acc[ai][bj][m][1] * r;
                    if (act) {
#pragma unroll
                        for (int j = 0; j < 2; ++j) {
                            f32x2 x0 = (f32x2){v0[2 * j], v0[2 * j + 1]}, x1 = (f32x2){v1[2 * j], v1[2 * j + 1]};
                            const f32x2 t0 = (x0 * x0 * 0.044715f + 1.0f) * x0 * (-2.302208198f), t1 = (x1 * x1 * 0.044715f + 1.0f) * x1 * (-2.302208198f);
                            f32x2 e0, e1; e0.x = __builtin_amdgcn_exp2f(t0.x); e0.y = __builtin_amdgcn_exp2f(t0.y); e1.x = __builtin_amdgcn_exp2f(t1.x); e1.y = __builtin_amdgcn_exp2f(t1.y);
                            e0 = e0 + 1.0f; e1 = e1 + 1.0f;
                            v0[2 * j] = x0.x * __builtin_amdgcn_rcpf(e0.x); v0[2 * j + 1] = x0.y * __builtin_amdgcn_rcpf(e0.y); v1[2 * j] = x1.x * __builtin_amdgcn_rcpf(e1.x); v1[2 * j + 1] = x1.y * __builtin_amdgcn_rcpf(e1.y);
                        }
                    }
                    u32x4 w; w.x = cvt_pk_bf16(v0[0], v0[1]); w.y = cvt_pk_bf16(v0[2], v0[3]); w.z = cvt_pk_bf16(v1[0], v1[1]); w.w = cvt_pk_bf16(v1[2], v1[3]);
                    __builtin_nontemporal_store(w, (u32x4*)(Z + (size_t)row * ldz + col0 + bj * HALF));
                }
            }
    }
};

template <class Epi, class Sched, bool ALIGN_EPI = false, bool SP2 = false>
__device__ __forceinline__ void gemm_phase(PG8_LAS unsigned char* lds, const Gemm g, const Sched& S, const Epi& E) {
    const int tid = threadIdx.x, wid = __builtin_amdgcn_readfirstlane(tid >> 6), lane = tid & 63, wr = wid >> 2, wc = wid & 3, fr = lane & 15, fq = lane >> 4;
    const int K = g.K, nt = K / BK;
    unsigned voffA[2], voffB[2];
#pragma unroll
    for (int i = 0; i < 2; ++i) { int R, C; stage_rc(tid * 16 + i * 8192, R, C); const int Rb = Epi::PERM ? ((R & ~31) + perm32(R & 31)) : R;
        voffA[i] = (unsigned)(R * K + C) * 2u; voffB[i] = (unsigned)(Rb * K + C) * 2u; }
    const size_t kstep = (size_t)(BK * 2);
    const size_t hstep = (size_t)HALF * K * 2;
    const size_t tstep = 2 * hstep;
    const unsigned ldsw = (unsigned)wid * 1024u;
    const int aoff = lds_byte(wr * 64 + fr, fq * 8), boff = lds_byte(wc * 32 + fr, fq * 8);
#define PG8_SA(b, h) (((b) * 2 + (h)) * HTB)
#define PG8_SB(b, h) ((4 + (b) * 2 + (h)) * HTB)
#define PG8_STAGE(bufoff, gbase, voff) do { _Pragma("unroll") for (int _i = 0; _i < 2; ++_i) \
        __builtin_amdgcn_global_load_lds((const unsigned*)((const char*)(gbase) + (voff)[_i]), (PG8_LAS unsigned*)(lds + (bufoff) + ldsw + _i * 8192), 16, 0, 0); } while (0)
#define PG8_LDA(dst, b, h) do { _Pragma("unroll") for (int m = 0; m < 4; ++m) _Pragma("unroll") for (int k = 0; k < 2; ++k) dst[m][k] = *(const PG8_LAS bf16x8*)(lds + PG8_SA(b, h) + aoff + m * 2048 + k * 1024); } while (0)
#define PG8_LDB(dst, b, h) do { _Pragma("unroll") for (int n = 0; n < 2; ++n) _Pragma("unroll") for (int k = 0; k < 2; ++k) dst[n][k] = *(const PG8_LAS bf16x8*)(lds + PG8_SB(b, h) + boff + n * 2048 + k * 1024); } while (0)
#define PG8_MMA(ai, bj, At, Bt) do { __builtin_amdgcn_s_setprio(1); _Pragma("unroll") for (int m = 0; m < 4; ++m) _Pragma("unroll") for (int n = 0; n < 2; ++n) _Pragma("unroll") for (int k = 0; k < 2; ++k) \
        acc[ai][bj][m][n] = __builtin_amdgcn_mfma_f32_16x16x32_bf16(Bt[n][k], At[m][k], acc[ai][bj][m][n], 0, 0, 0); __builtin_amdgcn_s_setprio(0); } while (0)
#define PG8_STAGE1(bufoff, gbase, voff, i) __builtin_amdgcn_global_load_lds((const unsigned*)((const char*)(gbase) + (voff)[i]), (PG8_LAS unsigned*)(lds + (bufoff) + ldsw + (i) * 8192), 16, 0, 0)
#define PG8_MMAQ(ai, bj, At, Bt, m) do { _Pragma("unroll") for (int n = 0; n < 2; ++n) _Pragma("unroll") for (int k = 0; k < 2; ++k) \
        acc[ai][bj][m][n] = __builtin_amdgcn_mfma_f32_16x16x32_bf16(Bt[n][k], At[m][k], acc[ai][bj][m][n], 0, 0, 0); } while (0)
#define PG8_M1(At, B0, B1, bufoff, gbase, voff) do { __builtin_amdgcn_s_setprio(1); \
        PG8_MMAQ(0, 0, At, B0, 0); PG8_MMAQ(0, 0, At, B0, 1); PG8_SCHED; PG8_STAGE1(bufoff, gbase, voff, 0); PG8_SCHED; \
        PG8_MMAQ(0, 0, At, B0, 2); PG8_MMAQ(0, 0, At, B0, 3); PG8_SCHED; PG8_STAGE1(bufoff, gbase, voff, 1); PG8_SCHED; \
        PG8_MMAQ(0, 1, At, B1, 0); PG8_MMAQ(0, 1, At, B1, 1); PG8_MMAQ(0, 1, At, B1, 2); PG8_MMAQ(0, 1, At, B1, 3); __builtin_amdgcn_s_setprio(0); } while (0)
#define PG8_M2(At, B0, B1, o0, g0, v0, o1, g1, v1, o2, g2, v2) do { __builtin_amdgcn_s_setprio(1); \
        PG8_MMAQ(1, 0, At, B0, 0); PG8_SCHED; PG8_STAGE1(o0, g0, v0, 0); PG8_SCHED; PG8_MMAQ(1, 0, At, B0, 1); PG8_SCHED; PG8_STAGE1(o0, g0, v0, 1); PG8_SCHED; \
        PG8_MMAQ(1, 0, At, B0, 2); PG8_SCHED; PG8_STAGE1(o1, g1, v1, 0); PG8_SCHED; PG8_MMAQ(1, 0, At, B0, 3); PG8_SCHED; PG8_STAGE1(o1, g1, v1, 1); PG8_SCHED; \
        PG8_MMAQ(1, 1, At, B1, 0); PG8_SCHED; PG8_STAGE1(o2, g2, v2, 0); PG8_SCHED; PG8_MMAQ(1, 1, At, B1, 1); PG8_SCHED; PG8_STAGE1(o2, g2, v2, 1); PG8_SCHED; \
        PG8_MMAQ(1, 1, At, B1, 2); PG8_MMAQ(1, 1, At, B1, 3); __builtin_amdgcn_s_setprio(0); } while (0)
#define PG8_WAIT_V(n) asm volatile("s_waitcnt vmcnt(" #n ")" ::: "memory")
#define PG8_WAIT_L(n) asm volatile("s_waitcnt lgkmcnt(" #n ")" ::: "memory")
#define PG8_BAR __builtin_amdgcn_s_barrier()
#define PG8_SCHED __builtin_amdgcn_sched_barrier(0)
    Unit cur, nxt; int ui = 0;
    if (!S.next(0, cur)) return;
    float pre[8]; E.prefetch(cur, wr, fr, pre);
    f32x4 acc[2][2][4][2];
#pragma unroll
    for (int a = 0; a < 2; ++a)
#pragma unroll
        for (int b = 0; b < 2; ++b)
#pragma unroll
            for (int m = 0; m < 4; ++m)
#pragma unroll
                for (int n = 0; n < 2; ++n) acc[a][b][m][n] = (f32x4){0.f, 0.f, 0.f, 0.f};
    bf16x8 At[4][2], B0[2][2], B1[2][2];
    const char* cA = (const char*)g.A + (size_t)cur.pm * tstep; const char* cB = (const char*)g.Bt + (size_t)cur.pn * tstep;
    S.a_ready(cur);
    if constexpr (SP2) {
        PG8_STAGE(PG8_SB(0, 0), cB, voffB); PG8_STAGE(PG8_SB(0, 1), cB + hstep, voffB); PG8_STAGE(PG8_SA(0, 0), cA, voffA); PG8_STAGE(PG8_SA(0, 1), cA + hstep, voffA);
        if (wr == 1) PG8_BAR;
        PG8_WAIT_V(2); PG8_BAR;
        PG8_STAGE(PG8_SB(1, 0), cB + kstep, voffB); PG8_STAGE(PG8_SA(1, 0), cA + kstep, voffA); PG8_STAGE(PG8_SB(1, 1), cB + hstep + kstep, voffB);
        PG8_WAIT_V(6); PG8_BAR;
    } else {
        PG8_STAGE(PG8_SB(0, 0), cB, voffB); PG8_STAGE(PG8_SA(0, 0), cA, voffA); PG8_STAGE(PG8_SB(0, 1), cB + hstep, voffB); PG8_STAGE(PG8_SA(0, 1), cA + hstep, voffA);
        if (wr == 1) PG8_BAR;
        PG8_WAIT_V(4); PG8_BAR;
        PG8_STAGE(PG8_SB(1, 0), cB + kstep, voffB); PG8_STAGE(PG8_SA(1, 0), cA + kstep, voffA); PG8_STAGE(PG8_SB(1, 1), cB + hstep + kstep, voffB);
        PG8_WAIT_V(6); PG8_BAR;
    }
    for (;;) {
        const bool has_next = S.next(ui + 1, nxt);
        const char* nA = has_next ? (const char*)g.A + (size_t)nxt.pm * tstep : cA; const char* nB = has_next ? (const char*)g.Bt + (size_t)nxt.pn * tstep : cB;
        for (int t = 0; t < nt; t += 2) {
            const bool last = (t == nt - 2);
            const char* a1 = cA + (size_t)(t + 1) * kstep;
            const char* a2 = last ? nA : cA + (size_t)(t + 2) * kstep; const char* b2 = last ? nB : cB + (size_t)(t + 2) * kstep;
            const char* a3 = a2 + kstep; const char* b3 = b2 + kstep;
            if (last && has_next) S.a_ready(nxt);
            if constexpr (SP2) {
#if PG8_STGMMA
            PG8_LDB(B0, 0, 0); PG8_LDB(B1, 0, 1); PG8_SCHED; PG8_LDA(At, 0, 0);
            PG8_WAIT_V(6); PG8_WAIT_L(0); PG8_BAR; PG8_M1(At, B0, B1, PG8_SA(1, 1), a1 + hstep, voffA); PG8_BAR; PG8_SCHED;
            PG8_LDA(At, 0, 1);
            PG8_WAIT_V(2); PG8_WAIT_L(0); PG8_BAR; PG8_M2(At, B0, B1, PG8_SB(0, 0), b2, voffB, PG8_SB(0, 1), b2 + hstep, voffB, PG8_SA(0, 0), a2, voffA); PG8_BAR; PG8_SCHED;
            PG8_LDB(B0, 1, 0); PG8_LDB(B1, 1, 1); PG8_SCHED; PG8_LDA(At, 1, 0);
            PG8_WAIT_V(6); PG8_WAIT_L(0); PG8_BAR; PG8_M1(At, B0, B1, PG8_SA(0, 1), a2 + hstep, voffA); PG8_BAR; PG8_SCHED;
            PG8_LDA(At, 1, 1);
            PG8_WAIT_V(2); PG8_WAIT_L(0); PG8_BAR; PG8_M2(At, B0, B1, PG8_SB(1, 0), b3, voffB, PG8_SB(1, 1), b3 + hstep, voffB, PG8_SA(1, 0), a3, voffA); PG8_BAR; PG8_SCHED;
#else
            PG8_LDB(B0, 0, 0); PG8_LDB(B1, 0, 1); PG8_SCHED; PG8_LDA(At, 0, 0); PG8_STAGE(PG8_SA(1, 1), a1 + hstep, voffA);
            PG8_WAIT_V(8); PG8_WAIT_L(0); PG8_BAR; PG8_MMA(0, 0, At, B0); PG8_MMA(0, 1, At, B1); PG8_BAR; PG8_SCHED;
            PG8_LDA(At, 0, 1); PG8_STAGE(PG8_SB(0, 0), b2, voffB); PG8_STAGE(PG8_SB(0, 1), b2 + hstep, voffB); PG8_STAGE(PG8_SA(0, 0), a2, voffA);
            PG8_WAIT_V(8); PG8_WAIT_L(0); PG8_BAR; PG8_MMA(1, 0, At, B0); PG8_MMA(1, 1, At, B1); PG8_BAR; PG8_SCHED;
            PG8_LDB(B0, 1, 0); PG8_LDB(B1, 1, 1); PG8_SCHED; PG8_LDA(At, 1, 0); PG8_STAGE(PG8_SA(0, 1), a2 + hstep, voffA);
            PG8_WAIT_V(8); PG8_WAIT_L(0); PG8_BAR; PG8_MMA(0, 0, At, B0); PG8_MMA(0, 1, At, B1); PG8_BAR; PG8_SCHED;
            PG8_LDA(At, 1, 1); PG8_STAGE(PG8_SB(1, 0), b3, voffB); PG8_STAGE(PG8_SB(1, 1), b3 + hstep, voffB); PG8_STAGE(PG8_SA(1, 0), a3, voffA);
            PG8_WAIT_V(8); PG8_WAIT_L(0); PG8_BAR; PG8_MMA(1, 0, At, B0); PG8_MMA(1, 1, At, B1); PG8_BAR; PG8_SCHED;
#endif
            } else {
            PG8_LDB(B0, 0, 0); PG8_SCHED; PG8_LDA(At, 0, 0); PG8_STAGE(PG8_SA(1, 1), a1 + hstep, voffA);
            PG8_WAIT_L(8); PG8_BAR; PG8_WAIT_L(0); PG8_MMA(0, 0, At, B0); PG8_BAR; PG8_SCHED;
            PG8_LDB(B1, 0, 1); PG8_STAGE(PG8_SB(0, 0), b2, voffB);
            PG8_BAR; PG8_WAIT_L(0); PG8_MMA(0, 1, At, B1); PG8_BAR;
            PG8_LDA(At, 0, 1); PG8_STAGE(PG8_SA(0, 0), a2, voffA);
            PG8_BAR; PG8_WAIT_L(0); PG8_MMA(1, 0, At, B0); PG8_BAR; PG8_SCHED;
            PG8_STAGE(PG8_SB(0, 1), b2 + hstep, voffB);
            PG8_WAIT_V(6); PG8_BAR; PG8_MMA(1, 1, At, B1); PG8_BAR;
            PG8_LDB(B0, 1, 0); PG8_SCHED; PG8_LDA(At, 1, 0); PG8_STAGE(PG8_SA(0, 1), a2 + hstep, voffA);
            PG8_WAIT_L(8); PG8_BAR; PG8_WAIT_L(0); PG8_MMA(0, 0, At, B0); PG8_BAR; PG8_SCHED;
            PG8_LDB(B1, 1, 1); PG8_STAGE(PG8_SB(1, 0), b3, voffB);
            PG8_BAR; PG8_WAIT_L(0); PG8_MMA(0, 1, At, B1); PG8_BAR;
            PG8_LDA(At, 1, 1); PG8_STAGE(PG8_SA(1, 0), a3, voffA);
            PG8_BAR; PG8_WAIT_L(0); PG8_MMA(1, 0, At, B0); PG8_BAR; PG8_SCHED;
            PG8_STAGE(PG8_SB(1, 1), b3 + hstep, voffB);
            PG8_WAIT_V(6); PG8_BAR; PG8_MMA(1, 1, At, B1); PG8_BAR;
            }
        }
        if constexpr (ALIGN_EPI) { if (wr == 0) PG8_BAR; }
        if constexpr (!Epi::AFTER_DRAIN) { E(acc, cur, wr, wc, fr, fq, pre); S.done(cur); }
        if (!has_next) break;
#pragma unroll
        for (int a = 0; a < 2; ++a)
#pragma unroll
            for (int b = 0; b < 2; ++b)
#pragma unroll
                for (int m = 0; m < 4; ++m)
#pragma unroll
                    for (int n = 0; n < 2; ++n) acc[a][b][m][n] = (f32x4){0.f, 0.f, 0.f, 0.f};
        cur = nxt; cA = nA; cB = nB; ++ui;
        E.prefetch(cur, wr, fr, pre);
        if constexpr (ALIGN_EPI) { if (wr == 1) PG8_BAR; }
    }
    PG8_WAIT_V(0);
    if constexpr (!ALIGN_EPI) { if (wr == 0) PG8_BAR; }
    PG8_BAR;
    if constexpr (Epi::AFTER_DRAIN) { E.fused(acc, cur, wr, wc, fr, fq, lds, wid, lane); S.done(cur); }
#undef PG8_SA
#undef PG8_SB
#undef PG8_STAGE
#undef PG8_LDA
#undef PG8_LDB
#undef PG8_MMA
#undef PG8_MMAQ
#undef PG8_M1
#undef PG8_M2
#undef PG8_STAGE1
#undef PG8_WAIT_V
#undef PG8_WAIT_L
#undef PG8_BAR
#undef PG8_SCHED
}
}

constexpr int NWAVES = 8, NTHR = 512;
constexpr int BATCH = 8, SEQ = 8192, D = 1024, M = BATCH * SEQ, FF = 2816, NGU = 2 * FF, NIN = 2568, NINP = 2816, ZW = 2560, NCHK = SEQ / 64, NHEAD = 4;
constexpr int NTASK = BATCH * NHEAD * NCHK;
constexpr float EPS = 1e-6f;
constexpr size_t MiB = 1u << 20;
constexpr size_t WS_WGU1 = 2 * MiB, WS_WD1 = 13 * MiB, WS_WIN = 19 * MiB, WS_WOUT = 25 * MiB, WS_WGU2 = 27 * MiB, WS_WD2 = 38 * MiB, WS_SGUW = 44 * MiB;
constexpr size_t WS_RSS = 45 * MiB, WS_GATES = 46 * MiB, WS_ML = 48 * MiB, WS_NST = 49 * MiB;
constexpr size_t WS_XB = 64 * MiB, WS_HID = 192 * MiB, WS_Z = 192 * MiB, WS_Y = 544 * MiB, WS_CST = 672 * MiB, WS_END = 800 * MiB;
constexpr int LDS_BYTES = 147456, MISC_OFF = LDS_BYTES - 128;
constexpr size_t WS_CTL = 0, CTL_ZERO_BYTES = 65536;

#define LAS __attribute__((address_space(3)))
typedef unsigned short bf16;
typedef unsigned u32x4 __attribute__((ext_vector_type(4)));
typedef unsigned u32x2 __attribute__((ext_vector_type(2)));
typedef float f32x4 __attribute__((ext_vector_type(4)));
typedef short bf16x8 __attribute__((ext_vector_type(8)));
#define LDS_WAIT() asm volatile("s_waitcnt lgkmcnt(0)" ::: "memory")
#define LBAR() do { asm volatile("s_waitcnt lgkmcnt(0)" ::: "memory"); __builtin_amdgcn_s_barrier(); asm volatile("" ::: "memory"); } while (0)
__device__ __forceinline__ unsigned f2bf(float f) { unsigned u = __builtin_bit_cast(unsigned, f); return (u + 0x7fffu + ((u >> 16) & 1u)) >> 16; }
__device__ __forceinline__ unsigned pk2(float lo, float hi) { return f2bf(lo) | (f2bf(hi) << 16); }
__device__ __forceinline__ float bflo(unsigned w) { return __builtin_bit_cast(float, w << 16); }
__device__ __forceinline__ float bfhi(unsigned w) { return __builtin_bit_cast(float, w & 0xffff0000u); }
__device__ __forceinline__ float wave_sum(float v) {
#pragma unroll
    for (int o = 1; o < 64; o <<= 1) v += __shfl_xor(v, o);
    return v;
}
__device__ __forceinline__ float wave_max(float v) {
#pragma unroll
    for (int o = 1; o < 64; o <<= 1) v = fmaxf(v, __shfl_xor(v, o));
    return v;
}
template <int CTRL, int ROWMASK> __device__ __forceinline__ float dpp_mov(float ident, float src) {
    return __builtin_bit_cast(float, __builtin_amdgcn_update_dpp(__builtin_bit_cast(int, ident), __builtin_bit_cast(int, src), CTRL, ROWMASK, 0xf, false));
}
__device__ __forceinline__ float scan_add(float v, int) {
    v += dpp_mov<0x111, 0xf>(0.f, v); v += dpp_mov<0x112, 0xf>(0.f, v); v += dpp_mov<0x114, 0xf>(0.f, v); v += dpp_mov<0x118, 0xf>(0.f, v);
    v += dpp_mov<0x142, 0xa>(0.f, v); v += dpp_mov<0x143, 0xc>(0.f, v);
    return v;
}
__device__ __forceinline__ float scan_max(float v, int) {
    const float ninf = -__builtin_inff();
    v = fmaxf(v, dpp_mov<0x111, 0xf>(ninf, v)); v = fmaxf(v, dpp_mov<0x112, 0xf>(ninf, v)); v = fmaxf(v, dpp_mov<0x114, 0xf>(ninf, v)); v = fmaxf(v, dpp_mov<0x118, 0xf>(ninf, v));
    v = fmaxf(v, dpp_mov<0x142, 0xa>(ninf, v)); v = fmaxf(v, dpp_mov<0x143, 0xc>(ninf, v));
    return v;
}
__device__ __forceinline__ float logsigmoid_f(float x) { const float e = __expf(-fabsf(x)); return fminf(x, 0.f) - ((e < 1e-4f) ? e * (1.0f - 0.5f * e) : __logf(1.0f + e)); }

struct Args {
    const float* in[22]; float* out; unsigned char* ws; int ph_lo, ph_hi;
};
enum { I_X = 0, I_N1, I_G1, I_U1, I_D1, I_MIXN, I_WIN, I_LNG, I_LNB, I_SGUW, I_SGUB, I_CONVW, I_CONVB, I_IGB, I_FGB, I_MHN, I_WOUT, I_N2, I_G2, I_U2, I_D2, I_FINALN };

__device__ __forceinline__ void tr_item(const float* __restrict__ W, int K, int N, const float* __restrict__ gain, bf16* WT, int drow0, int k0, int n0, LAS float* scr, int lane) {
    const int kk8 = lane >> 3, c4 = (lane & 7) * 4; const bool ok = (n0 + c4) < N;
    f32x4 v[8];
#pragma unroll
    for (int i = 0; i < 8; ++i) { const int kk = 8 * i + kk8; v[i] = ok ? *(const f32x4*)(W + (size_t)(k0 + kk) * N + n0 + c4) : (f32x4){0.f, 0.f, 0.f, 0.f}; }
#pragma unroll
    for (int i = 0; i < 8; ++i) { const int kk = 8 * i + kk8; const float g = gain ? gain[k0 + kk] : 1.0f; LAS float* d = scr + kk * 33 + c4;
        d[0] = v[i][0] * g; d[1] = v[i][1] * g; d[2] = v[i][2] * g; d[3] = v[i][3] * g; }
    LDS_WAIT(); asm volatile("" ::: "memory");
    const int c = lane & 7;
#pragma unroll
    for (int j = 0; j < 4; ++j) { const int nn = (lane >> 3) + 8 * j; const LAS float* s = scr + (8 * c) * 33 + nn;
        u32x4 o; o.x = pk2(s[0 * 33], s[1 * 33]); o.y = pk2(s[2 * 33], s[3 * 33]); o.z = pk2(s[4 * 33], s[5 * 33]); o.w = pk2(s[6 * 33], s[7 * 33]);
        *(u32x4*)(WT + (size_t)(drow0 + nn) * K + k0 + 8 * c) = o; }
    LDS_WAIT(); asm volatile("" ::: "memory");
}
__device__ __forceinline__ void p0_prologue(const Args& a, LAS unsigned char* lds, int vcu, int G, int tid) {
    const int wave = __builtin_amdgcn_readfirstlane(tid >> 6), lane = tid & 63;
    unsigned char* ws = a.ws;
    LAS float* scr = (LAS float*)(lds + wave * 16384);
    const int gw = vcu * NWAVES + wave, NGW = G * NWAVES;
    constexpr int IT_GU = 16 * 88, IT_D = 44 * 32, IT_IN = 16 * 88, IT_OUT = 16 * 32;
    constexpr int NITEMS = 4 * IT_GU + 2 * IT_D + IT_IN + IT_OUT;
    for (int it = gw; it < NITEMS; it += NGW) {
        int r = it;
        if (r < 2 * IT_GU) {
            const int s = r / IT_GU; r -= s * IT_GU; const int kb = r / 88, nb = r % 88, n0 = nb * 32;
            tr_item(a.in[s ? I_U1 : I_G1], D, FF, a.in[I_N1], (bf16*)(ws + WS_WGU1), 256 * (n0 >> 7) + 128 * s + (n0 & 127), kb * 64, n0, scr, lane); continue; }
        r -= 2 * IT_GU;
        if (r < 2 * IT_GU) {
            const int s = r / IT_GU; r -= s * IT_GU; const int kb = r / 88, nb = r % 88, n0 = nb * 32;
            tr_item(a.in[s ? I_U2 : I_G2], D, FF, a.in[I_N2], (bf16*)(ws + WS_WGU2), 256 * (n0 >> 7) + 128 * s + (n0 & 127), kb * 64, n0, scr, lane); continue; }
        r -= 2 * IT_GU;
        if (r < 2 * IT_D) {
            const int s = r / IT_D; r -= s * IT_D; const int kb = r / 32, nb = r % 32, n0 = nb * 32;
            tr_item(a.in[s ? I_D2 : I_D1], FF, D, nullptr, (bf16*)(ws + (s ? WS_WD2 : WS_WD1)), n0, kb * 64, n0, scr, lane); continue; }
        r -= 2 * IT_D;
        if (r < IT_IN) { const int kb = r / 88, nb = r % 88, n0 = nb * 32;
            tr_item(a.in[I_WIN], D, NIN, a.in[I_MIXN], (bf16*)(ws + WS_WIN), n0, kb * 64, n0, scr, lane); continue; }
        r -= IT_IN;
        { const int kb = r / 32, nb = r % 32, n0 = nb * 32;
            tr_item(a.in[I_WOUT], D, D, nullptr, (bf16*)(ws + WS_WOUT), n0, kb * 64, n0, scr, lane); }
    }
    {
        float* rss0 = (float*)(ws + WS_RSS); bf16* XB = (bf16*)(ws + WS_XB); const float* x = a.in[I_X];
        for (int m0 = gw * 4; m0 < M; m0 += NGW * 4) {
            f32x4 v[4][4];
#pragma unroll
            for (int r = 0; r < 4; ++r) { const f32x4* xr = (const f32x4*)(x + (size_t)(m0 + r) * D) + lane;
#pragma unroll
                for (int j = 0; j < 4; ++j) v[r][j] = __builtin_nontemporal_load(xr + 64 * j); }
#pragma unroll
            for (int r = 0; r < 4; ++r) { unsigned long long* o8 = (unsigned long long*)(XB + (size_t)(m0 + r) * D) + lane; float s = 0.f;
#pragma unroll
                for (int j = 0; j < 4; ++j) { s += (v[r][j].x * v[r][j].x + v[r][j].y * v[r][j].y) + (v[r][j].z * v[r][j].z + v[r][j].w * v[r][j].w);
                    o8[64 * j] = (unsigned long long)pk2(v[r][j].x, v[r][j].y) | ((unsigned long long)pk2(v[r][j].z, v[r][j].w) << 32); }
                s = wave_sum(s); if (lane == 0) rss0[m0 + r] = s; }
        }
    }
    {
        float* rss = (float*)(ws + WS_RSS) + M; const int gt = vcu * NTHR + tid, NGT = G * NTHR;
        for (int i = gt; i < 3 * M; i += NGT) rss[i] = 0.f;
        bf16* sw = (bf16*)(ws + WS_SGUW); const float* w = a.in[I_SGUW];
        for (int i = gt; i < 4 * 128 * 128; i += NGT) { const int t = (i >> 7) & 127, s = i & 127; sw[i] = (bf16)(((t >> 6) >= (s >> 6)) ? f2bf(w[i]) : 0u); }
    }
}

__device__ __forceinline__ void sgu_chunk(const Args& a, LAS unsigned char* lds, int chunk, int tid) {
    const int wave = __builtin_amdgcn_readfirstlane(tid >> 6), lane = tid & 63, fr = lane & 15, fq = lane >> 4;
    unsigned char* ws = a.ws;
    const bf16* Z = (const bf16*)(ws + WS_Z); bf16* Y = (bf16*)(ws + WS_Y); const bf16* SW = (const bf16*)(ws + WS_SGUW);
    constexpr int VS = 136;
    LAS bf16* vT = (LAS bf16*)lds;
    LAS float* st = (LAS float*)(lds + 512 * VS * 2);
    bf16x8 wfr[4][4]; float bsv[4];
    { const int tt = 16 * wave + fr;
#pragma unroll
      for (int g = 0; g < 4; ++g) { bsv[g] = a.in[I_SGUB][g * 128 + tt];
#pragma unroll
          for (int ks = 0; ks < 4; ++ks) wfr[g][ks] = *(const bf16x8*)(SW + ((size_t)(g * 128 + tt) * 128 + 32 * ks + 8 * fq)); } }
    {
        const int t = tid & 127, g = tid >> 7;
        const u32x4* zr = (const u32x4*)(Z + ((size_t)chunk * 128 + t) * ZW + 512 + g * 128);
        u32x4 raw[16]; float s = 0.f, ss = 0.f;
#pragma unroll
        for (int i = 0; i < 16; ++i) { raw[i] = zr[i];
#pragma unroll
            for (int j = 0; j < 4; ++j) { const float lo = bflo(raw[i][j]), hi = bfhi(raw[i][j]); s += lo + hi; ss += lo * lo + hi * hi; } }
        st[(g * 128 + t) * 2] = s; st[(g * 128 + t) * 2 + 1] = ss;
        __syncthreads();
        float S = 0.f, SS = 0.f;
#pragma unroll
        for (int gg = 0; gg < 4; ++gg) { S += st[(gg * 128 + t) * 2]; SS += st[(gg * 128 + t) * 2 + 1]; }
        const float mu = S * (1.f / 512.f), var = fmaxf(SS * (1.f / 512.f) - mu * mu, 0.f), rstd = 1.0f / sqrtf(var + EPS);
        const float* lg = a.in[I_LNG] + g * 128; const float* lb = a.in[I_LNB] + g * 128;
#pragma unroll
        for (int i = 0; i < 16; ++i)
#pragma unroll
            for (int j = 0; j < 4; ++j) { const int d = 8 * i + 2 * j;
                const float y0 = (bflo(raw[i][j]) - mu) * rstd * lg[d] + lb[d], y1 = (bfhi(raw[i][j]) - mu) * rstd * lg[d + 1] + lb[d + 1];
                vT[(g * 128 + d) * VS + t] = (bf16)f2bf(y0); vT[(g * 128 + d + 1) * VS + t] = (bf16)f2bf(y1); }
    }
    __syncthreads();
    {
        const int tb = wave, tt = 16 * tb + fr; const size_t row = (size_t)chunk * 128 + tt; const bool full = tb >= 4;
#pragma unroll
        for (int g = 0; g < 4; ++g) {
            f32x4 acc[4][2];
#pragma unroll
            for (int p = 0; p < 4; ++p) { acc[p][0] = (f32x4){0.f, 0.f, 0.f, 0.f}; acc[p][1] = (f32x4){0.f, 0.f, 0.f, 0.f}; }
            u32x4 uu[4];
#pragma unroll
            for (int p = 0; p < 4; ++p) uu[p] = *(const u32x4*)(Z + row * ZW + g * 128 + 32 * p + 8 * fq);
#pragma unroll
            for (int ks = 0; ks < 4; ++ks) {
                if (ks < 2 || full) {
                    const bf16x8 wf = wfr[g][ks];
#pragma unroll
                    for (int p = 0; p < 4; ++p)
#pragma unroll
                        for (int n = 0; n < 2; ++n) { const int drow = g * 128 + 32 * p + 8 * (fr >> 2) + 4 * n + (fr & 3);
                            const bf16x8 vf = *(const LAS bf16x8*)(vT + drow * VS + 32 * ks + 8 * fq);
                            acc[p][n] = __builtin_amdgcn_mfma_f32_16x16x32_bf16(vf, wf, acc[p][n], 0, 0, 0); }
                }
            }
            const float bias = bsv[g];
#pragma unroll
            for (int p = 0; p < 4; ++p) { const int d0 = g * 128 + 32 * p + 8 * fq; const u32x4 u = uu[p];
                u32x4 o;
                o.x = pk2(bflo(u.x) * (acc[p][0][0] + bias), bfhi(u.x) * (acc[p][0][1] + bias)); o.y = pk2(bflo(u.y) * (acc[p][0][2] + bias), bfhi(u.y) * (acc[p][0][3] + bias));
                o.z = pk2(bflo(u.z) * (acc[p][1][0] + bias), bfhi(u.z) * (acc[p][1][1] + bias)); o.w = pk2(bflo(u.w) * (acc[p][1][2] + bias), bfhi(u.w) * (acc[p][1][3] + bias));
                *(u32x4*)(Y + row * 1024 + d0) = o; }
        }
    }
    __syncthreads();
}

__device__ __forceinline__ void conv8_fetch(const bf16* Z, int b, int pos, int ch, u32x4 (&z)[4]) {
#pragma unroll
    for (int j = 0; j < 4; ++j) { const int tt = pos - 3 + j; z[j] = (tt >= 0) ? *(const u32x4*)(Z + ((size_t)b * SEQ + tt) * ZW + 1024 + ch) : (u32x4){0u, 0u, 0u, 0u}; }
}
__device__ __forceinline__ void conv8_math(const Args& a, int ch, const u32x4 (&zz)[4], float (&o)[8]) {
    const float* cw = a.in[I_CONVW]; const float* cb = a.in[I_CONVB];
    const f32x4 b0 = *(const f32x4*)(cb + ch), b1 = *(const f32x4*)(cb + ch + 4);
    float acc[8] = {b0[0], b0[1], b0[2], b0[3], b1[0], b1[1], b1[2], b1[3]};
#pragma unroll
    for (int j = 0; j < 4; ++j) { const u32x4 z = zz[j];
        const f32x4 w0 = *(const f32x4*)(cw + j * 512 + ch), w1 = *(const f32x4*)(cw + j * 512 + ch + 4);
        acc[0] += w0[0] * bflo(z.x); acc[1] += w0[1] * bfhi(z.x); acc[2] += w0[2] * bflo(z.y); acc[3] += w0[3] * bfhi(z.y);
        acc[4] += w1[0] * bflo(z.z); acc[5] += w1[1] * bfhi(z.z); acc[6] += w1[2] * bflo(z.w); acc[7] += w1[3] * bfhi(z.w); }
#pragma unroll
    for (int i = 0; i < 8; ++i) o[i] = pg8::silu_f(acc[i]);
}

struct M1Pre { u32x4 zk[4]; u32x4 vv[2]; float fpre, ipre; };
__device__ __forceinline__ void m1_fetch(const Args& a, int task, int tid, M1Pre& P) {
    const int wave = __builtin_amdgcn_readfirstlane(tid >> 6), lane = tid & 63;
    const bf16* Z = (const bf16*)(a.ws + WS_Z); const float* gates = (const float*)(a.ws + WS_GATES);
    const int b = task / (NHEAD * NCHK), h = (task / NCHK) % NHEAD, c = task % NCHK; const size_t row0 = (size_t)b * SEQ + c * 64;
    if (wave == 0) { P.fpre = gates[(row0 + lane) * 8 + 4 + h]; P.ipre = gates[(row0 + lane) * 8 + h]; }
    const int l = tid & 63, c8 = wave * 8, v16 = wave * 16;
    conv8_fetch(Z, b, c * 64 + l, 256 + h * 64 + c8, P.zk);
    const u32x4* vr = (const u32x4*)(Z + (row0 + l) * ZW + 1536 + h * 128 + v16); P.vv[0] = vr[0]; P.vv[1] = vr[1];
}
__device__ __forceinline__ void m1_body(const Args& a, LAS unsigned char* lds, int task, int tid, M1Pre& P, bool has_next, int next_task, M1Pre& Pn) {
    const int wave = __builtin_amdgcn_readfirstlane(tid >> 6), lane = tid & 63, fr = lane & 15, fq = lane >> 4;
    unsigned char* ws = a.ws;
    float* ML = (float*)(ws + WS_ML); float* BL = ML + NTASK; bf16* CST = (bf16*)(ws + WS_CST); float* NST = (float*)(ws + WS_NST);
    const int h = (task / NCHK) % NHEAD;
    constexpr int KS = 72;
    LAS float* wg = (LAS float*)lds;
    LAS bf16* kwT = (LAS bf16*)(lds + 256);
    LAS bf16* vT = (LAS bf16*)(lds + 256 + 64 * KS * 2);
    if (wave == 0) {
        const float fpre = P.fpre + a.in[I_FGB][h], ipre = P.ipre + a.in[I_IGB][h];
        const float bc = scan_add(logsigmoid_f(fpre), lane), blast = __shfl(bc, 63);
        const float g = blast - bc + ipre, mloc = wave_max(g);
        wg[lane] = expf(g - mloc);
        if (lane == 0) { ML[task] = mloc; BL[task] = blast; }
    }
    const int l = tid & 63, c8 = wave * 8, v16 = wave * 16;
    float kv[8]; conv8_math(a, 256 + h * 64 + c8, P.zk, kv);
#pragma unroll
    for (int q = 0; q < 2; ++q) { const u32x4 z = P.vv[q];
#pragma unroll
        for (int j = 0; j < 4; ++j) { vT[(v16 + 8 * q + 2 * j) * KS + l] = (bf16)(z[j] & 0xffffu); vT[(v16 + 8 * q + 2 * j + 1) * KS + l] = (bf16)(z[j] >> 16); } }
    LBAR();
    {
        const float sc = 0.125f * wg[l];
#pragma unroll
        for (int i = 0; i < 8; ++i) kwT[(c8 + i) * KS + l] = (bf16)f2bf(kv[i] * sc);
    }
    LBAR();
    if (has_next) m1_fetch(a, next_task, tid, Pn);
    {
        f32x4 acc[4];
#pragma unroll
        for (int kb = 0; kb < 4; ++kb) acc[kb] = (f32x4){0.f, 0.f, 0.f, 0.f};
#pragma unroll
        for (int ks = 0; ks < 2; ++ks) { const bf16x8 yf = *(const LAS bf16x8*)(vT + (16 * wave + fr) * KS + 32 * ks + 8 * fq);
#pragma unroll
            for (int kb = 0; kb < 4; ++kb) { const bf16x8 xf = *(const LAS bf16x8*)(kwT + (16 * kb + fr) * KS + 32 * ks + 8 * fq);
                acc[kb] = __builtin_amdgcn_mfma_f32_16x16x32_bf16(xf, yf, acc[kb], 0, 0, 0); } }
        bf16* cp = CST + (size_t)task * 8192 + (16 * wave + fr) * 64 + 4 * fq;
#pragma unroll
        for (int kb = 0; kb < 4; ++kb) { u32x2 o; o.x = pk2(acc[kb][0], acc[kb][1]); o.y = pk2(acc[kb][2], acc[kb][3]); *(u32x2*)(cp + 16 * kb) = o; }
        if (tid < 64) { float s = 0.f;
#pragma unroll 8
            for (int ll = 0; ll < 64; ++ll) s += __builtin_bit_cast(float, (unsigned)kwT[tid * KS + ll] << 16);
            NST[(size_t)task * 64 + tid] = s; }
    }
    LBAR();
}

__device__ __forceinline__ void scan_block(const Args& a, LAS unsigned char* lds, int vb, int tid) {
    unsigned char* ws = a.ws;
    float* ML = (float*)(ws + WS_ML); float* BL = ML + NTASK; float* MP = ML + 2 * NTASK; bf16* CST = (bf16*)(ws + WS_CST); float* NST = (float*)(ws + WS_NST);
    const int bh = vb >> 3, part = vb & 7;
    LAS float* sm = (LAS float*)lds;
    if (tid < 128) { sm[tid] = ML[bh * NCHK + tid]; sm[128 + tid] = BL[bh * NCHK + tid]; }
    typedef float f32x2v __attribute__((ext_vector_type(2)));
    unsigned* cp = (unsigned*)(CST + (size_t)bh * NCHK * 8192) + part * 512 + tid;
    const bool hasn = (part == 0 && tid < 64); float* np = NST + (size_t)bh * NCHK * 64 + tid;
    f32x2v cs = (f32x2v){0.f, 0.f}; float ns = 0.f, ms = 0.f;
    unsigned cl[8], cn[8]; float nl[8], nn[8];
#pragma unroll
    for (int i = 0; i < 8; ++i) { cl[i] = cp[(size_t)i * 4096]; nl[i] = hasn ? np[i * 64] : 0.f; }
    LBAR();
    for (int c0 = 0; c0 < NCHK; c0 += 8) {
        if (c0 + 8 < NCHK) {
#pragma unroll
            for (int i = 0; i < 8; ++i) { cn[i] = cp[(size_t)(c0 + 8 + i) * 4096]; nn[i] = hasn ? np[(c0 + 8 + i) * 64] : 0.f; }
        }
#pragma unroll
        for (int i = 0; i < 8; ++i) {
            const float ml = sm[c0 + i], bl = sm[128 + c0 + i];
            const float mn = fmaxf(bl + ms, ml), aa = __expf(bl + ms - mn), ee = __expf(ml - mn);
            cp[(size_t)(c0 + i) * 4096] = pk2(cs.x, cs.y); if (hasn) np[(c0 + i) * 64] = ns;
            if (part == 0 && tid == 0) MP[bh * NCHK + c0 + i] = ms;
            cs = cs * aa + (f32x2v){bflo(cl[i]), bfhi(cl[i])} * ee; ns = ns * aa + nl[i] * ee; ms = mn;
        }
#pragma unroll
        for (int i = 0; i < 8; ++i) { cl[i] = cn[i]; nl[i] = nn[i]; }
    }
    LBAR();
}

struct M3Pre { u32x4 zq[2][4]; u32x4 vv[2]; u32x4 cc[2]; u32x4 ov[2]; float fpre, ipre, mp, nst; };
__device__ __forceinline__ void m3_fetch(const Args& a, int task, int tid, M3Pre& P) {
    const int wave = __builtin_amdgcn_readfirstlane(tid >> 6), lane = tid & 63, fr = lane & 15, fq = lane >> 4;
    unsigned char* ws = a.ws;
    const bf16* Z = (const bf16*)(ws + WS_Z); const float* gates = (const float*)(ws + WS_GATES);
    const float* MP = (const float*)(ws + WS_ML) + 2 * NTASK; const bf16* CST = (const bf16*)(ws + WS_CST); const float* NST = (const float*)(ws + WS_NST);
    const int b = task / (NHEAD * NCHK), h = (task / NCHK) % NHEAD, c = task % NCHK; const size_t row0 = (size_t)b * SEQ + c * 64;
    if (wave == 0) { P.fpre = gates[(row0 + lane) * 8 + 4 + h]; P.ipre = gates[(row0 + lane) * 8 + h]; P.mp = MP[task]; P.nst = NST[(size_t)task * 64 + lane]; }
    { const int mat = tid >> 8, l = (tid & 255) >> 2, c16 = (tid & 3) * 16;
#pragma unroll
      for (int q = 0; q < 2; ++q) conv8_fetch(Z, b, c * 64 + l, mat * 256 + h * 64 + c16 + 8 * q, P.zq[q]); }
    { const int l = tid & 63, v16 = wave * 16; const u32x4* vr = (const u32x4*)(Z + (row0 + l) * ZW + 1536 + h * 128 + v16); P.vv[0] = vr[0]; P.vv[1] = vr[1]; }
    { const int v = tid >> 2, k16 = (tid & 3) * 16; const u32x4* cr = (const u32x4*)(CST + (size_t)task * 8192 + v * 64 + k16); P.cc[0] = cr[0]; P.cc[1] = cr[1]; }
    { const int tb = wave & 3, vh = wave >> 2, t = 16 * tb + fr;
#pragma unroll
      for (int p = 0; p < 2; ++p) P.ov[p] = *(const u32x4*)(Z + (row0 + t) * ZW + 2048 + h * 128 + vh * 64 + 32 * p + 8 * fq); }
}
__device__ __forceinline__ void m3_body(const Args& a, LAS unsigned char* lds, int task, int tid, M3Pre& P, bool has_next, int next_task, M3Pre& Pn) {
    const int wave = __builtin_amdgcn_readfirstlane(tid >> 6), lane = tid & 63, fr = lane & 15, fq = lane >> 4;
    unsigned char* ws = a.ws;
    bf16* Y = (bf16*)(ws + WS_Y);
    const int b = task / (NHEAD * NCHK), h = (task / NCHK) % NHEAD, c = task % NCHK; const size_t row0 = (size_t)b * SEQ + c * 64;
    constexpr int QS = 72, PS = 136;
    LAS float* bm = (LAS float*)lds; LAS float* ib = bm + 64; LAS float* ai = bm + 128; LAS float* emt = bm + 192;
    LAS float* hs = (LAS float*)(lds + 1024);
    LAS bf16* Qs = (LAS bf16*)(lds + 2048);
    LAS bf16* Ks = (LAS bf16*)(lds + 2048 + 9216);
    LAS bf16* Ps = (LAS bf16*)(lds + 20480);
    LAS bf16* Rs = (LAS bf16*)(lds + 37888);
    if (wave == 0) {
        const float fpre = P.fpre + a.in[I_FGB][h], ipre = P.ipre + a.in[I_IGB][h];
        const float bc = scan_add(logsigmoid_f(fpre), lane), ibv = ipre - bc, cm = scan_max(ibv, lane), mp = P.mp;
        const float mx = fmaxf(mp, cm), mt = bc + mx;
        bm[lane] = -mx; ib[lane] = ibv; ai[lane] = expf(mp - mx); emt[lane] = expf(-mt);
        Rs[128 * PS + lane] = (bf16)0x3f80u; Rs[128 * PS + 64 + lane] = (bf16)f2bf(P.nst);
    }
    {
        const int mat = tid >> 8, l = (tid & 255) >> 2, c16 = (tid & 3) * 16; LAS bf16* dst = (mat ? Ks : Qs) + l * QS + c16; const float sc = mat ? 0.125f : 1.0f;
#pragma unroll
        for (int q = 0; q < 2; ++q) { float kv[8]; conv8_math(a, mat * 256 + h * 64 + c16 + 8 * q, P.zq[q], kv);
            u32x4 o; o.x = pk2(kv[0] * sc, kv[1] * sc); o.y = pk2(kv[2] * sc, kv[3] * sc); o.z = pk2(kv[4] * sc, kv[5] * sc); o.w = pk2(kv[6] * sc, kv[7] * sc);
            *(LAS u32x4*)(dst + 8 * q) = o; }
    }
    {
        const int l = tid & 63, v16 = wave * 16;
#pragma unroll
        for (int q = 0; q < 2; ++q) { const u32x4 z = P.vv[q];
#pragma unroll
            for (int j = 0; j < 4; ++j) { Rs[(v16 + 8 * q + 2 * j) * PS + l] = (bf16)(z[j] & 0xffffu); Rs[(v16 + 8 * q + 2 * j + 1) * PS + l] = (bf16)(z[j] >> 16); } }
        const int v = tid >> 2, k16 = (tid & 3) * 16;
        *(LAS u32x4*)(Rs + v * PS + 64 + k16) = P.cc[0]; *(LAS u32x4*)(Rs + v * PS + 64 + k16 + 8) = P.cc[1];
    }
    const u32x4 ov0 = P.ov[0], ov1 = P.ov[1];
    LBAR();
    if (has_next) m3_fetch(a, next_task, tid, Pn);
    f32x4 gn[2][2];
    { const int vh = wave >> 2;
#pragma unroll
      for (int p = 0; p < 2; ++p) { const int v0 = h * 128 + vh * 64 + 32 * p + 8 * fq; gn[p][0] = *(const f32x4*)(a.in[I_MHN] + v0); gn[p][1] = *(const f32x4*)(a.in[I_MHN] + v0 + 4); } }
    {
        const int tb = wave & 3, sb2 = wave >> 2, t = 16 * tb + fr; const float bmt = bm[t];
#pragma unroll
        for (int e = 0; e < 2; ++e) { const int sb = 2 * sb2 + e; u32x2 o = (u32x2){0u, 0u};
            if (sb <= tb) { f32x4 acc = (f32x4){0.f, 0.f, 0.f, 0.f};
#pragma unroll
                for (int ks = 0; ks < 2; ++ks) { const bf16x8 xf = *(const LAS bf16x8*)(Ks + (16 * sb + fr) * QS + 32 * ks + 8 * fq), yf = *(const LAS bf16x8*)(Qs + t * QS + 32 * ks + 8 * fq);
                    acc = __builtin_amdgcn_mfma_f32_16x16x32_bf16(xf, yf, acc, 0, 0, 0); }
                float w[4];
#pragma unroll
                for (int j = 0; j < 4; ++j) { const int s = 16 * sb + 4 * fq + j; w[j] = (s <= t) ? __expf(bmt + ib[s]) * acc[j] : 0.f; }
                o.x = pk2(w[0], w[1]); o.y = pk2(w[2], w[3]); }
            *(LAS u32x2*)(Ps + t * PS + 16 * sb + 4 * fq) = o; }
        const int t2 = tid >> 3, k8 = (tid & 7) * 8; const float av = ai[t2]; const u32x4 qv = *(const LAS u32x4*)(Qs + t2 * QS + k8);
        u32x4 o; o.x = pk2(bflo(qv.x) * av, bfhi(qv.x) * av); o.y = pk2(bflo(qv.y) * av, bfhi(qv.y) * av); o.z = pk2(bflo(qv.z) * av, bfhi(qv.z) * av); o.w = pk2(bflo(qv.w) * av, bfhi(qv.w) * av);
        *(LAS u32x4*)(Ps + t2 * PS + 64 + k8) = o;
    }
    LBAR();
    {
        const int tb = wave & 3, vh = wave >> 2, t = 16 * tb + fr;
        f32x4 acc[2][2], accd = (f32x4){0.f, 0.f, 0.f, 0.f};
#pragma unroll
        for (int p = 0; p < 2; ++p) { acc[p][0] = (f32x4){0.f, 0.f, 0.f, 0.f}; acc[p][1] = (f32x4){0.f, 0.f, 0.f, 0.f}; }
#pragma unroll
        for (int ks = 0; ks < 4; ++ks) { const bf16x8 yf = *(const LAS bf16x8*)(Ps + t * PS + 32 * ks + 8 * fq);
#pragma unroll
            for (int p = 0; p < 2; ++p)
#pragma unroll
                for (int n = 0; n < 2; ++n) { const int vrow = vh * 64 + 32 * p + 8 * (fr >> 2) + 4 * n + (fr & 3);
                    const bf16x8 xf = *(const LAS bf16x8*)(Rs + vrow * PS + 32 * ks + 8 * fq);
                    acc[p][n] = __builtin_amdgcn_mfma_f32_16x16x32_bf16(xf, yf, acc[p][n], 0, 0, 0); }
            const bf16x8 xd = *(const LAS bf16x8*)(Rs + 128 * PS + 32 * ks + 8 * fq);
            accd = __builtin_amdgcn_mfma_f32_16x16x32_bf16(xd, yf, accd, 0, 0, 0); }
        const float den = accd[0], inv = 1.0f / fmaxf(fabsf(den), emt[t]);
        float ssq = 0.f;
#pragma unroll
        for (int p = 0; p < 2; ++p)
#pragma unroll
            for (int n = 0; n < 2; ++n) { acc[p][n] = acc[p][n] * inv; ssq += (acc[p][n][0] * acc[p][n][0] + acc[p][n][1] * acc[p][n][1]) + (acc[p][n][2] * acc[p][n][2] + acc[p][n][3] * acc[p][n][3]); }
        ssq += __shfl_xor(ssq, 16); ssq += __shfl_xor(ssq, 32);
        if (fq == 0) hs[t * 2 + vh] = ssq;
        LBAR();
        const float rs = __builtin_amdgcn_rsqf((hs[t * 2] + hs[t * 2 + 1]) * (1.f / 128.f) + EPS);
#pragma unroll
        for (int p = 0; p < 2; ++p) { const int v0 = h * 128 + vh * 64 + 32 * p + 8 * fq;
            const u32x4 ov = p ? ov1 : ov0; const f32x4 g0 = gn[p][0], g1 = gn[p][1];
            u32x4 o;
            o.x = pk2(acc[p][0][0] * rs * g0[0] * pg8::sigmoid_f(bflo(ov.x)), acc[p][0][1] * rs * g0[1] * pg8::sigmoid_f(bfhi(ov.x)));
            o.y = pk2(acc[p][0][2] * rs * g0[2] * pg8::sigmoid_f(bflo(ov.y)), acc[p][0][3] * rs * g0[3] * pg8::sigmoid_f(bfhi(ov.y)));
            o.z = pk2(acc[p][1][0] * rs * g1[0] * pg8::sigmoid_f(bflo(ov.z)), acc[p][1][1] * rs * g1[1] * pg8::sigmoid_f(bfhi(ov.z)));
            o.w = pk2(acc[p][1][2] * rs * g1[2] * pg8::sigmoid_f(bflo(ov.w)), acc[p][1][3] * rs * g1[3] * pg8::sigmoid_f(bfhi(ov.w)));
            *(u32x4*)(Y + (row0 + t) * 1024 + 512 + v0) = o; }
    }
    LBAR();
}

#define XB_TMO      128
#define XB_XCNT(j)  (256  + 64 * (j))
#define XB_XSUB(j)  (1280 + 64 * (j))
#define XB_XGEN(j)  (2304 + 64 * (j))
#define XB_TOP      3328
#define XB_TOPGEN   3392
#define XCD_BAR_WORDS 3456
#define XB_SPIN_CAP (1u << 18)

__device__ __forceinline__ unsigned xb_ld(unsigned* p)              { return __hip_atomic_load(p, __ATOMIC_RELAXED, __HIP_MEMORY_SCOPE_AGENT); }
__device__ __forceinline__ unsigned xb_add(unsigned* p, unsigned v) { return __hip_atomic_fetch_add(p, v, __ATOMIC_RELAXED, __HIP_MEMORY_SCOPE_AGENT); }
__device__ __forceinline__ unsigned xb_xcc_id() { return (unsigned)__builtin_amdgcn_s_getreg((3 << 11) | 20) & 0xFu; }
#define XB_SPIN(cond, bar) do { unsigned _sp = 0; while (cond) { __builtin_amdgcn_s_sleep(1); \
    if ((++_sp & 255u) == 0u) { if (xb_ld(&(bar)[XB_TMO])) break; if (_sp > XB_SPIN_CAP) { atomicAdd(&(bar)[XB_TMO], 1u); break; } } } } while (0)

struct XcdBarrier {
    unsigned* bar; unsigned x;
    volatile LAS unsigned* st;
};

__device__ __forceinline__ XcdBarrier xcd_barrier_post(unsigned* bar, volatile LAS unsigned* st) {
    XcdBarrier b; b.bar = bar; b.x = xb_xcc_id(); b.st = st;
    if (threadIdx.x == 0) (void)xb_add(&bar[XB_XCNT(b.x)], 1u);
    return b;
}
__device__ __forceinline__ void xcd_barrier_complete(unsigned* bar, unsigned x, unsigned& nloc, unsigned& nx) {
    const unsigned G = gridDim.x * gridDim.y * gridDim.z;
    unsigned sum, cnt, mine, sp = 0u;
    for (;;) {
        sum = 0u; cnt = 0u; mine = 0u;
#pragma unroll
        for (unsigned j = 0; j < 16; ++j) { const unsigned c = xb_ld(&bar[XB_XCNT(j)]); sum += c; cnt += (c > 0u) ? 1u : 0u; mine = (j == x) ? c : mine; }
        if (sum == G) break;
        __builtin_amdgcn_s_sleep(1);
        if ((++sp & 255u) == 0u) { if (xb_ld(&bar[XB_TMO])) break; if (sp > XB_SPIN_CAP) { atomicAdd(&bar[XB_TMO], 1u); break; } }
    }
    nloc = mine > 0u ? mine : 1u; nx = cnt > 0u ? cnt : 1u;
}

__device__ __forceinline__ void xcd_barrier(const XcdBarrier& b) {
    asm volatile("s_waitcnt vmcnt(0)" ::: "memory");
    __syncthreads();
    if (threadIdx.x == 0) {
        unsigned* bar = b.bar;
        __builtin_amdgcn_s_waitcnt(0);
        unsigned nloc = b.st[0], nx = b.st[1];
        if (nloc == 0u) { xcd_barrier_complete(bar, b.x, nloc, nx); b.st[0] = nloc; b.st[1] = nx; }
        const unsigned old = xb_add(&bar[XB_XSUB(b.x)], 1u);
        const unsigned gen = old / nloc;
        if (old + 1u == (gen + 1u) * nloc) {
            __builtin_amdgcn_fence(__ATOMIC_RELEASE, "agent");
            asm volatile("s_waitcnt vmcnt(0)" ::: "memory");
            const unsigned og = xb_add(&bar[XB_TOP], 1u);
            const unsigned tg = og / nx;
            if (og + 1u == (tg + 1u) * nx) xb_add(&bar[XB_TOPGEN], 1u);
            else XB_SPIN(xb_ld(&bar[XB_TOPGEN]) == tg, bar);
            __builtin_amdgcn_fence(__ATOMIC_ACQUIRE, "agent");
            xb_add(&bar[XB_XGEN(b.x)], 1u);
            asm volatile("s_waitcnt vmcnt(0)" ::: "memory");
        } else {
            XB_SPIN(xb_ld(&bar[XB_XGEN(b.x)]) == gen, bar);
            __builtin_amdgcn_fence(__ATOMIC_ACQUIRE, "agent");
            asm volatile("s_waitcnt vmcnt(0)" ::: "memory");
        }
    }
    __syncthreads();
}
__global__ void __launch_bounds__(NTHR, 2) fwd_megakernel(Args args) {
    extern __shared__ __attribute__((aligned(16))) unsigned char lds_raw[];
    LAS unsigned char* lds = (LAS unsigned char*)lds_raw;
    cg::grid_group grid = cg::this_grid();
    const int tid = threadIdx.x, wave = __builtin_amdgcn_readfirstlane(tid >> 6), lane = tid & 63;
    const int G = gridDim.x, bx = blockIdx.x, vcu = (G % 8 == 0) ? (bx % 8) * (G / 8) + bx / 8 : bx;
    unsigned char* ws = args.ws;
    const int lo = args.ph_lo, hi = args.ph_hi;
#define IN(k) (lo <= (k) && (k) < hi)
#define REPS(k) ((((REP_MASK) >> (k)) & 1) ? 2 : 1)
#define SEAM(k) do { if (IN(k) && IN((k) + 1)) { if (USE_CG_SYNC) grid.sync(); else xcd_barrier(xbar); } } while (0)
    volatile LAS unsigned* MISC = (volatile LAS unsigned*)(lds + MISC_OFF);
    if (tid < 32) MISC[tid] = 0u;
    __syncthreads();
    XcdBarrier xbar = xcd_barrier_post((unsigned*)(ws + WS_CTL) + 1024, MISC + 8);
    bf16* XB = (bf16*)(ws + WS_XB); bf16* HID = (bf16*)(ws + WS_HID); bf16* Zb = (bf16*)(ws + WS_Z); bf16* Yb = (bf16*)(ws + WS_Y);
    float* RSS = (float*)(ws + WS_RSS); float* X1 = args.out;

    if (hi < 0) grid.sync();
    if (IN(0)) { for (int rep = 0; rep < REPS(0); ++rep) p0_prologue(args, lds, vcu, G, tid); } SEAM(0);
    if (REPS(12) == 2) { for (int i = 0; i < 10; ++i) grid.sync(); }
    if (IN(1)) _Pragma("unroll") for (int rep = 0; rep < REPS(1); ++rep) {
        pg8::Gemm g{XB, (const bf16*)(ws + WS_WGU1), M, NGU, D}; pg8::StaticOrder S; S.init(M, NGU, G, bx);
        pg8::EpiGU E{HID, RSS, FF};
        pg8::gemm_phase<pg8::EpiGU, pg8::StaticOrder, GEMM_ALIGN, GEMM_SP2>(lds, g, S, E);
    } SEAM(1);
    if (IN(2)) {
        pg8::Gemm g{HID, (const bf16*)(ws + WS_WD1), M, D, FF}; pg8::StaticOrder S; S.init(M, D, G, bx);
        pg8::EpiRes<false> E{args.in[I_X], XB, RSS + M, 0.5f};
        pg8::gemm_phase<pg8::EpiRes<false>, pg8::StaticOrder, GEMM_ALIGN, GEMM_SP2>(lds, g, S, E);
    } SEAM(2);
    if (IN(3)) _Pragma("unroll") for (int rep = 0; rep < REPS(3); ++rep) {
        pg8::Gemm g{XB, (const bf16*)(ws + WS_WIN), M, NINP, D}; pg8::StaticOrder S; S.init(M, NINP, G, bx);
        pg8::EpiIn E{Zb, (float*)(ws + WS_GATES), RSS + M, ZW};
        pg8::gemm_phase<pg8::EpiIn, pg8::StaticOrder, GEMM_ALIGN, GEMM_SP2>(lds, g, S, E);
    } SEAM(3);
    if (IN(4)) {
        for (int rep = 0; rep < REPS(11); ++rep) for (int ch = vcu; ch < M / 128; ch += G) sgu_chunk(args, lds, ch, tid);
        { M1Pre P, Pn; int t = vcu; if (t < NTASK) m1_fetch(args, t, tid, P);
          for (; t < NTASK; t += G) { const int tn = t + G; m1_body(args, lds, t, tid, P, tn < NTASK, tn, Pn); P = Pn; } }
    } SEAM(4);
    if (IN(5)) { for (int vb = vcu; vb < 256; vb += G) scan_block(args, lds, vb, tid); } SEAM(5);
    if (IN(6)) { M3Pre P, Pn; int t = vcu; if (t < NTASK) m3_fetch(args, t, tid, P);
        for (; t < NTASK; t += G) { const int tn = t + G; m3_body(args, lds, t, tid, P, tn < NTASK, tn, Pn); P = Pn; } } SEAM(6);
    if (IN(7)) {
        pg8::Gemm g{Yb, (const bf16*)(ws + WS_WOUT), M, D, D}; pg8::StaticOrder S; S.init(M, D, G, bx);
        pg8::EpiRes<true> E{XB, XB, RSS + 2 * M, 1.0f};
        pg8::gemm_phase<pg8::EpiRes<true>, pg8::StaticOrder, GEMM_ALIGN, GEMM_SP2>(lds, g, S, E);
    } SEAM(7);
    if (IN(8)) {
        pg8::Gemm g{XB, (const bf16*)(ws + WS_WGU2), M, NGU, D}; pg8::StaticOrder S; S.init(M, NGU, G, bx);
        pg8::EpiGU E{HID, RSS + 2 * M, FF};
        pg8::gemm_phase<pg8::EpiGU, pg8::StaticOrder, GEMM_ALIGN, GEMM_SP2>(lds, g, S, E);
    } SEAM(8);
#if FUSE_FINAL
    if (IN(9)) {
        pg8::Gemm g{HID, (const bf16*)(ws + WS_WD2), M, D, FF}; pg8::StaticOrder S; S.init(M, D, G, bx);
        pg8::EpiResNorm E{XB, X1, RSS + 3 * M, (unsigned*)(ws + WS_CTL) + 8192, args.in[I_FINALN], 0.5f};
        pg8::gemm_phase<pg8::EpiResNorm, pg8::StaticOrder, GEMM_ALIGN, GEMM_SP2>(lds, g, S, E);
    }
#else
    if (IN(9)) {
        pg8::Gemm g{HID, (const bf16*)(ws + WS_WD2), M, D, FF}; pg8::StaticOrder S; S.init(M, D, G, bx);
        pg8::EpiRes<true> E{XB, XB, RSS + 3 * M, 0.5f};
        pg8::gemm_phase<pg8::EpiRes<true>, pg8::StaticOrder, GEMM_ALIGN, GEMM_SP2>(lds, g, S, E);
    } SEAM(9);
    if (IN(10)) {
        const int gw = vcu * NWAVES + wave, NGW = G * NWAVES; const float* rss3 = RSS + 3 * M; const f32x4* gn = (const f32x4*)args.in[I_FINALN];
        const f32x4 g0 = gn[lane], g1 = gn[64 + lane], g2 = gn[128 + lane], g3 = gn[192 + lane];
        for (int m0 = gw * 4; m0 < M; m0 += NGW * 4) {
            u32x2 v[4][4]; float r[4];
#pragma unroll
            for (int q = 0; q < 4; ++q) { const u32x2* xr = (const u32x2*)(XB + (size_t)(m0 + q) * D) + lane;
#pragma unroll
                for (int j = 0; j < 4; ++j) v[q][j] = __builtin_nontemporal_load(xr + 64 * j);
                r[q] = rss3[m0 + q]; }
#pragma unroll
            for (int q = 0; q < 4; ++q) { const float rs = __builtin_amdgcn_rsqf(r[q] * (1.f / 1024.f) + EPS); f32x4* o = (f32x4*)(X1 + (size_t)(m0 + q) * D) + lane;
                *(o) = ((f32x4){bflo(v[q][0].x), bfhi(v[q][0].x), bflo(v[q][0].y), bfhi(v[q][0].y)}) * rs * g0;
                *(o + 64) = ((f32x4){bflo(v[q][1].x), bfhi(v[q][1].x), bflo(v[q][1].y), bfhi(v[q][1].y)}) * rs * g1;
                *(o + 128) = ((f32x4){bflo(v[q][2].x), bfhi(v[q][2].x), bflo(v[q][2].y), bfhi(v[q][2].y)}) * rs * g2;
                *(o + 192) = ((f32x4){bflo(v[q][3].x), bfhi(v[q][3].x), bflo(v[q][3].y), bfhi(v[q][3].y)}) * rs * g3; }
        }
    }
#endif
#undef IN
#undef SEAM
}

#ifndef MK_N_LAUNCHES
#define MK_N_LAUNCHES 1
#endif
constexpr int N_PHASES = FUSE_FINAL ? 10 : 11;
extern "C" void kernel_launch(void* const* d_in, const int* in_sizes, int n_in, void* d_out, int out_size, void* d_ws, size_t ws_size, hipStream_t stream) {
    static int grid = 0;
    if (grid == 0) {
        if (n_in != 22 || in_sizes[0] != M * D || out_size != M * D || ws_size < WS_END) { fprintf(stderr, "kernel_launch: unexpected shapes (n_in %d, in0 %d, out %d, ws %zu)\n", n_in, n_in > 0 ? in_sizes[0] : -1, out_size, ws_size); grid = -1; return; }
        int dev = 0, cus = 0, per_cu = 0;
        hipGetDevice(&dev); hipDeviceGetAttribute(&cus, hipDeviceAttributeMultiprocessorCount, dev);
        hipFuncSetAttribute((const void*)fwd_megakernel, hipFuncAttributeMaxDynamicSharedMemorySize, LDS_BYTES);
        if (hipOccupancyMaxActiveBlocksPerMultiprocessor(&per_cu, (const void*)fwd_megakernel, NTHR, LDS_BYTES) != hipSuccess || per_cu < 1) { fprintf(stderr, "kernel_launch: occupancy query gave %d\n", per_cu); per_cu = 1; }
        (void)hipGetLastError();
        grid = cus * per_cu;
    }
    if (grid < 0) return;
    if (hipMemsetAsync((char*)d_ws + WS_CTL, 0, CTL_ZERO_BYTES, stream) != hipSuccess) { fprintf(stderr, "kernel_launch: memset failed\n"); return; }
    Args a{};
    for (int i = 0; i < 22; ++i) a.in[i] = (const float*)d_in[i];
    a.out = (float*)d_out; a.ws = (unsigned char*)d_ws;
#if MK_N_LAUNCHES == 1
    a.ph_lo = 0; a.ph_hi = N_PHASES;
    void* kargs[] = {&a};
    hipError_t e = hipLaunchCooperativeKernel((const void*)fwd_megakernel, dim3(grid), dim3(NTHR), kargs, LDS_BYTES, stream);
    if (e != hipSuccess) fprintf(stderr, "cooperative launch failed: %s (grid %d)\n", hipGetErrorString(e), grid);
#else
    for (int p = 0; p < N_PHASES; ++p) { a.ph_lo = p; a.ph_hi = p + 1; hipLaunchKernelGGL(fwd_megakernel, dim3(grid), dim3(NTHR), LDS_BYTES, stream, a); }
#endif
}
```

```cpp
#include <hip/hip_runtime.h>
#include <hip/hip_cooperative_groups.h>
#include <cstdio>
#include <cstdint>
namespace cg = cooperative_groups;
#ifndef REP_MASK
#define REP_MASK 0
#endif
#ifndef USE_CG_SYNC
#define USE_CG_SYNC 0
#endif
#ifndef FUSE_FINAL
#define FUSE_FINAL 1
#endif
#ifndef PG8_STGMMA
#define PG8_STGMMA 0
#endif
#ifndef GEMM_SP2
#define GEMM_SP2 true
#endif
#ifndef GEMM_ALIGN
#define GEMM_ALIGN true
#endif
namespace pg8 {
#define PG8_LAS __attribute__((address_space(3)))
typedef unsigned short bf16_t;
typedef short bf16x8 __attribute__((ext_vector_type(8)));
typedef float f32x4 __attribute__((ext_vector_type(4)));
typedef unsigned u32x4 __attribute__((ext_vector_type(4)));
constexpr int BM = 256, BK = 64, HALF = 128, HTB = HALF * BK * 2  , STAGE_BYTES = 8 * HTB, NXCD = 8, WGM = 4;

__host__ __device__ __forceinline__ int lds_byte(int r, int c) { const int st = (r >> 4) * 2 + (c >> 5), rr = r & 15, cc = c & 31, ob = rr * 64 + cc * 2; return st * 1024 + (ob ^ (((ob >> 9) & 1) << 5)); }
__host__ __device__ __forceinline__ void stage_rc(int b, int& R, int& C) { const int st = b / 1024, sb = b % 1024, swz = sb ^ (((sb >> 9) & 1) << 5); R = (st >> 1) * 16 + swz / 64; C = (st & 1) * 32 + (swz % 64) / 2; }
__host__ __device__ __forceinline__ int perm32(int rho) { const int n = rho >> 4, i = rho & 15; return 8 * (i >> 2) + 4 * n + (i & 3); }

struct Unit { int pm, pn; };
struct Gemm { const bf16_t* A; const bf16_t* Bt; int M, N, K; };

struct StaticOrder {
    int nM, nN, nwg, G, c;
    __host__ __device__ void init(int M, int N, int G_, int c_) { nM = M / BM; nN = N / BM; nwg = nM * nN; G = G_; c = c_; }
    __host__ __device__ bool next(int i, Unit& u) const {
        const long L = (long)i * G + c; if (L >= nwg) return false;
        int wgid = (int)L; { const int q = nwg / NXCD, r = nwg % NXCD, xcd = wgid % NXCD, off = wgid / NXCD; wgid = (xcd < r ? xcd * (q + 1) : r * (q + 1) + (xcd - r) * q) + off; }
        const int nig = WGM * nN, gid = wgid / nig, fm = gid * WGM, gsz = (nM - fm) < WGM ? (nM - fm) : WGM;
        u.pm = fm + ((wgid % nig) % gsz); u.pn = (wgid % nig) / gsz; return true;
    }
    __device__ __forceinline__ void a_ready(const Unit&) const {}
    __device__ __forceinline__ void done(const Unit&) const {}
};

__device__ __forceinline__ unsigned cvt_pk_bf16(float lo, float hi) { unsigned r; asm volatile("v_cvt_pk_bf16_f32 %0, %1, %2" : "=v"(r) : "v"(lo), "v"(hi)); return r; }
typedef float f32x2 __attribute__((ext_vector_type(2)));
__device__ __forceinline__ float silu_f(float g) { return g * __builtin_amdgcn_rcpf(1.0f + __builtin_amdgcn_exp2f(-1.44269504f * g)); }
__device__ __forceinline__ float sigmoid_f(float g) { return __builtin_amdgcn_rcpf(1.0f + __builtin_amdgcn_exp2f(-1.44269504f * g)); }
__device__ __forceinline__ float gelu_tanh_f(float x) { const float t = x * (1.0f + 0.044715f * x * x); return x * __builtin_amdgcn_rcpf(1.0f + __builtin_amdgcn_exp2f(-2.302208198f * t)); }
__device__ __forceinline__ float row_rs(const float* rowss, int row) { return __builtin_amdgcn_rsqf(rowss[row] * (1.0f / 1024.0f) + 1e-6f); }

struct EpiGU {
    static constexpr bool PERM = true, AFTER_DRAIN = false;
    bf16_t* H; const float* rowss; int ldh;
    __device__ __forceinline__ void prefetch(const Unit& u, int wr, int fr, float (&pre)[8]) const {
        const int row0 = u.pm * BM + wr * 64 + fr;
#pragma unroll
        for (int i = 0; i < 8; ++i) pre[i] = rowss[row0 + (i >> 2) * HALF + (i & 3) * 16];
    }
    __device__ __forceinline__ void operator()(const f32x4 (&acc)[2][2][4][2], const Unit& u, int wr, int wc, int fr, int fq, const float (&pre)[8]) const {
        const int row0 = u.pm * BM + wr * 64 + fr, col0 = u.pn * 128 + wc * 32 + 8 * fq;
        float rr[2][4];
#pragma unroll
        for (int ai = 0; ai < 2; ++ai)
#pragma unroll
            for (int m = 0; m < 4; ++m) rr[ai][m] = pre[ai * 4 + m];
#pragma unroll
        for (int ai = 0; ai < 2; ++ai)
#pragma unroll
            for (int m = 0; m < 4; ++m) {
                const int row = row0 + ai * HALF + m * 16; const float r = __builtin_amdgcn_rsqf(rr[ai][m] * (1.0f / 1024.0f) + 1e-6f), rn = -1.44269504f * r, r2 = r * r;
                unsigned w[4];
#pragma unroll
                for (int n = 0; n < 2; ++n)
#pragma unroll
                    for (int j = 0; j < 2; ++j) {
                        const f32x2 g = (f32x2){acc[ai][0][m][n][2 * j], acc[ai][0][m][n][2 * j + 1]}, uu = (f32x2){acc[ai][1][m][n][2 * j], acc[ai][1][m][n][2 * j + 1]};
                        const f32x2 t = g * rn; f32x2 e; e.x = __builtin_amdgcn_exp2f(t.x); e.y = __builtin_amdgcn_exp2f(t.y);
                        const f32x2 d = e + 1.0f; f32x2 sg; sg.x = __builtin_amdgcn_rcpf(d.x); sg.y = __builtin_amdgcn_rcpf(d.y);
                        const f32x2 h = ((g * uu) * r2) * sg;
                        w[n * 2 + j] = cvt_pk_bf16(h.x, h.y);
                    }
                u32x4 wv; wv.x = w[0]; wv.y = w[1]; wv.z = w[2]; wv.w = w[3];
                __builtin_nontemporal_store(wv, (u32x4*)(H + (size_t)row * ldh + col0));
            }
    }
};
template <bool BASE_BF16> struct EpiRes {
    static constexpr bool PERM = true, AFTER_DRAIN = false;
    const void* base; bf16_t* outb; float* rowss_out; float scale;
    __device__ __forceinline__ void prefetch(const Unit&, int, int, float (&)[8]) const {}
    __device__ __forceinline__ void operator()(const f32x4 (&acc)[2][2][4][2], const Unit& u, int wr, int wc, int fr, int fq, const float (&)[8]) const {
        const int row0 = u.pm * BM + wr * 64 + fr, col0 = u.pn * BM + wc * 32 + 8 * fq;
#pragma unroll
        for (int ai = 0; ai < 2; ++ai)
#pragma unroll
            for (int m = 0; m < 4; ++m) {
                const int row = row0 + ai * HALF + m * 16; float ss = 0.f;
#pragma unroll
                for (int bj = 0; bj < 2; ++bj) {
                    const size_t off = (size_t)row * 1024 + col0 + bj * HALF;
                    f32x4 b0, b1;
                    if (BASE_BF16) { const u32x4 bb = *(const u32x4*)((const bf16_t*)base + off);
                        b0 = (f32x4){__builtin_bit_cast(float, bb.x << 16), __builtin_bit_cast(float, bb.x & 0xffff0000u), __builtin_bit_cast(float, bb.y << 16), __builtin_bit_cast(float, bb.y & 0xffff0000u)};
                        b1 = (f32x4){__builtin_bit_cast(float, bb.z << 16), __builtin_bit_cast(float, bb.z & 0xffff0000u), __builtin_bit_cast(float, bb.w << 16), __builtin_bit_cast(float, bb.w & 0xffff0000u)}; }
                    else { b0 = *(const f32x4*)((const float*)base + off); b1 = *(const f32x4*)((const float*)base + off + 4); }
                    const f32x4 v0 = b0 + acc[ai][bj][m][0] * scale, v1 = b1 + acc[ai][bj][m][1] * scale;
                    u32x4 w; w.x = cvt_pk_bf16(v0[0], v0[1]); w.y = cvt_pk_bf16(v0[2], v0[3]); w.z = cvt_pk_bf16(v1[0], v1[1]); w.w = cvt_pk_bf16(v1[2], v1[3]); *(u32x4*)(outb + off) = w;
                    ss += (v0[0] * v0[0] + v0[1] * v0[1]) + (v0[2] * v0[2] + v0[3] * v0[3]) + (v1[0] * v1[0] + v1[1] * v1[1]) + (v1[2] * v1[2] + v1[3] * v1[3]);
                }
                ss += __shfl_xor(ss, 16); ss += __shfl_xor(ss, 32);
                if (fq == 0) __hip_atomic_fetch_add(rowss_out + row, ss, __ATOMIC_RELAXED, __HIP_MEMORY_SCOPE_AGENT);
            }
    }
};
struct EpiResNorm {
    static constexpr bool PERM = true, AFTER_DRAIN = false;
    const bf16_t* base; float* out; float* rowss; unsigned* cnt; const float* gain; float scale;
    __device__ __forceinline__ void prefetch(const Unit&, int, int, float (&)[8]) const {}
    __device__ __forceinline__ void operator()(f32x4 (&acc)[2][2][4][2], const Unit& u, int wr, int wc, int fr, int fq, const float (&)[8]) const {
        const int row0 = u.pm * BM + wr * 64 + fr, col0 = u.pn * BM + wc * 32 + 8 * fq;
#pragma unroll
        for (int ai = 0; ai < 2; ++ai)
#pragma unroll
            for (int m = 0; m < 4; ++m) {
                const int row = row0 + ai * HALF + m * 16; float ss = 0.f;
#pragma unroll
                for (int bj = 0; bj < 2; ++bj) {
                    const size_t off = (size_t)row * 1024 + col0 + bj * HALF;
                    const u32x4 bb = *(const u32x4*)(base + off);
                    const f32x4 b0 = (f32x4){__builtin_bit_cast(float, bb.x << 16), __builtin_bit_cast(float, bb.x & 0xffff0000u), __builtin_bit_cast(float, bb.y << 16), __builtin_bit_cast(float, bb.y & 0xffff0000u)};
                    const f32x4 b1 = (f32x4){__builtin_bit_cast(float, bb.z << 16), __builtin_bit_cast(float, bb.z & 0xffff0000u), __builtin_bit_cast(float, bb.w << 16), __builtin_bit_cast(float, bb.w & 0xffff0000u)};
                    const f32x4 v0 = b0 + acc[ai][bj][m][0] * scale, v1 = b1 + acc[ai][bj][m][1] * scale;
                    acc[ai][bj][m][0] = v0; acc[ai][bj][m][1] = v1;
                    ss += (v0[0] * v0[0] + v0[1] * v0[1]) + (v0[2] * v0[2] + v0[3] * v0[3]) + (v1[0] * v1[0] + v1[1] * v1[1]) + (v1[2] * v1[2] + v1[3] * v1[3]);
                }
                ss += __shfl_xor(ss, 16); ss += __shfl_xor(ss, 32);
                if (fq == 0) __hip_atomic_fetch_add(rowss + row, ss, __ATOMIC_RELAXED, __HIP_MEMORY_SCOPE_AGENT);
            }
        asm volatile("s_waitcnt vmcnt(0)" ::: "memory");
        unsigned* c = cnt + 16 * u.pm;
        if (fr == 0 && fq == 0) __hip_atomic_fetch_add(c, 1u, __ATOMIC_RELAXED, __HIP_MEMORY_SCOPE_AGENT);
        { unsigned sp = 0;
          while ((unsigned)__builtin_amdgcn_readfirstlane(__hip_atomic_load(c, __ATOMIC_RELAXED, __HIP_MEMORY_SCOPE_AGENT)) < 32u) { __builtin_amdgcn_s_sleep(2); if (++sp > (1u << 17)) break; } }
        asm volatile("" ::: "memory");
        float rsv[2][4];
#pragma unroll
        for (int ai = 0; ai < 2; ++ai)
#pragma unroll
            for (int m = 0; m < 4; ++m) rsv[ai][m] = __hip_atomic_load(rowss + row0 + ai * HALF + m * 16, __ATOMIC_RELAXED, __HIP_MEMORY_SCOPE_AGENT);
#pragma unroll
        for (int ai = 0; ai < 2; ++ai)
#pragma unroll
            for (int m = 0; m < 4; ++m) {
                const int row = row0 + ai * HALF + m * 16;
                const float r = __builtin_amdgcn_rsqf(rsv[ai][m] * (1.0f / 1024.0f) + 1e-6f);
#pragma unroll
                for (int bj = 0; bj < 2; ++bj) {
                    const int col = col0 + bj * HALF; const size_t off = (size_t)row * 1024 + col;
                    const f32x4 g0 = *(const f32x4*)(gain + col), g1 = *(const f32x4*)(gain + col + 4);
                    *(f32x4*)(out + off) = acc[ai][bj][m][0] * r * g0; *(f32x4*)(out + off + 4) = acc[ai][bj][m][1] * r * g1;
                }
            }
    }
};
struct EpiIn {
    static constexpr bool PERM = true, AFTER_DRAIN = false;
    bf16_t* Z; float* gates; const float* rowss; int ldz;
    __device__ __forceinline__ void prefetch(const Unit& u, int wr, int fr, float (&pre)[8]) const {
        const int row0 = u.pm * BM + wr * 64 + fr;
#pragma unroll
        for (int i = 0; i < 8; ++i) pre[i] = rowss[row0 + (i >> 2) * HALF + (i & 3) * 16];
    }
    __device__ __forceinline__ void operator()(const f32x4 (&acc)[2][2][4][2], const Unit& u, int wr, int wc, int fr, int fq, const float (&pre)[8]) const {
        const int row0 = u.pm * BM + wr * 64 + fr, col0 = u.pn * BM + wc * 32 + 8 * fq;
        if (u.pn == 10) {
            if (wc == 0 && fq == 0) {
#pragma unroll
                for (int ai = 0; ai < 2; ++ai)
#pragma unroll
                    for (int m = 0; m < 4; ++m) {
                        const int row = row0 + ai * HALF + m * 16; const float r = __builtin_amdgcn_rsqf(pre[ai * 4 + m] * (1.0f / 1024.0f) + 1e-6f);
                        *(f32x4*)(gates + (size_t)row * 8) = acc[ai][0][m][0] * r; *(f32x4*)(gates + (size_t)row * 8 + 4) = acc[ai][0][m][1] * r;
                    }
            }
            return;
        }
        const bool act = u.pn < 4;
#pragma unroll
        for (int ai = 0; ai < 2; ++ai)
#pragma unroll
            for (int m = 0; m < 4; ++m) {
                const int row = row0 + ai * HALF + m * 16; const float r = __builtin_amdgcn_rsqf(pre[ai * 4 + m] * (1.0f / 1024.0f) + 1e-6f);
#pragma unroll
                for (int bj = 0; bj < 2; ++bj) {
                    f32x4 v0 = acc[ai][bj][m][0] * r, v1 = acc[ai][bj][m][1] * r;
                    if (act) {
#pragma unroll
                        for (int j = 0; j < 2; ++j) {
                            f32x2 x0 = (f32x2){v0[2 * j], v0[2 * j + 1]}, x1 = (f32x2){v1[2 * j], v1[2 * j + 1]};
                            const f32x2 t0 = (x0 * x0 * 0.044715f + 1.0f) * x0 * (-2.302208198f), t1 = (x1 * x1 * 0.044715f + 1.0f) * x1 * (-2.302208198f);
                            f32x2 e0, e1; e0.x = __builtin_amdgcn_exp2f(t0.x); e0.y = __builtin_amdgcn_exp2f(t0.y); e1.x = __builtin_amdgcn_exp2f(t1.x); e1.y = __builtin_amdgcn_exp2f(t1.y);
                            e0 = e0 + 1.0f; e1 = e1 + 1.0f;
                            v0[2 * j] = x0.x * __builtin_amdgcn_rcpf(e0.x); v0[2 * j + 1] = x0.y * __builtin_amdgcn_rcpf(e0.y); v1[2 * j] = x1.x * __builtin_amdgcn_rcpf(e1.x); v1[2 * j + 1] = x1.y * __builtin_amdgcn_rcpf(e1.y);
                        }
                    }
                    u32x4 w; w.x = cvt_pk_bf16(v0[0], v0[1]); w.y = cvt_pk_bf16(v0[2], v0[3]); w.z = cvt_pk_bf16(v1[0], v1[1]); w.w = cvt_pk_bf16(v1[2], v1[3]);
                    __builtin_nontemporal_store(w, (u32x4*)(Z + (size_t)row * ldz + col0 + bj * HALF));
                }
            }
    }
};

template <class Epi, class Sched, bool ALIGN_EPI = false, bool SP2 = false>
__device__ __forceinline__ void gemm_phase(PG8_LAS unsigned char* lds, const Gemm g, const Sched& S, const Epi& E) {
    const int tid = threadIdx.x, wid = __builtin_amdgcn_readfirstlane(tid >> 6), lane = tid & 63, wr = wid >> 2, wc = wid & 3, fr = lane & 15, fq = lane >> 4;
    const int K = g.K, nt = K / BK;
    unsigned voffA[2], voffB[2];
#pragma unroll
    for (int i = 0; i < 2; ++i) { int R, C; stage_rc(tid * 16 + i * 8192, R, C); const int Rb = Epi::PERM ? ((R & ~31) + perm32(R & 31)) : R;
        voffA[i] = (unsigned)(R * K + C) * 2u; voffB[i] = (unsigned)(Rb * K + C) * 2u; }
    const size_t kstep = (size_t)(BK * 2);
    const size_t hstep = (size_t)HALF * K * 2;
    const size_t tstep = 2 * hstep;
    const unsigned ldsw = (unsigned)wid * 1024u;
    const int aoff = lds_byte(wr * 64 + fr, fq * 8), boff = lds_byte(wc * 32 + fr, fq * 8);
#define PG8_SA(b, h) (((b) * 2 + (h)) * HTB)
#define PG8_SB(b, h) ((4 + (b) * 2 + (h)) * HTB)
#define PG8_STAGE(bufoff, gbase, voff) do { _Pragma("unroll") for (int _i = 0; _i < 2; ++_i) \
        __builtin_amdgcn_global_load_lds((const unsigned*)((const char*)(gbase) + (voff)[_i]), (PG8_LAS unsigned*)(lds + (bufoff) + ldsw + _i * 8192), 16, 0, 0); } while (0)
#define PG8_LDA(dst, b, h) do { _Pragma("unroll") for (int m = 0; m < 4; ++m) _Pragma("unroll") for (int k = 0; k < 2; ++k) dst[m][k] = *(const PG8_LAS bf16x8*)(lds + PG8_SA(b, h) + aoff + m * 2048 + k * 1024); } while (0)
#define PG8_LDB(dst, b, h) do { _Pragma("unroll") for (int n = 0; n < 2; ++n) _Pragma("unroll") for (int k = 0; k < 2; ++k) dst[n][k] = *(const PG8_LAS bf16x8*)(lds + PG8_SB(b, h) + boff + n * 2048 + k * 1024); } while (0)
#define PG8_MMA(ai, bj, At, Bt) do { __builtin_amdgcn_s_setprio(1); _Pragma("unroll") for (int m = 0; m < 4; ++m) _Pragma("unroll") for (int n = 0; n < 2; ++n) _Pragma("unroll") for (int k = 0; k < 2; ++k) \
        acc[ai][bj][m][n] = __builtin_amdgcn_mfma_f32_16x16x32_bf16(Bt[n][k], At[m][k], acc[ai][bj][m][n], 0, 0, 0); __builtin_amdgcn_s_setprio(0); } while (0)
#define PG8_STAGE1(bufoff, gbase, voff, i) __builtin_amdgcn_global_load_lds((const unsigned*)((const char*)(gbase) + (voff)[i]), (PG8_LAS unsigned*)(lds + (bufoff) + ldsw + (i) * 8192), 16, 0, 0)
#define PG8_MMAQ(ai, bj, At, Bt, m) do { _Pragma("unroll") for (int n = 0; n < 2; ++n) _Pragma("unroll") for (int k = 0; k < 2; ++k) \
        acc[ai][bj][m][n] = __builtin_amdgcn_mfma_f32_16x16x32_bf16(Bt[n][k], At[m][k], acc[ai][bj][m][n], 0, 0, 0); } while (0)
#define PG8_M1(At, B0, B1, bufoff, gbase, voff) do { __builtin_amdgcn_s_setprio(1); \
        PG8_MMAQ(0, 0, At, B0, 0); PG8_MMAQ(0, 0, At, B0, 1); PG8_SCHED; PG8_STAGE1(bufoff, gbase, voff, 0); PG8_SCHED; \
        PG8_MMAQ(0, 0, At, B0, 2); PG8_MMAQ(0, 0, At, B0, 3); PG8_SCHED; PG8_STAGE1(bufoff, gbase, voff, 1); PG8_SCHED; \
        PG8_MMAQ(0, 1, At, B1, 0); PG8_MMAQ(0, 1, At, B1, 1); PG8_MMAQ(0, 1, At, B1, 2); PG8_MMAQ(0, 1, At, B1, 3); __builtin_amdgcn_s_setprio(0); } while (0)
#define PG8_M2(At, B0, B1, o0, g0, v0, o1, g1, v1, o2, g2, v2) do { __builtin_amdgcn_s_setprio(1); \
        PG8_MMAQ(1, 0, At, B0, 0); PG8_SCHED; PG8_STAGE1(o0, g0, v0, 0); PG8_SCHED; PG8_MMAQ(1, 0, At, B0, 1); PG8_SCHED; PG8_STAGE1(o0, g0, v0, 1); PG8_SCHED; \
        PG8_MMAQ(1, 0, At, B0, 2); PG8_SCHED; PG8_STAGE1(o1, g1, v1, 0); PG8_SCHED; PG8_MMAQ(1, 0, At, B0, 3); PG8_SCHED; PG8_STAGE1(o1, g1, v1, 1); PG8_SCHED; \
        PG8_MMAQ(1, 1, At, B1, 0); PG8_SCHED; PG8_STAGE1(o2, g2, v2, 0); PG8_SCHED; PG8_MMAQ(1, 1, At, B1, 1); PG8_SCHED; PG8_STAGE1(o2, g2, v2, 1); PG8_SCHED; \
        PG8_MMAQ(1, 1, At, B1, 2); PG8_MMAQ(1, 1, At, B1, 3); __builtin_amdgcn_s_setprio(0); } while (0)
#define PG8_WAIT_V(n) asm volatile("s_waitcnt vmcnt(" #n ")" ::: "memory")
#define PG8_WAIT_L(n) asm volatile("s_waitcnt lgkmcnt(" #n ")" ::: "memory")
#define PG8_BAR __builtin_amdgcn_s_barrier()
#define PG8_SCHED __builtin_amdgcn_sched_barrier(0)
    Unit cur, nxt; int ui = 0;
    if (!S.next(0, cur)) return;
    float pre[8]; E.prefetch(cur, wr, fr, pre);
    f32x4 acc[2][2][4][2];
#pragma unroll
    for (int a = 0; a < 2; ++a)
#pragma unroll
        for (int b = 0; b < 2; ++b)
#pragma unroll
            for (int m = 0; m < 4; ++m)
#pragma unroll
                for (int n = 0; n < 2; ++n) acc[a][b][m][n] = (f32x4){0.f, 0.f, 0.f, 0.f};
    bf16x8 At[4][2], B0[2][2], B1[2][2];
    const char* cA = (const char*)g.A + (size_t)cur.pm * tstep; const char* cB = (const char*)g.Bt + (size_t)cur.pn * tstep;
    S.a_ready(cur);
    if constexpr (SP2) {
        PG8_STAGE(PG8_SB(0, 0), cB, voffB); PG8_STAGE(PG8_SB(0, 1), cB + hstep, voffB); PG8_STAGE(PG8_SA(0, 0), cA, voffA); PG8_STAGE(PG8_SA(0, 1), cA + hstep, voffA);
        if (wr == 1) PG8_BAR;
        PG8_WAIT_V(2); PG8_BAR;
        PG8_STAGE(PG8_SB(1, 0), cB + kstep, voffB); PG8_STAGE(PG8_SA(1, 0), cA + kstep, voffA); PG8_STAGE(PG8_SB(1, 1), cB + hstep + kstep, voffB);
        PG8_WAIT_V(6); PG8_BAR;
    } else {
        PG8_STAGE(PG8_SB(0, 0), cB, voffB); PG8_STAGE(PG8_SA(0, 0), cA, voffA); PG8_STAGE(PG8_SB(0, 1), cB + hstep, voffB); PG8_STAGE(PG8_SA(0, 1), cA + hstep, voffA);
        if (wr == 1) PG8_BAR;
        PG8_WAIT_V(4); PG8_BAR;
        PG8_STAGE(PG8_SB(1, 0), cB + kstep, voffB); PG8_STAGE(PG8_SA(1, 0), cA + kstep, voffA); PG8_STAGE(PG8_SB(1, 1), cB + hstep + kstep, voffB);
        PG8_WAIT_V(6); PG8_BAR;
    }
    for (;;) {
        const bool has_next = S.next(ui + 1, nxt);
        const char* nA = has_next ? (const char*)g.A + (size_t)nxt.pm * tstep : cA; const char* nB = has_next ? (const char*)g.Bt + (size_t)nxt.pn * tstep : cB;
        for (int t = 0; t < nt; t += 2) {
            const bool last = (t == nt - 2);
            const char* a1 = cA + (size_t)(t + 1) * kstep;
            const char* a2 = last ? nA : cA + (size_t)(t + 2) * kstep; const char* b2 = last ? nB : cB + (size_t)(t + 2) * kstep;
            const char* a3 = a2 + kstep; const char* b3 = b2 + kstep;
            if (last && has_next) S.a_ready(nxt);
            if constexpr (SP2) {
#if PG8_STGMMA
            PG8_LDB(B0, 0, 0); PG8_LDB(B1, 0, 1); PG8_SCHED; PG8_LDA(At, 0, 0);
            PG8_WAIT_V(6); PG8_WAIT_L(0); PG8_BAR; PG8_M1(At, B0, B1, PG8_SA(1, 1), a1 + hstep, voffA); PG8_BAR; PG8_SCHED;
            PG8_LDA(At, 0, 1);
            PG8_WAIT_V(2); PG8_WAIT_L(0); PG8_BAR; PG8_M2(At, B0, B1, PG8_SB(0, 0), b2, voffB, PG8_SB(0, 1), b2 + hstep, voffB, PG8_SA(0, 0), a2, voffA); PG8_BAR; PG8_SCHED;
            PG8_LDB(B0, 1, 0); PG8_LDB(B1, 1, 1); PG8_SCHED; PG8_LDA(At, 1, 0);
            PG8_WAIT_V(6); PG8_WAIT_L(0); PG8_BAR; PG8_M1(At, B0, B1, PG8_SA(0, 1), a2 + hstep, voffA); PG8_BAR; PG8_SCHED;
            PG8_LDA(At, 1, 1);
            PG8_WAIT_V(2); PG8_WAIT_L(0); PG8_BAR; PG8_M2(At, B0, B1, PG8_SB(1, 0), b3, voffB, PG8_SB(1, 1), b3 + hstep, voffB, PG8_SA(1, 0), a3, voffA); PG8_BAR; PG8_SCHED;
#else
            PG8_LDB(B0, 0, 0); PG8_LDB(B1, 0, 1); PG8_SCHED; PG8_LDA(At, 0, 0); PG8_STAGE(PG8_SA(1, 1), a1 + hstep, voffA);
            PG8_WAIT_V(8); PG8_WAIT_L(0); PG8_BAR; PG8_MMA(0, 0, At, B0); PG8_MMA(0, 1, At, B1); PG8_BAR; PG8_SCHED;
            PG8_LDA(At, 0, 1); PG8_STAGE(PG8_SB(0, 0), b2, voffB); PG8_STAGE(PG8_SB(0, 1), b2 + hstep, voffB); PG8_STAGE(PG8_SA(0, 0), a2, voffA);
            PG8_WAIT_V(8); PG8_WAIT_L(0); PG8_BAR; PG8_MMA(1, 0, At, B0); PG8_MMA(1, 1, At, B1); PG8_BAR; PG8_SCHED;
            PG8_LDB(B0, 1, 0); PG8_LDB(B1, 1, 1); PG8_SCHED; PG8_LDA(At, 1, 0); PG8_STAGE(PG8_SA(0, 1), a2 + hstep, voffA);
            PG8_WAIT_V(8); PG8_WAIT_L(0); PG8_BAR; PG8_MMA(0, 0, At, B0); PG8_MMA(0, 1, At, B1); PG8_BAR; PG8_SCHED;
            PG8_LDA(At, 1, 1); PG8_STAGE(PG8_SB(1, 0), b3, voffB); PG8_STAGE(PG8_SB(1, 1), b3 + hstep, voffB); PG8_STAGE(PG8_SA(1, 0), a3, voffA);
            PG8_WAIT_V(8); PG8_WAIT_L(0); PG8_BAR; PG8_MMA(1, 0, At, B0); PG8_MMA(1, 1, At, B1); PG8_BAR; PG8_SCHED;
#endif
            } else {
            PG8_LDB(B0, 0, 0); PG8_SCHED; PG8_LDA(At, 0, 0); PG8_STAGE(PG8_SA(1, 1), a1 + hstep, voffA);
            PG8_WAIT_L(8); PG8_BAR; PG8_WAIT_L(0); PG8_MMA(0, 0, At, B0); PG8_BAR; PG8_SCHED;
            PG8_LDB(B1, 0, 1); PG8_STAGE(PG8_SB(0, 0), b2, voffB);
            PG8_BAR; PG8_WAIT_L(0); PG8_MMA(0, 1, At, B1); PG8_BAR;
            PG8_LDA(At, 0, 1); PG8_STAGE(PG8_SA(0, 0), a2, voffA);
            PG8_BAR; PG8_WAIT_L(0); PG8_MMA(1, 0, At, B0); PG8_BAR; PG8_SCHED;
            PG8_STAGE(PG8_SB(0, 1), b2 + hstep, voffB);
            PG8_WAIT_V(6); PG8_BAR; PG8_MMA(1, 1, At, B1); PG8_BAR;
            PG8_LDB(B0, 1, 0); PG8_SCHED; PG8_LDA(At, 1, 0); PG8_STAGE(PG8_SA(0, 1), a2 + hstep, voffA);
            PG8_WAIT_L(8); PG8_BAR; PG8_WAIT_L(0); PG8_MMA(0, 0, At, B0); PG8_BAR; PG8_SCHED;
            PG8_LDB(B1, 1, 1); PG8_STAGE(PG8_SB(1, 0), b3, voffB);
            PG8_BAR; PG8_WAIT_L(0); PG8_MMA(0, 1, At, B1); PG8_BAR;
            PG8_LDA(At, 1, 1); PG8_STAGE(PG8_SA(1, 0), a3, voffA);
            PG8_BAR; PG8_WAIT_L(0); PG8_MMA(1, 0, At, B0); PG8_BAR; PG8_SCHED;
            PG8_STAGE(PG8_SB(1, 1), b3 + hstep, voffB);
            PG8_WAIT_V(6); PG8_BAR; PG8_MMA(1, 1, At, B1); PG8_BAR;
            }
        }
        if constexpr (ALIGN_EPI) { if (wr == 0) PG8_BAR; }
        if constexpr (!Epi::AFTER_DRAIN) { E(acc, cur, wr, wc, fr, fq, pre); S.done(cur); }
        if (!has_next) break;
#pragma unroll
        for (int a = 0; a < 2; ++a)
#pragma unroll
            for (int b = 0; b < 2; ++b)
#pragma unroll
                for (int m = 0; m < 4; ++m)
#pragma unroll
                    for (int n = 0; n < 2; ++n) acc[a][b][m][n] = (f32x4){0.f, 0.f, 0.f, 0.f};
        cur = nxt; cA = nA; cB = nB; ++ui;
        E.prefetch(cur, wr, fr, pre);
        if constexpr (ALIGN_EPI) { if (wr == 1) PG8_BAR; }
    }
    PG8_WAIT_V(0);
    if constexpr (!ALIGN_EPI) { if (wr == 0) PG8_BAR; }
    PG8_BAR;
    if constexpr (Epi::AFTER_DRAIN) { E.fused(acc, cur, wr, wc, fr, fq, lds, wid, lane); S.done(cur); }
#undef PG8_SA
#undef PG8_SB
#undef PG8_STAGE
#undef PG8_LDA
#undef PG8_LDB
#undef PG8_MMA
#undef PG8_MMAQ
#undef PG8_M1
#undef PG8_M2
#undef PG8_STAGE1
#undef PG8_WAIT_V
#undef PG8_WAIT_L
#undef PG8_BAR
#undef PG8_SCHED
}
}

constexpr int NWAVES = 8, NTHR = 512;
constexpr int BATCH = 8, SEQ = 8192, D = 1024, M = BATCH * SEQ, FF = 2816, NGU = 2 * FF, NIN = 2568, NINP = 2816, ZW = 2560, NCHK = SEQ / 64, NHEAD = 4;
constexpr int NTASK = BATCH * NHEAD * NCHK;
constexpr float EPS = 1e-6f;
constexpr size_t MiB = 1u << 20;
constexpr size_t WS_WGU1 = 2 * MiB, WS_WD1 = 13 * MiB, WS_WIN = 19 * MiB, WS_WOUT = 25 * MiB, WS_WGU2 = 27 * MiB, WS_WD2 = 38 * MiB, WS_SGUW = 44 * MiB;
constexpr size_t WS_RSS = 45 * MiB, WS_GATES = 46 * MiB, WS_ML = 48 * MiB, WS_NST = 49 * MiB;
constexpr size_t WS_XB = 64 * MiB, WS_HID = 192 * MiB, WS_Z = 192 * MiB, WS_Y = 544 * MiB, WS_CST = 672 * MiB, WS_END = 800 * MiB;
constexpr int LDS_BYTES = 147456, MISC_OFF = LDS_BYTES - 128;
constexpr size_t WS_CTL = 0, CTL_ZERO_BYTES = 65536;

#define LAS __attribute__((address_space(3)))
typedef unsigned short bf16;
typedef unsigned u32x4 __attribute__((ext_vector_type(4)));
typedef unsigned u32x2 __attribute__((ext_vector_type(2)));
typedef float f32x4 __attribute__((ext_vector_type(4)));
typedef short bf16x8 __attribute__((ext_vector_type(8)));
#define LDS_WAIT() asm volatile("s_waitcnt lgkmcnt(0)" ::: "memory")
#define LBAR() do { asm volatile("s_waitcnt lgkmcnt(0)" ::: "memory"); __builtin_amdgcn_s_barrier(); asm volatile("" ::: "memory"); } while (0)
__device__ __forceinline__ unsigned f2bf(float f) { unsigned u = __builtin_bit_cast(unsigned, f); return (u + 0x7fffu + ((u >> 16) & 1u)) >> 16; }
__device__ __forceinline__ unsigned pk2(float lo, float hi) { return f2bf(lo) | (f2bf(hi) << 16); }
__device__ __forceinline__ float bflo(unsigned w) { return __builtin_bit_cast(float, w << 16); }
__device__ __forceinline__ float bfhi(unsigned w) { return __builtin_bit_cast(float, w & 0xffff0000u); }
__device__ __forceinline__ float wave_sum(float v) {
#pragma unroll
    for (int o = 1; o < 64; o <<= 1) v += __shfl_xor(v, o);
    return v;
}
__device__ __forceinline__ float wave_max(float v) {
#pragma unroll
    for (int o = 1; o < 64; o <<= 1) v = fmaxf(v, __shfl_xor(v, o));
    return v;
}
template <int CTRL, int ROWMASK> __device__ __forceinline__ float dpp_mov(float ident, float src) {
    return __builtin_bit_cast(float, __builtin_amdgcn_update_dpp(__builtin_bit_cast(int, ident), __builtin_bit_cast(int, src), CTRL, ROWMASK, 0xf, false));
}
__device__ __forceinline__ float scan_add(float v, int) {
    v += dpp_mov<0x111, 0xf>(0.f, v); v += dpp_mov<0x112, 0xf>(0.f, v); v += dpp_mov<0x114, 0xf>(0.f, v); v += dpp_mov<0x118, 0xf>(0.f, v);
    v += dpp_mov<0x142, 0xa>(0.f, v); v += dpp_mov<0x143, 0xc>(0.f, v);
    return v;
}
__device__ __forceinline__ float scan_max(float v, int) {
    const float ninf = -__builtin_inff();
    v = fmaxf(v, dpp_mov<0x111, 0xf>(ninf, v)); v = fmaxf(v, dpp_mov<0x112, 0xf>(ninf, v)); v = fmaxf(v, dpp_mov<0x114, 0xf>(ninf, v)); v = fmaxf(v, dpp_mov<0x118, 0xf>(ninf, v));
    v = fmaxf(v, dpp_mov<0x142, 0xa>(ninf, v)); v = fmaxf(v, dpp_mov<0x143, 0xc>(ninf, v));
    return v;
}
__device__ __forceinline__ float logsigmoid_f(float x) { const float e = __expf(-fabsf(x)); return fminf(x, 0.f) - ((e < 1e-4f) ? e * (1.0f - 0.5f * e) : __logf(1.0f + e)); }

struct Args {
    const float* in[22]; float* out; unsigned char* ws; int ph_lo, ph_hi;
};
enum { I_X = 0, I_N1, I_G1, I_U1, I_D1, I_MIXN, I_WIN, I_LNG, I_LNB, I_SGUW, I_SGUB, I_CONVW, I_CONVB, I_IGB, I_FGB, I_MHN, I_WOUT, I_N2, I_G2, I_U2, I_D2, I_FINALN };

__device__ __forceinline__ void tr_item(const float* __restrict__ W, int K, int N, const float* __restrict__ gain, bf16* WT, int drow0, int k0, int n0, LAS float* scr, int lane) {
    const int kk8 = lane >> 3, c4 = (lane & 7) * 4; const bool ok = (n0 + c4) < N;
    f32x4 v[8];
#pragma unroll
    for (int i = 0; i < 8; ++i) { const int kk = 8 * i + kk8; v[i] = ok ? *(const f32x4*)(W + (size_t)(k0 + kk) * N + n0 + c4) : (f32x4){0.f, 0.f, 0.f, 0.f}; }
#pragma unroll
    for (int i = 0; i < 8; ++i) { const int kk = 8 * i + kk8; const float g = gain ? gain[k0 + kk] : 1.0f; LAS float* d = scr + kk * 33 + c4;
        d[0] = v[i][0] * g; d[1] = v[i][1] * g; d[2] = v[i][2] * g; d[3] = v[i][3] * g; }
    LDS_WAIT(); asm volatile("" ::: "memory");
    const int c = lane & 7;
#pragma unroll
    for (int j = 0; j < 4; ++j) { const int nn = (lane >> 3) + 8 * j; const LAS float* s = scr + (8 * c) * 33 + nn;
        u32x4 o; o.x = pk2(s[0 * 33], s[1 * 33]); o.y = pk2(s[2 * 33], s[3 * 33]); o.z = pk2(s[4 * 33], s[5 * 33]); o.w = pk2(s[6 * 33], s[7 * 33]);
        *(u32x4*)(WT + (size_t)(drow0 + nn) * K + k0 + 8 * c) = o; }
    LDS_WAIT(); asm volatile("" ::: "memory");
}
__device__ __forceinline__ void p0_prologue(const Args& a, LAS unsigned char* lds, int vcu, int G, int tid) {
    const int wave = __builtin_amdgcn_readfirstlane(tid >> 6), lane = tid & 63;
    unsigned char* ws = a.ws;
    LAS float* scr = (LAS float*)(lds + wave * 16384);
    const int gw = vcu * NWAVES + wave, NGW = G * NWAVES;
    constexpr int IT_GU = 16 * 88, IT_D = 44 * 32, IT_IN = 16 * 88, IT_OUT = 16 * 32;
    constexpr int NITEMS = 4 * IT_GU + 2 * IT_D + IT_IN + IT_OUT;
    for (int it = gw; it < NITEMS; it += NGW) {
        int r = it;
        if (r < 2 * IT_GU) {
            const int s = r / IT_GU; r -= s * IT_GU; const int kb = r / 88, nb = r % 88, n0 = nb * 32;
            tr_item(a.in[s ? I_U1 : I_G1], D, FF, a.in[I_N1], (bf16*)(ws + WS_WGU1), 256 * (n0 >> 7) + 128 * s + (n0 & 127), kb * 64, n0, scr, lane); continue; }
        r -= 2 * IT_GU;
        if (r < 2 * IT_GU) {
            const int s = r / IT_GU; r -= s * IT_GU; const int kb = r / 88, nb = r % 88, n0 = nb * 32;
            tr_item(a.in[s ? I_U2 : I_G2], D, FF, a.in[I_N2], (bf16*)(ws + WS_WGU2), 256 * (n0 >> 7) + 128 * s + (n0 & 127), kb * 64, n0, scr, lane); continue; }
        r -= 2 * IT_GU;
        if (r < 2 * IT_D) {
            const int s = r / IT_D; r -= s * IT_D; const int kb = r / 32, nb = r % 32, n0 = nb * 32;
            tr_item(a.in[s ? I_D2 : I_D1], FF, D, nullptr, (bf16*)(ws + (s ? WS_WD2 : WS_WD1)), n0, kb * 64, n0, scr, lane); continue; }
        r -= 2 * IT_D;
        if (r < IT_IN) { const int kb = r / 88, nb = r % 88, n0 = nb * 32;
            tr_item(a.in[I_WIN], D, NIN, a.in[I_MIXN], (bf16*)(ws + WS_WIN), n0, kb * 64, n0, scr, lane); continue; }
        r -= IT_IN;
        { const int kb = r / 32, nb = r % 32, n0 = nb * 32;
            tr_item(a.in[I_WOUT], D, D, nullptr, (bf16*)(ws + WS_WOUT), n0, kb * 64, n0, scr, lane); }
    }
    {
        float* rss0 = (float*)(ws + WS_RSS); bf16* XB = (bf16*)(ws + WS_XB); const float* x = a.in[I_X];
        for (int m0 = gw * 4; m0 < M; m0 += NGW * 4) {
            f32x4 v[4][4];
#pragma unroll
            for (int r = 0; r < 4; ++r) { const f32x4* xr = (const f32x4*)(x + (size_t)(m0 + r) * D) + lane;
#pragma unroll
                for (int j = 0; j < 4; ++j) v[r][j] = __builtin_nontemporal_load(xr + 64 * j); }
#pragma unroll
            for (int r = 0; r < 4; ++r) { unsigned long long* o8 = (unsigned long long*)(XB + (size_t)(m0 + r) * D) + lane; float s = 0.f;
#pragma unroll
                for (int j = 0; j < 4; ++j) { s += (v[r][j].x * v[r][j].x + v[r][j].y * v[r][j].y) + (v[r][j].z * v[r][j].z + v[r][j].w * v[r][j].w);
                    o8[64 * j] = (unsigned long long)pk2(v[r][j].x, v[r][j].y) | ((unsigned long long)pk2(v[r][j].z, v[r][j].w) << 32); }
                s = wave_sum(s); if (lane == 0) rss0[m0 + r] = s; }
        }
    }
    {
        float* rss = (float*)(ws + WS_RSS) + M; const int gt = vcu * NTHR + tid, NGT = G * NTHR;
        for (int i = gt; i < 3 * M; i += NGT) rss[i] = 0.f;
        bf16* sw = (bf16*)(ws + WS_SGUW); const float* w = a.in[I_SGUW];
        for (int i = gt; i < 4 * 128 * 128; i += NGT) { const int t = (i >> 7) & 127, s = i & 127; sw[i] = (bf16)(((t >> 6) >= (s >> 6)) ? f2bf(w[i]) : 0u); }
    }
}

__device__ __forceinline__ void sgu_chunk(const Args& a, LAS unsigned char* lds, int chunk, int tid) {
    const int wave = __builtin_amdgcn_readfirstlane(tid >> 6), lane = tid & 63, fr = lane & 15, fq = lane >> 4;
    unsigned char* ws = a.ws;
    const bf16* Z = (const bf16*)(ws + WS_Z); bf16* Y = (bf16*)(ws + WS_Y); const bf16* SW = (const bf16*)(ws + WS_SGUW);
    constexpr int VS = 136;
    LAS bf16* vT = (LAS bf16*)lds;
    LAS float* st = (LAS float*)(lds + 512 * VS * 2);
    bf16x8 wfr[4][4]; float bsv[4];
    { const int tt = 16 * wave + fr;
#pragma unroll
      for (int g = 0; g < 4; ++g) { bsv[g] = a.in[I_SGUB][g * 128 + tt];
#pragma unroll
          for (int ks = 0; ks < 4; ++ks) wfr[g][ks] = *(const bf16x8*)(SW + ((size_t)(g * 128 + tt) * 128 + 32 * ks + 8 * fq)); } }
    {
        const int t = tid & 127, g = tid >> 7;
        const u32x4* zr = (const u32x4*)(Z + ((size_t)chunk * 128 + t) * ZW + 512 + g * 128);
        u32x4 raw[16]; float s = 0.f, ss = 0.f;
#pragma unroll
        for (int i = 0; i < 16; ++i) { raw[i] = zr[i];
#pragma unroll
            for (int j = 0; j < 4; ++j) { const float lo = bflo(raw[i][j]), hi = bfhi(raw[i][j]); s += lo + hi; ss += lo * lo + hi * hi; } }
        st[(g * 128 + t) * 2] = s; st[(g * 128 + t) * 2 + 1] = ss;
        __syncthreads();
        float S = 0.f, SS = 0.f;
#pragma unroll
        for (int gg = 0; gg < 4; ++gg) { S += st[(gg * 128 + t) * 2]; SS += st[(gg * 128 + t) * 2 + 1]; }
        const float mu = S * (1.f / 512.f), var = fmaxf(SS * (1.f / 512.f) - mu * mu, 0.f), rstd = 1.0f / sqrtf(var + EPS);
        const float* lg = a.in[I_LNG] + g * 128; const float* lb = a.in[I_LNB] + g * 128;
#pragma unroll
        for (int i = 0; i < 16; ++i)
#pragma unroll
            for (int j = 0; j < 4; ++j) { const int d = 8 * i + 2 * j;
                const float y0 = (bflo(raw[i][j]) - mu) * rstd * lg[d] + lb[d], y1 = (bfhi(raw[i][j]) - mu) * rstd * lg[d + 1] + lb[d + 1];
                vT[(g * 128 + d) * VS + t] = (bf16)f2bf(y0); vT[(g * 128 + d + 1) * VS + t] = (bf16)f2bf(y1); }
    }
    __syncthreads();
    {
        const int tb = wave, tt = 16 * tb + fr; const size_t row = (size_t)chunk * 128 + tt; const bool full = tb >= 4;
#pragma unroll
        for (int g = 0; g < 4; ++g) {
            f32x4 acc[4][2];
#pragma unroll
            for (int p = 0; p < 4; ++p) { acc[p][0] = (f32x4){0.f, 0.f, 0.f, 0.f}; acc[p][1] = (f32x4){0.f, 0.f, 0.f, 0.f}; }
            u32x4 uu[4];
#pragma unroll
            for (int p = 0; p < 4; ++p) uu[p] = *(const u32x4*)(Z + row * ZW + g * 128 + 32 * p + 8 * fq);
#pragma unroll
            for (int ks = 0; ks < 4; ++ks) {
                if (ks < 2 || full) {
                    const bf16x8 wf = wfr[g][ks];
#pragma unroll
                    for (int p = 0; p < 4; ++p)
#pragma unroll
                        for (int n = 0; n < 2; ++n) { const int drow = g * 128 + 32 * p + 8 * (fr >> 2) + 4 * n + (fr & 3);
                            const bf16x8 vf = *(const LAS bf16x8*)(vT + drow * VS + 32 * ks + 8 * fq);
                            acc[p][n] = __builtin_amdgcn_mfma_f32_16x16x32_bf16(vf, wf, acc[p][n], 0, 0, 0); }
                }
            }
            const float bias = bsv[g];
#pragma unroll
            for (int p = 0; p < 4; ++p) { const int d0 = g * 128 + 32 * p + 8 * fq; const u32x4 u = uu[p];
                u32x4 o;
                o.x = pk2(bflo(u.x) * (acc[p][0][0] + bias), bfhi(u.x) * (acc[p][0][1] + bias)); o.y = pk2(bflo(u.y) * (acc[p][0][2] + bias), bfhi(u.y) * (acc[p][0][3] + bias));
                o.z = pk2(bflo(u.z) * (acc[p][1][0] + bias), bfhi(u.z) * (acc[p][1][1] + bias)); o.w = pk2(bflo(u.w) * (acc[p][1][2] + bias), bfhi(u.w) * (acc[p][1][3] + bias));
                *(u32x4*)(Y + row * 1024 + d0) = o; }
        }
    }
    __syncthreads();
}

__device__ __forceinline__ void conv8_fetch(const bf16* Z, int b, int pos, int ch, u32x4 (&z)[4]) {
#pragma unroll
    for (int j = 0; j < 4; ++j) { const int tt = pos - 3 + j; z[j] = (tt >= 0) ? *(const u32x4*)(Z + ((size_t)b * SEQ + tt) * ZW + 1024 + ch) : (u32x4){0u, 0u, 0u, 0u}; }
}
__device__ __forceinline__ void conv8_math(const Args& a, int ch, const u32x4 (&zz)[4], float (&o)[8]) {
    const float* cw = a.in[I_CONVW]; const float* cb = a.in[I_CONVB];
    const f32x4 b0 = *(const f32x4*)(cb + ch), b1 = *(const f32x4*)(cb + ch + 4);
    float acc[8] = {b0[0], b0[1], b0[2], b0[3], b1[0], b1[1], b1[2], b1[3]};
#pragma unroll
    for (int j = 0; j < 4; ++j) { const u32x4 z = zz[j];
        const f32x4 w0 = *(const f32x4*)(cw + j * 512 + ch), w1 = *(const f32x4*)(cw + j * 512 + ch + 4);
        acc[0] += w0[0] * bflo(z.x); acc[1] += w0[1] * bfhi(z.x); acc[2] += w0[2] * bflo(z.y); acc[3] += w0[3] * bfhi(z.y);
        acc[4] += w1[0] * bflo(z.z); acc[5] += w1[1] * bfhi(z.z); acc[6] += w1[2] * bflo(z.w); acc[7] += w1[3] * bfhi(z.w); }
#pragma unroll
    for (int i = 0; i < 8; ++i) o[i] = pg8::silu_f(acc[i]);
}

struct M1Pre { u32x4 zk[4]; u32x4 vv[2]; float fpre, ipre; };
__device__ __forceinline__ void m1_fetch(const Args& a, int task, int tid, M1Pre& P) {
    const int wave = __builtin_amdgcn_readfirstlane(tid >> 6), lane = tid & 63;
    const bf16* Z = (const bf16*)(a.ws + WS_Z); const float* gates = (const float*)(a.ws + WS_GATES);
    const int b = task / (NHEAD * NCHK), h = (task / NCHK) % NHEAD, c = task % NCHK; const size_t row0 = (size_t)b * SEQ + c * 64;
    if (wave == 0) { P.fpre = gates[(row0 + lane) * 8 + 4 + h]; P.ipre = gates[(row0 + lane) * 8 + h]; }
    const int l = tid & 63, c8 = wave * 8, v16 = wave * 16;
    conv8_fetch(Z, b, c * 64 + l, 256 + h * 64 + c8, P.zk);
    const u32x4* vr = (const u32x4*)(Z + (row0 + l) * ZW + 1536 + h * 128 + v16); P.vv[0] = vr[0]; P.vv[1] = vr[1];
}
__device__ __forceinline__ void m1_body(const Args& a, LAS unsigned char* lds, int task, int tid, M1Pre& P, bool has_next, int next_task, M1Pre& Pn) {
    const int wave = __builtin_amdgcn_readfirstlane(tid >> 6), lane = tid & 63, fr = lane & 15, fq = lane >> 4;
    unsigned char* ws = a.ws;
    float* ML = (float*)(ws + WS_ML); float* BL = ML + NTASK; bf16* CST = (bf16*)(ws + WS_CST); float* NST = (float*)(ws + WS_NST);
    const int h = (task / NCHK) % NHEAD;
    constexpr int KS = 72;
    LAS float* wg = (LAS float*)lds;
    LAS bf16* kwT = (LAS bf16*)(lds + 256);
    LAS bf16* vT = (LAS bf16*)(lds + 256 + 64 * KS * 2);
    if (wave == 0) {
        const float fpre = P.fpre + a.in[I_FGB][h], ipre = P.ipre + a.in[I_IGB][h];
        const float bc = scan_add(logsigmoid_f(fpre), lane), blast = __shfl(bc, 63);
        const float g = blast - bc + ipre, mloc = wave_max(g);
        wg[lane] = expf(g - mloc);
        if (lane == 0) { ML[task] = mloc; BL[task] = blast; }
    }
    const int l = tid & 63, c8 = wave * 8, v16 = wave * 16;
    float kv[8]; conv8_math(a, 256 + h * 64 + c8, P.zk, kv);
#pragma unroll
    for (int q = 0; q < 2; ++q) { const u32x4 z = P.vv[q];
#pragma unroll
        for (int j = 0; j < 4; ++j) { vT[(v16 + 8 * q + 2 * j) * KS + l] = (bf16)(z[j] & 0xffffu); vT[(v16 + 8 * q + 2 * j + 1) * KS + l] = (bf16)(z[j] >> 16); } }
    LBAR();
    {
        const float sc = 0.125f * wg[l];
#pragma unroll
        for (int i = 0; i < 8; ++i) kwT[(c8 + i) * KS + l] = (bf16)f2bf(kv[i] * sc);
    }
    LBAR();
    if (has_next) m1_fetch(a, next_task, tid, Pn);
    {
        f32x4 acc[4];
#pragma unroll
        for (int kb = 0; kb < 4; ++kb) acc[kb] = (f32x4){0.f, 0.f, 0.f, 0.f};
#pragma unroll
        for (int ks = 0; ks < 2; ++ks) { const bf16x8 yf = *(const LAS bf16x8*)(vT + (16 * wave + fr) * KS + 32 * ks + 8 * fq);
#pragma unroll
            for (int kb = 0; kb < 4; ++kb) { const bf16x8 xf = *(const LAS bf16x8*)(kwT + (16 * kb + fr) * KS + 32 * ks + 8 * fq);
                acc[kb] = __builtin_amdgcn_mfma_f32_16x16x32_bf16(xf, yf, acc[kb], 0, 0, 0); } }
        bf16* cp = CST + (size_t)task * 8192 + (16 * wave + fr) * 64 + 4 * fq;
#pragma unroll
        for (int kb = 0; kb < 4; ++kb) { u32x2 o; o.x = pk2(acc[kb][0], acc[kb][1]); o.y = pk2(acc[kb][2], acc[kb][3]); *(u32x2*)(cp + 16 * kb) = o; }
        if (tid < 64) { float s = 0.f;
#pragma unroll 8
            for (int ll = 0; ll < 64; ++ll) s += __builtin_bit_cast(float, (unsigned)kwT[tid * KS + ll] << 16);
            NST[(size_t)task * 64 + tid] = s; }
    }
    LBAR();
}

__device__ __forceinline__ void scan_block(const Args& a, LAS unsigned char* lds, int vb, int tid) {
    unsigned char* ws = a.ws;
    float* ML = (float*)(ws + WS_ML); float* BL = ML + NTASK; float* MP = ML + 2 * NTASK; bf16* CST = (bf16*)(ws + WS_CST); float* NST = (float*)(ws + WS_NST);
    const int bh = vb >> 3, part = vb & 7;
    LAS float* sm = (LAS float*)lds;
    if (tid < 128) { sm[tid] = ML[bh * NCHK + tid]; sm[128 + tid] = BL[bh * NCHK + tid]; }
    typedef float f32x2v __attribute__((ext_vector_type(2)));
    unsigned* cp = (unsigned*)(CST + (size_t)bh * NCHK * 8192) + part * 512 + tid;
    const bool hasn = (part == 0 && tid < 64); float* np = NST + (size_t)bh * NCHK * 64 + tid;
    f32x2v cs = (f32x2v){0.f, 0.f}; float ns = 0.f, ms = 0.f;
    unsigned cl[8], cn[8]; float nl[8], nn[8];
#pragma unroll
    for (int i = 0; i < 8; ++i) { cl[i] = cp[(size_t)i * 4096]; nl[i] = hasn ? np[i * 64] : 0.f; }
    LBAR();
    for (int c0 = 0; c0 < NCHK; c0 += 8) {
        if (c0 + 8 < NCHK) {
#pragma unroll
            for (int i = 0; i < 8; ++i) { cn[i] = cp[(size_t)(c0 + 8 + i) * 4096]; nn[i] = hasn ? np[(c0 + 8 + i) * 64] : 0.f; }
        }
#pragma unroll
        for (int i = 0; i < 8; ++i) {
            const float ml = sm[c0 + i], bl = sm[128 + c0 + i];
            const float mn = fmaxf(bl + ms, ml), aa = __expf(bl + ms - mn), ee = __expf(ml - mn);
            cp[(size_t)(c0 + i) * 4096] = pk2(cs.x, cs.y); if (hasn) np[(c0 + i) * 64] = ns;
            if (part == 0 && tid == 0) MP[bh * NCHK + c0 + i] = ms;
            cs = cs * aa + (f32x2v){bflo(cl[i]), bfhi(cl[i])} * ee; ns = ns * aa + nl[i] * ee; ms = mn;
        }
#pragma unroll
        for (int i = 0; i < 8; ++i) { cl[i] = cn[i]; nl[i] = nn[i]; }
    }
    LBAR();
}

struct M3Pre { u32x4 zq[2][4]; u32x4 vv[2]; u32x4 cc[2]; u32x4 ov[2]; float fpre, ipre, mp, nst; };
__device__ __forceinline__ void m3_fetch(const Args& a, int task, int tid, M3Pre& P) {
    const int wave = __builtin_amdgcn_readfirstlane(tid >> 6), lane = tid & 63, fr = lane & 15, fq = lane >> 4;
    unsigned char* ws = a.ws;
    const bf16* Z = (const bf16*)(ws + WS_Z); const float* gates = (const float*)(ws + WS_GATES);
    const float* MP = (const float*)(ws + WS_ML) + 2 * NTASK; const bf16* CST = (const bf16*)(ws + WS_CST); const float* NST = (const float*)(ws + WS_NST);
    const int b = task / (NHEAD * NCHK), h = (task / NCHK) % NHEAD, c = task % NCHK; const size_t row0 = (size_t)b * SEQ + c * 64;
    if (wave == 0) { P.fpre = gates[(row0 + lane) * 8 + 4 + h]; P.ipre = gates[(row0 + lane) * 8 + h]; P.mp = MP[task]; P.nst = NST[(size_t)task * 64 + lane]; }
    { const int mat = tid >> 8, l = (tid & 255) >> 2, c16 = (tid & 3) * 16;
#pragma unroll
      for (int q = 0; q < 2; ++q) conv8_fetch(Z, b, c * 64 + l, mat * 256 + h * 64 + c16 + 8 * q, P.zq[q]); }
    { const int l = tid & 63, v16 = wave * 16; const u32x4* vr = (const u32x4*)(Z + (row0 + l) * ZW + 1536 + h * 128 + v16); P.vv[0] = vr[0]; P.vv[1] = vr[1]; }
    { const int v = tid >> 2, k16 = (tid & 3) * 16; const u32x4* cr = (const u32x4*)(CST + (size_t)task * 8192 + v * 64 + k16); P.cc[0] = cr[0]; P.cc[1] = cr[1]; }
    { const int tb = wave & 3, vh = wave >> 2, t = 16 * tb + fr;
#pragma unroll
      for (int p = 0; p < 2; ++p) P.ov[p] = *(const u32x4*)(Z + (row0 + t) * ZW + 2048 + h * 128 + vh * 64 + 32 * p + 8 * fq); }
}
__device__ __forceinline__ void m3_body(const Args& a, LAS unsigned char* lds, int task, int tid, M3Pre& P, bool has_next, int next_task, M3Pre& Pn) {
    const int wave = __builtin_amdgcn_readfirstlane(tid >> 6), lane = tid & 63, fr = lane & 15, fq = lane >> 4;
    unsigned char* ws = a.ws;
    bf16* Y = (bf16*)(ws + WS_Y);
    const int b = task / (NHEAD * NCHK), h = (task / NCHK) % NHEAD, c = task % NCHK; const size_t row0 = (size_t)b * SEQ + c * 64;
    constexpr int QS = 72, PS = 136;
    LAS float* bm = (LAS float*)lds; LAS float* ib = bm + 64; LAS float* ai = bm + 128; LAS float* emt = bm + 192;
    LAS float* hs = (LAS float*)(lds + 1024);
    LAS bf16* Qs = (LAS bf16*)(lds + 2048);
    LAS bf16* Ks = (LAS bf16*)(lds + 2048 + 9216);
    LAS bf16* Ps = (LAS bf16*)(lds + 20480);
    LAS bf16* Rs = (LAS bf16*)(lds + 37888);
    if (wave == 0) {
        const float fpre = P.fpre + a.in[I_FGB][h], ipre = P.ipre + a.in[I_IGB][h];
        const float bc = scan_add(logsigmoid_f(fpre), lane), ibv = ipre - bc, cm = scan_max(ibv, lane), mp = P.mp;
        const float mx = fmaxf(mp, cm), mt = bc + mx;
        bm[lane] = -mx; ib[lane] = ibv; ai[lane] = expf(mp - mx); emt[lane] = expf(-mt);
        Rs[128 * PS + lane] = (bf16)0x3f80u; Rs[128 * PS + 64 + lane] = (bf16)f2bf(P.nst);
    }
    {
        const int mat = tid >> 8, l = (tid & 255) >> 2, c16 = (tid & 3) * 16; LAS bf16* dst = (mat ? Ks : Qs) + l * QS + c16; const float sc = mat ? 0.125f : 1.0f;
#pragma unroll
        for (int q = 0; q < 2; ++q) { float kv[8]; conv8_math(a, mat * 256 + h * 64 + c16 + 8 * q, P.zq[q], kv);
            u32x4 o; o.x = pk2(kv[0] * sc, kv[1] * sc); o.y = pk2(kv[2] * sc, kv[3] * sc); o.z = pk2(kv[4] * sc, kv[5] * sc); o.w = pk2(kv[6] * sc, kv[7] * sc);
            *(LAS u32x4*)(dst + 8 * q) = o; }
    }
    {
        const int l = tid & 63, v16 = wave * 16;
#pragma unroll
        for (int q = 0; q < 2; ++q) { const u32x4 z = P.vv[q];
#pragma unroll
            for (int j = 0; j < 4; ++j) { Rs[(v16 + 8 * q + 2 * j) * PS + l] = (bf16)(z[j] & 0xffffu); Rs[(v16 + 8 * q + 2 * j + 1) * PS + l] = (bf16)(z[j] >> 16); } }
        const int v = tid >> 2, k16 = (tid & 3) * 16;
        *(LAS u32x4*)(Rs + v * PS + 64 + k16) = P.cc[0]; *(LAS u32x4*)(Rs + v * PS + 64 + k16 + 8) = P.cc[1];
    }
    const u32x4 ov0 = P.ov[0], ov1 = P.ov[1];
    LBAR();
    if (has_next) m3_fetch(a, next_task, tid, Pn);
    f32x4 gn[2][2];
    { const int vh = wave >> 2;
#pragma unroll
      for (int p = 0; p < 2; ++p) { const int v0 = h * 128 + vh * 64 + 32 * p + 8 * fq; gn[p][0] = *(const f32x4*)(a.in[I_MHN] + v0); gn[p][1] = *(const f32x4*)(a.in[I_MHN] + v0 + 4); } }
    {
        const int tb = wave & 3, sb2 = wave >> 2, t = 16 * tb + fr; const float bmt = bm[t];
#pragma unroll
        for (int e = 0; e < 2; ++e) { const int sb = 2 * sb2 + e; u32x2 o = (u32x2){0u, 0u};
            if (sb <= tb) { f32x4 acc = (f32x4){0.f, 0.f, 0.f, 0.f};
#pragma unroll
                for (int ks = 0; ks < 2; ++ks) { const bf16x8 xf = *(const LAS bf16x8*)(Ks + (16 * sb + fr) * QS + 32 * ks + 8 * fq), yf = *(const LAS bf16x8*)(Qs + t * QS + 32 * ks + 8 * fq);
                    acc = __builtin_amdgcn_mfma_f32_16x16x32_bf16(xf, yf, acc, 0, 0, 0); }
                float w[4];
#pragma unroll
                for (int j = 0; j < 4; ++j) { const int s = 16 * sb + 4 * fq + j; w[j] = (s <= t) ? __expf(bmt + ib[s]) * acc[j] : 0.f; }
                o.x = pk2(w[0], w[1]); o.y = pk2(w[2], w[3]); }
            *(LAS u32x2*)(Ps + t * PS + 16 * sb + 4 * fq) = o; }
        const int t2 = tid >> 3, k8 = (tid & 7) * 8; const float av = ai[t2]; const u32x4 qv = *(const LAS u32x4*)(Qs + t2 * QS + k8);
        u32x4 o; o.x = pk2(bflo(qv.x) * av, bfhi(qv.x) * av); o.y = pk2(bflo(qv.y) * av, bfhi(qv.y) * av); o.z = pk2(bflo(qv.z) * av, bfhi(qv.z) * av); o.w = pk2(bflo(qv.w) * av, bfhi(qv.w) * av);
        *(LAS u32x4*)(Ps + t2 * PS + 64 + k8) = o;
    }
    LBAR();
    {
        const int tb = wave & 3, vh = wave >> 2, t = 16 * tb + fr;
        f32x4 acc[2][2], accd = (f32x4){0.f, 0.f, 0.f, 0.f};
#pragma unroll
        for (int p = 0; p < 2; ++p) { acc[p][0] = (f32x4){0.f, 0.f, 0.f, 0.f}; acc[p][1] = (f32x4){0.f, 0.f, 0.f, 0.f}; }
#pragma unroll
        for (int ks = 0; ks < 4; ++ks) { const bf16x8 yf = *(const LAS bf16x8*)(Ps + t * PS + 32 * ks + 8 * fq);
#pragma unroll
            for (int p = 0; p < 2; ++p)
#pragma unroll
                for (int n = 0; n < 2; ++n) { const int vrow = vh * 64 + 32 * p + 8 * (fr >> 2) + 4 * n + (fr & 3);
                    const bf16x8 xf = *(const LAS bf16x8*)(Rs + vrow * PS + 32 * ks + 8 * fq);
                    acc[p][n] = __builtin_amdgcn_mfma_f32_16x16x32_bf16(xf, yf, acc[p][n], 0, 0, 0); }
            const bf16x8 xd = *(const LAS bf16x8*)(Rs + 128 * PS + 32 * ks + 8 * fq);
            accd = __builtin_amdgcn_mfma_f32_16x16x32_bf16(xd, yf, accd, 0, 0, 0); }
        const float den = accd[0], inv = 1.0f / fmaxf(fabsf(den), emt[t]);
        float ssq = 0.f;
#pragma unroll
        for (int p = 0; p < 2; ++p)
#pragma unroll
            for (int n = 0; n < 2; ++n) { acc[p][n] = acc[p][n] * inv; ssq += (acc[p][n][0] * acc[p][n][0] + acc[p][n][1] * acc[p][n][1]) + (acc[p][n][2] * acc[p][n][2] + acc[p][n][3] * acc[p][n][3]); }
        ssq += __shfl_xor(ssq, 16); ssq += __shfl_xor(ssq, 32);
        if (fq == 0) hs[t * 2 + vh] = ssq;
        LBAR();
        const float rs = __builtin_amdgcn_rsqf((hs[t * 2] + hs[t * 2 + 1]) * (1.f / 128.f) + EPS);
#pragma unroll
        for (int p = 0; p < 2; ++p) { const int v0 = h * 128 + vh * 64 + 32 * p + 8 * fq;
            const u32x4 ov = p ? ov1 : ov0; const f32x4 g0 = gn[p][0], g1 = gn[p][1];
            u32x4 o;
            o.x = pk2(acc[p][0][0] * rs * g0[0] * pg8::sigmoid_f(bflo(ov.x)), acc[p][0][1] * rs * g0[1] * pg8::sigmoid_f(bfhi(ov.x)));
            o.y = pk2(acc[p][0][2] * rs * g0[2] * pg8::sigmoid_f(bflo(ov.y)), acc[p][0][3] * rs * g0[3] * pg8::sigmoid_f(bfhi(ov.y)));
            o.z = pk2(acc[p][1][0] * rs * g1[0] * pg8::sigmoid_f(bflo(ov.z)), acc[p][1][1] * rs * g1[1] * pg8::sigmoid_f(bfhi(ov.z)));
            o.w = pk2(acc[p][1][2] * rs * g1[2] * pg8::sigmoid_f(bflo(ov.w)), acc[p][1][3] * rs * g1[3] * pg8::sigmoid_f(bfhi(ov.w)));
            *(u32x4*)(Y + (row0 + t) * 1024 + 512 + v0) = o; }
    }
    LBAR();
}

#define XB_TMO      128
#define XB_XCNT(j)  (256  + 64 * (j))
#define XB_XSUB(j)  (1280 + 64 * (j))
#define XB_XGEN(j)  (2304 + 64 * (j))
#define XB_TOP      3328
#define XB_TOPGEN   3392
#define XCD_BAR_WORDS 3456
#define XB_SPIN_CAP (1u << 18)

__device__ __forceinline__ unsigned xb_ld(unsigned* p)              { return __hip_atomic_load(p, __ATOMIC_RELAXED, __HIP_MEMORY_SCOPE_AGENT); }
__device__ __forceinline__ unsigned xb_add(unsigned* p, unsigned v) { return __hip_atomic_fetch_add(p, v, __ATOMIC_RELAXED, __HIP_MEMORY_SCOPE_AGENT); }
__device__ __forceinline__ unsigned xb_xcc_id() { return (unsigned)__builtin_amdgcn_s_getreg((3 << 11) | 20) & 0xFu; }
#define XB_SPIN(cond, bar) do { unsigned _sp = 0; while (cond) { __builtin_amdgcn_s_sleep(1); \
    if ((++_sp & 255u) == 0u) { if (xb_ld(&(bar)[XB_TMO])) break; if (_sp > XB_SPIN_CAP) { atomicAdd(&(bar)[XB_TMO], 1u); break; } } } } while (0)

struct XcdBarrier {
    unsigned* bar; unsigned x;
    volatile LAS unsigned* st;
};

__device__ __forceinline__ XcdBarrier xcd_barrier_post(unsigned* bar, volatile LAS unsigned* st) {
    XcdBarrier b; b.bar = bar; b.x = xb_xcc_id(); b.st = st;
    if (threadIdx.x == 0) (void)xb_add(&bar[XB_XCNT(b.x)], 1u);
    return b;
}
__device__ __forceinline__ void xcd_barrier_complete(unsigned* bar, unsigned x, unsigned& nloc, unsigned& nx) {
    const unsigned G = gridDim.x * gridDim.y * gridDim.z;
    unsigned sum, cnt, mine, sp = 0u;
    for (;;) {
        sum = 0u; cnt = 0u; mine = 0u;
#pragma unroll
        for (unsigned j = 0; j < 16; ++j) { const unsigned c = xb_ld(&bar[XB_XCNT(j)]); sum += c; cnt += (c > 0u) ? 1u : 0u; mine = (j == x) ? c : mine; }
        if (sum == G) break;
        __builtin_amdgcn_s_sleep(1);
        if ((++sp & 255u) == 0u) { if (xb_ld(&bar[XB_TMO])) break; if (sp > XB_SPIN_CAP) { atomicAdd(&bar[XB_TMO], 1u); break; } }
    }
    nloc = mine > 0u ? mine : 1u; nx = cnt > 0u ? cnt : 1u;
}

__device__ __forceinline__ void xcd_barrier(const XcdBarrier& b) {
    asm volatile("s_waitcnt vmcnt(0)" ::: "memory");
    __syncthreads();
    if (threadIdx.x == 0) {
        unsigned* bar = b.bar;
        __builtin_amdgcn_s_waitcnt(0);
        unsigned nloc = b.st[0], nx = b.st[1];
        if (nloc == 0u) { xcd_barrier_complete(bar, b.x, nloc, nx); b.st[0] = nloc; b.st[1] = nx; }
        const unsigned old = xb_add(&bar[XB_XSUB(b.x)], 1u);
        const unsigned gen = old / nloc;
        if (old + 1u == (gen + 1u) * nloc) {
            __builtin_amdgcn_fence(__ATOMIC_RELEASE, "agent");
            asm volatile("s_waitcnt vmcnt(0)" ::: "memory");
            const unsigned og = xb_add(&bar[XB_TOP], 1u);
            const unsigned tg = og / nx;
            if (og + 1u == (tg + 1u) * nx) xb_add(&bar[XB_TOPGEN], 1u);
            else XB_SPIN(xb_ld(&bar[XB_TOPGEN]) == tg, bar);
            __builtin_amdgcn_fence(__ATOMIC_ACQUIRE, "agent");
            xb_add(&bar[XB_XGEN(b.x)], 1u);
            asm volatile("s_waitcnt vmcnt(0)" ::: "memory");
        } else {
            XB_SPIN(xb_ld(&bar[XB_XGEN(b.x)]) == gen, bar);
            __builtin_amdgcn_fence(__ATOMIC_ACQUIRE, "agent");
            asm volatile("s_waitcnt vmcnt(0)" ::: "memory");
        }
    }
    __syncthreads();
}
__global__ void __launch_bounds__(NTHR, 2) fwd_megakernel(Args args) {
    extern __shared__ __attribute__((aligned(16))) unsigned char lds_raw[];
    LAS unsigned char* lds = (LAS unsigned char*)lds_raw;
    cg::grid_group grid = cg::this_grid();
    const int tid = threadIdx.x, wave = __builtin_amdgcn_readfirstlane(tid >> 6), lane = tid & 63;
    const int G = gridDim.x, bx = blockIdx.x, vcu = (G % 8 == 0) ? (bx % 8) * (G / 8) + bx / 8 : bx;
    unsigned char* ws = args.ws;
    const int lo = args.ph_lo, hi = args.ph_hi;
#define IN(k) (lo <= (k) && (k) < hi)
#define REPS(k) ((((REP_MASK) >> (k)) & 1) ? 2 : 1)
#define SEAM(k) do { if (IN(k) && IN((k) + 1)) { if (USE_CG_SYNC) grid.sync(); else xcd_barrier(xbar); } } while (0)
    volatile LAS unsigned* MISC = (volatile LAS unsigned*)(lds + MISC_OFF);
    if (tid < 32) MISC[tid] = 0u;
    __syncthreads();
    XcdBarrier xbar = xcd_barrier_post((unsigned*)(ws + WS_CTL) + 1024, MISC + 8);
    bf16* XB = (bf16*)(ws + WS_XB); bf16* HID = (bf16*)(ws + WS_HID); bf16* Zb = (bf16*)(ws + WS_Z); bf16* Yb = (bf16*)(ws + WS_Y);
    float* RSS = (float*)(ws + WS_RSS); float* X1 = args.out;

    if (hi < 0) grid.sync();
    if (IN(0)) { for (int rep = 0; rep < REPS(0); ++rep) p0_prologue(args, lds, vcu, G, tid); } SEAM(0);
    if (REPS(12) == 2) { for (int i = 0; i < 10; ++i) grid.sync(); }
    if (IN(1)) _Pragma("unroll") for (int rep = 0; rep < REPS(1); ++rep) {
        pg8::Gemm g{XB, (const bf16*)(ws + WS_WGU1), M, NGU, D}; pg8::StaticOrder S; S.init(M, NGU, G, bx);
        pg8::EpiGU E{HID, RSS, FF};
        pg8::gemm_phase<pg8::EpiGU, pg8::StaticOrder, GEMM_ALIGN, GEMM_SP2>(lds, g, S, E);
    } SEAM(1);
    if (IN(2)) {
        pg8::Gemm g{HID, (const bf16*)(ws + WS_WD1), M, D, FF}; pg8::StaticOrder S; S.init(M, D, G, bx);
        pg8::EpiRes<false> E{args.in[I_X], XB, RSS + M, 0.5f};
        pg8::gemm_phase<pg8::EpiRes<false>, pg8::StaticOrder, GEMM_ALIGN, GEMM_SP2>(lds, g, S, E);
    } SEAM(2);
    if (IN(3)) _Pragma("unroll") for (int rep = 0; rep < REPS(3); ++rep) {
        pg8::Gemm g{XB, (const bf16*)(ws + WS_WIN), M, NINP, D}; pg8::StaticOrder S; S.init(M, NINP, G, bx);
        pg8::EpiIn E{Zb, (float*)(ws + WS_GATES), RSS + M, ZW};
        pg8::gemm_phase<pg8::EpiIn, pg8::StaticOrder, GEMM_ALIGN, GEMM_SP2>(lds, g, S, E);
    } SEAM(3);
    if (IN(4)) {
        for (int rep = 0; rep < REPS(11); ++rep) for (int ch = vcu; ch < M / 128; ch += G) sgu_chunk(args, lds, ch, tid);
        { M1Pre P, Pn; int t = vcu; if (t < NTASK) m1_fetch(args, t, tid, P);
          for (; t < NTASK; t += G) { const int tn = t + G; m1_body(args, lds, t, tid, P, tn < NTASK, tn, Pn); P = Pn; } }
    } SEAM(4);
    if (IN(5)) { for (int vb = vcu; vb < 256; vb += G) scan_block(args, lds, vb, tid); } SEAM(5);
    if (IN(6)) { M3Pre P, Pn; int t = vcu; if (t < NTASK) m3_fetch(args, t, tid, P);
        for (; t < NTASK; t += G) { const int tn = t + G; m3_body(args, lds, t, tid, P, tn < NTASK, tn, Pn); P = Pn; } } SEAM(6);
    if (IN(7)) {
        pg8::Gemm g{Yb, (const bf16*)(ws + WS_WOUT), M, D, D}; pg8::StaticOrder S; S.init(M, D, G, bx);
        pg8::EpiRes<true> E{XB, XB, RSS + 2 * M, 1.0f};
        pg8::gemm_phase<pg8::EpiRes<true>, pg8::StaticOrder, GEMM_ALIGN, GEMM_SP2>(lds, g, S, E);
    } SEAM(7);
    if (IN(8)) {
        pg8::Gemm g{XB, (const bf16*)(ws + WS_WGU2), M, NGU, D}; pg8::StaticOrder S; S.init(M, NGU, G, bx);
        pg8::EpiGU E{HID, RSS + 2 * M, FF};
        pg8::gemm_phase<pg8::EpiGU, pg8::StaticOrder, GEMM_ALIGN, GEMM_SP2>(lds, g, S, E);
    } SEAM(8);
#if FUSE_FINAL
    if (IN(9)) {
        pg8::Gemm g{HID, (const bf16*)(ws + WS_WD2), M, D, FF}; pg8::StaticOrder S; S.init(M, D, G, bx);
        pg8::EpiResNorm E{XB, X1, RSS + 3 * M, (unsigned*)(ws + WS_CTL) + 8192, args.in[I_FINALN], 0.5f};
        pg8::gemm_phase<pg8::EpiResNorm, pg8::StaticOrder, GEMM_ALIGN, GEMM_SP2>(lds, g, S, E);
    }
#else
    if (IN(9)) {
        pg8::Gemm g{HID, (const bf16*)(ws + WS_WD2), M, D, FF}; pg8::StaticOrder S; S.init(M, D, G, bx);
        pg8::EpiRes<true> E{XB, XB, RSS + 3 * M, 0.5f};
        pg8::gemm_phase<pg8::EpiRes<true>, pg8::StaticOrder, GEMM_ALIGN, GEMM_SP2>(lds, g, S, E);
    } SEAM(9);
    if (IN(10)) {
        const int gw = vcu * NWAVES + wave, NGW = G * NWAVES; const float* rss3 = RSS + 3 * M; const f32x4* gn = (const f32x4*)args.in[I_FINALN];
        const f32x4 g0 = gn[lane], g1 = gn[64 + lane], g2 = gn[128 + lane], g3 = gn[192 + lane];
        for (int m0 = gw * 4; m0 < M; m0 += NGW * 4) {
            u32x2 v[4][4]; float r[4];
#pragma unroll
            for (int q = 0; q < 4; ++q) { const u32x2* xr = (const u32x2*)(XB + (size_t)(m0 + q) * D) + lane;
#pragma unroll
                for (int j = 0; j < 4; ++j) v[q][j] = __builtin_nontemporal_load(xr + 64 * j);
                r[q] = rss3[m0 + q]; }
#pragma unroll
            for (int q = 0; q < 4; ++q) { const float rs = __builtin_amdgcn_rsqf(r[q] * (1.f / 1024.f) + EPS); f32x4* o = (f32x4*)(X1 + (size_t)(m0 + q) * D) + lane;
                *(o) = ((f32x4){bflo(v[q][0].x), bfhi(v[q][0].x), bflo(v[q][0].y), bfhi(v[q][0].y)}) * rs * g0;
                *(o + 64) = ((f32x4){bflo(v[q][1].x), bfhi(v[q][1].x), bflo(v[q][1].y), bfhi(v[q][1].y)}) * rs * g1;
                *(o + 128) = ((f32x4){bflo(v[q][2].x), bfhi(v[q][2].x), bflo(v[q][2].y), bfhi(v[q][2].y)}) * rs * g2;
                *(o + 192) = ((f32x4){bflo(v[q][3].x), bfhi(v[q][3].x), bflo(v[q][3].y), bfhi(v[q][3].y)}) * rs * g3; }
        }
    }
#endif
#undef IN
#undef SEAM
}

#ifndef MK_N_LAUNCHES
#define MK_N_LAUNCHES 1
#endif
constexpr int N_PHASES = FUSE_FINAL ? 10 : 11;
extern "C" void kernel_launch(void* const* d_in, const int* in_sizes, int n_in, void* d_out, int out_size, void* d_ws, size_t ws_size, hipStream_t stream) {
    static int grid = 0;
    if (grid == 0) {
        if (n_in != 22 || in_sizes[0] != M * D || out_size != M * D || ws_size < WS_END) { fprintf(stderr, "kernel_launch: unexpected shapes (n_in %d, in0 %d, out %d, ws %zu)\n", n_in, n_in > 0 ? in_sizes[0] : -1, out_size, ws_size); grid = -1; return; }
        int dev = 0, cus = 0, per_cu = 0;
        hipGetDevice(&dev); hipDeviceGetAttribute(&cus, hipDeviceAttributeMultiprocessorCount, dev);
        hipFuncSetAttribute((const void*)fwd_megakernel, hipFuncAttributeMaxDynamicSharedMemorySize, LDS_BYTES);
        if (hipOccupancyMaxActiveBlocksPerMultiprocessor(&per_cu, (const void*)fwd_megakernel, NTHR, LDS_BYTES) != hipSuccess || per_cu < 1) { fprintf(stderr, "kernel_launch: occupancy query gave %d\n", per_cu); per_cu = 1; }
        (void)hipGetLastError();
        grid = cus * per_cu;
    }
    if (grid < 0) return;
    if (hipMemsetAsync((char*)d_ws + WS_CTL, 0, CTL_ZERO_BYTES, stream) != hipSuccess) { fprintf(stderr, "kernel_launch: memset failed\n"); return; }
    Args a{};
    for (int i = 0; i < 22; ++i) a.in[i] = (const float*)d_in[i];
    a.out = (float*)d_out; a.ws = (unsigned char*)d_ws;
#if MK_N_LAUNCHES == 1
    a.ph_lo = 0; a.ph_hi = N_PHASES;
    void* kargs[] = {&a};
    hipError_t e = hipLaunchCooperativeKernel((const void*)fwd_megakernel, dim3(grid), dim3(NTHR), kargs, LDS_BYTES, stream);
    if (e != hipSuccess) fprintf(stderr, "cooperative launch failed: %s (grid %d)\n", hipGetErrorString(e), grid);
#else
    for (int p = 0; p < N_PHASES; ++p) { a.ph_lo = p; a.ph_hi = p + 1; hipLaunchKernelGGL(fwd_megakernel, dim3(grid), dim3(NTHR), LDS_BYTES, stream, a); }
#endif
}
```
